# Optimizing an MI355X kernel written in HIP

```python
import math
import jax, jax.numpy as jnp
from jax import lax
import numpy as np

D_MODEL = 1024
BATCH = 8
SEQ = 2048
DEPTH = 1

D_MIX = D_MODEL
HEAD_DIM = 64
D_A = D_MIX // 2
D_B = D_MIX - D_A
N_HEADS_A = D_A // HEAD_DIM
N_HEADS_B = D_B // HEAD_DIM
IDX_HEADS = 16
IDX_DIM = 64
TOPK_MAX = 256
NUM_BUCKETS = 32
MAX_DISTANCE = 128
Q_BLOCK = 128
SPARSE_Q_BLOCK = 64
RMS_EPS = 1e-6
IDX_SCALE = (IDX_HEADS * IDX_DIM) ** -0.5

SPLIT_SIZES = (
    D_A, D_A, D_A, D_A,
    IDX_HEADS * IDX_DIM, IDX_DIM, IDX_HEADS,
    D_B, D_B, D_B, D_B,
)
D_IN_PROJ = sum(SPLIT_SIZES)

kernel_name = "hymba_dsa_stickbreaking_hybrid"


def rms_norm(x, gain):
    xf = x.astype(jnp.float32)
    y = xf * lax.rsqrt(jnp.mean(xf * xf, axis=-1, keepdims=True) + RMS_EPS)
    return (y * gain.astype(jnp.float32)).astype(x.dtype)


def split_columns(a):
    offsets = np.cumsum(SPLIT_SIZES)[:-1].tolist()
    return jnp.split(a, offsets, axis=-1)


def t5_bucket(dist):
    max_exact = NUM_BUCKETS // 2
    d = jnp.maximum(dist, 0)
    d_f = jnp.maximum(d, 1).astype(jnp.float32)
    large = max_exact + (jnp.log(d_f / max_exact) / math.log(MAX_DISTANCE / max_exact)
                         * (NUM_BUCKETS - max_exact)).astype(jnp.int32)
    large = jnp.minimum(large, NUM_BUCKETS - 1)
    return jnp.where(d < max_exact, d, large)


def to_blocks(a, block):
    b, l = a.shape[0], a.shape[1]
    return jnp.moveaxis(a.reshape(b, l // block, block, *a.shape[2:]), 1, 0)


def from_blocks(a):
    a = jnp.moveaxis(a, 0, 1)
    return a.reshape(a.shape[0], a.shape[1] * a.shape[2], *a.shape[3:])


def dsa_sparse_attention(q, k, v, q_idx, k_idx, w_idx, rel_bias):
    b, l, h, dh = q.shape
    topk = min(TOPK_MAX, l // 4)
    nb = l // SPARSE_Q_BLOCK
    key_pos = jnp.arange(l, dtype=jnp.int32)
    scale = dh ** -0.5
    gather = jax.vmap(lambda src, idx: src[idx])

    def block(args):
        qb, qib, wb, t0 = args
        t = t0 + jnp.arange(SPARSE_Q_BLOCK, dtype=jnp.int32)
        causal = key_pos[None, :] <= t[:, None]
        dots = jnp.einsum('btid,bsd->btis', qib, k_idx).astype(jnp.float32)
        score = jnp.einsum('bti,btis->bts', wb.astype(jnp.float32) * IDX_SCALE,
                           jax.nn.relu(dots))
        score = jnp.where(causal[None], score, -jnp.inf)
        _, sel = lax.top_k(score, topk)
        valid = sel <= t[None, :, None]
        k_sel = gather(k, sel)
        v_sel = gather(v, sel)
        logits = jnp.einsum('bthd,btkhd->bthk', qb, k_sel).astype(jnp.float32) * scale
        bias = rel_bias[t5_bucket(t[None, :, None] - sel)]
        logits = logits + jnp.moveaxis(bias.astype(jnp.float32), -1, 2)
        logits = jnp.where(valid[:, :, None, :], logits, -jnp.inf)
        p = jax.nn.softmax(logits, axis=-1)
        return jnp.einsum('bthk,btkhd->bthd', p.astype(v.dtype), v_sel)

    starts = jnp.arange(nb, dtype=jnp.int32) * SPARSE_Q_BLOCK
    out = lax.map(block, (to_blocks(q, SPARSE_Q_BLOCK), to_blocks(q_idx, SPARSE_Q_BLOCK),
                          to_blocks(w_idx, SPARSE_Q_BLOCK), starts))
    return from_blocks(out)


def stick_breaking_attention(q, k, v):
    b, l, h, dh = q.shape
    nb = l // Q_BLOCK
    key_pos = jnp.arange(l, dtype=jnp.int32)
    scale = dh ** -0.5

    def block(args):
        qb, t0 = args
        t = t0 + jnp.arange(Q_BLOCK, dtype=jnp.int32)
        strict = key_pos[None, :] < t[:, None]
        z = jnp.einsum('bthd,bshd->bhts', qb, k).astype(jnp.float32) * scale
        log_beta = jax.nn.log_sigmoid(z)
        log_one_minus = jnp.where(strict, jax.nn.log_sigmoid(-z), 0.0)
        suffix = lax.cumsum(log_one_minus, axis=3, reverse=True) - log_one_minus
        a = jnp.where(strict, jnp.exp(log_beta + suffix), 0.0)
        return jnp.einsum('bhts,bshd->bthd', a.astype(v.dtype), v)

    starts = jnp.arange(nb, dtype=jnp.int32) * Q_BLOCK
    out = lax.map(block, (to_blocks(q, Q_BLOCK), starts))
    return from_blocks(out)


def setup_inputs(seed: int = 0) -> dict:
    key = jax.random.key(seed)
    ks = jax.random.split(key, 8)
    x = jax.random.normal(ks[0], (BATCH, SEQ, D_MODEL), jnp.float32)
    norm_gain = 1.0 + 0.05 * jax.random.normal(ks[1], (DEPTH, D_MODEL), jnp.float32)
    w_in = jax.random.normal(ks[2], (DEPTH, D_MODEL, D_IN_PROJ), jnp.float32) * D_MODEL ** -0.5
    q_norm_gain = 1.0 + 0.05 * jax.random.normal(ks[3], (DEPTH, HEAD_DIM), jnp.float32)
    k_norm_gain = 1.0 + 0.05 * jax.random.normal(ks[4], (DEPTH, HEAD_DIM), jnp.float32)
    rel_bias = 0.5 * jax.random.normal(ks[5], (NUM_BUCKETS, N_HEADS_A), jnp.float32)
    w_out = jax.random.normal(ks[6], (DEPTH, D_MIX, D_MODEL), jnp.float32) * D_MIX ** -0.5
    return {"x": x, "norm_gain": norm_gain, "w_in": w_in, "q_norm_gain": q_norm_gain,
            "k_norm_gain": k_norm_gain, "rel_bias": rel_bias, "w_out": w_out}


def reference(x, norm_gain, w_in, q_norm_gain, k_norm_gain, rel_bias, w_out):
    b, l, _ = x.shape
    for layer in range(DEPTH):
        h = rms_norm(x, norm_gain[layer])
        proj = jnp.einsum('bld,dp->blp', h, w_in[layer])
        q_a, k_a, v_a, g_a, q_i, k_i, w_i, q_b, k_b, v_b, g_b = split_columns(proj)
        q_a = rms_norm(q_a.reshape(b, l, N_HEADS_A, HEAD_DIM), q_norm_gain[layer])
        k_a = rms_norm(k_a.reshape(b, l, N_HEADS_A, HEAD_DIM), k_norm_gain[layer])
        v_a = v_a.reshape(b, l, N_HEADS_A, HEAD_DIM)
        q_i = q_i.reshape(b, l, IDX_HEADS, IDX_DIM)
        o_a = dsa_sparse_attention(q_a, k_a, v_a, q_i, k_i, w_i, rel_bias)
        o_a = o_a.reshape(b, l, D_A) * jax.nn.silu(g_a)
        o_b = stick_breaking_attention(q_b.reshape(b, l, N_HEADS_B, HEAD_DIM),
                                       k_b.reshape(b, l, N_HEADS_B, HEAD_DIM),
                                       v_b.reshape(b, l, N_HEADS_B, HEAD_DIM))
        o_b = o_b.reshape(b, l, D_B) * jax.nn.silu(g_b)
        mixed = jnp.concatenate([o_a, o_b], axis=-1)
        x = x + jnp.einsum('blm,md->bld', mixed, w_out[layer])
    return x
```

```cpp
#include <hip/hip_runtime.h>
#include <stdint.h>

typedef _Float16 h16;

constexpr int NB = 8, SEQ = 2048, DM = 1024, MTOK = NB * SEQ;
constexpr int NPROJ = 5200;
constexpr float LOG2E = 1.4426950408889634f;
constexpr float QSCALE = 0.125f * LOG2E;
constexpr float IDXS = 0.03125f;
constexpr float RMS_EPS = 1e-6f;
constexpr int TOPK = 256;
constexpr int C_QA = 0, C_KA = 512, C_VA = 1024, C_GA = 1536, C_QI = 2048, C_KI = 3072, C_WI = 3136, C_QB = 3152, C_KB = 3664, C_VB = 4176, C_GB = 4688;

constexpr size_t MiB = 1u << 20;
constexpr size_t WS_CTL = 0, WS_HN = 1 * MiB, WS_W1T = 33 * MiB, WS_W2T = 44 * MiB;
constexpr size_t WS_QA = 46 * MiB, WS_KA = 62 * MiB, WS_VA = 78 * MiB, WS_GA = 94 * MiB, WS_QI = 110 * MiB, WS_KI = 142 * MiB, WS_WI = 144 * MiB;
constexpr size_t WS_QB = 145 * MiB, WS_KB = 161 * MiB, WS_VB = 177 * MiB, WS_GB = 193 * MiB, WS_MASK = 209 * MiB, WS_MIX = 213 * MiB, WS_FREE = 245 * MiB;

__device__ const unsigned char T5_BUCKET[128] = {0, 1, 2, 3, 4, 5, 6, 7, 8, 9, 10, 11, 12, 13, 14, 15, 16, 16, 16, 17, 17, 18, 18, 18, 19, 19, 19, 20, 20, 20, 20, 21, 21, 21, 21, 22, 22, 22, 22, 22, 23, 23, 23, 23, 23, 23, 24, 24, 24, 24, 24, 24, 25, 25, 25, 25, 25, 25, 25, 26, 26, 26, 26, 26, 26, 26, 26, 27, 27, 27, 27, 27, 27, 27, 27, 27, 27, 28, 28, 28, 28, 28, 28, 28, 28, 28, 28, 29, 29, 29, 29, 29, 29, 29, 29, 29, 29, 29, 29, 30, 30, 30, 30, 30, 30, 30, 30, 30, 30, 30, 30, 30, 30, 31, 31, 31, 31, 31, 31, 31, 31, 31, 31, 31, 31, 31, 31, 31};

__device__ __forceinline__ float wave_sum(float v) {
#pragma unroll
    for (int o = 1; o < 64; o <<= 1) v += __shfl_xor(v, o);
    return v;
}
__global__ void __launch_bounds__(256) k_rmsnorm(const float* __restrict__ x, const float* __restrict__ gain, h16* __restrict__ HN) {
    const int row = blockIdx.x * 4 + (threadIdx.x >> 6), lane = threadIdx.x & 63;
    const float4* xr = (const float4*)(x + (size_t)row * DM);
    float4 v[4]; float s = 0.f;
#pragma unroll
    for (int j = 0; j < 4; ++j) { v[j] = xr[lane + 64 * j]; s += v[j].x * v[j].x + v[j].y * v[j].y + v[j].z * v[j].z + v[j].w * v[j].w; }
    const float r = rsqrtf(wave_sum(s) * (1.f / DM) + RMS_EPS);
#pragma unroll
    for (int j = 0; j < 4; ++j) {
        const float4 g = ((const float4*)gain)[lane + 64 * j];
        h16* o = HN + (size_t)row * DM + 4 * (lane + 64 * j);
        o[0] = (h16)(v[j].x * r * g.x); o[1] = (h16)(v[j].y * r * g.y); o[2] = (h16)(v[j].z * r * g.z); o[3] = (h16)(v[j].w * r * g.w);
    }
}
__global__ void __launch_bounds__(256) k_gemm_ref(const h16* __restrict__ A, const float* __restrict__ Bm, int ldb, int col0, int ncols, int K, float* __restrict__ C) {
    __shared__ float sA[16][17], sB[16][17];
    const int tx = threadIdx.x & 15, ty = threadIdx.x >> 4;
    const int n = blockIdx.x * 16 + tx, m = blockIdx.y * 16 + ty;
    float acc = 0.f;
    for (int k0 = 0; k0 < K; k0 += 16) {
        sA[ty][tx] = (float)A[(size_t)m * K + k0 + tx];
        const int nn = blockIdx.x * 16 + tx;
        sB[ty][tx] = nn < ncols ? (float)(h16)Bm[(size_t)(k0 + ty) * ldb + col0 + nn] : 0.f;
        __syncthreads();
#pragma unroll
        for (int k = 0; k < 16; ++k) acc += sA[ty][k] * sB[k][tx];
        __syncthreads();
    }
    if (n < ncols) C[(size_t)m * ncols + n] = acc;
}
__global__ void __launch_bounds__(256) k_post(const float* __restrict__ C, int ncols, int mode, const float* __restrict__ gain, float scale, h16* __restrict__ O, float* __restrict__ O32, int ldo) {
    const size_t idx = (size_t)blockIdx.x * 256 + threadIdx.x;
    const int m = (int)(idx / ncols), n = (int)(idx % ncols);
    if (m >= MTOK) return;
    const float v = C[idx];
    if (mode == 0) O[(size_t)m * ldo + n] = (h16)(v * scale);
    else if (mode == 2) O[(size_t)m * ldo + n] = (h16)(v / (1.f + __expf(-v)));
    else if (mode == 3) O32[(size_t)m * ldo + n] = v * scale;
    else {
        const float* hp = C + (size_t)m * ncols + (n & ~63); float s = 0.f;
        for (int j = 0; j < 64; ++j) s += hp[j] * hp[j];
        O[(size_t)m * ldo + n] = (h16)(v * rsqrtf(s * (1.f / 64.f) + RMS_EPS) * gain[n & 63] * scale);
    }
}
__device__ __forceinline__ unsigned fkey(float f) { const unsigned u = __float_as_uint(f); return (u & 0x80000000u) ? ~u : (u | 0x80000000u); }
__global__ void __launch_bounds__(256) k_index_ref(const h16* __restrict__ QI, const h16* __restrict__ KI, const float* __restrict__ WI, unsigned* __restrict__ MASK) {
    __shared__ float sq[1024]; __shared__ float sw[16]; __shared__ unsigned sk[2048]; __shared__ unsigned sm[64];
    const int row = blockIdx.x, b = row / SEQ, t = row % SEQ, tid = threadIdx.x;
    for (int i = tid; i < 1024; i += 256) sq[i] = (float)QI[(size_t)row * 1024 + i];
    if (tid < 16) sw[tid] = WI[(size_t)row * 16 + tid];
    if (tid < 64) sm[tid] = 0u;
    __syncthreads();
    for (int s = tid; s <= t; s += 256) {
        const h16* kp = KI + (size_t)(b * SEQ + s) * 64;
        float sc = 0.f;
        for (int h = 0; h < 16; ++h) { float d = 0.f;
            for (int j = 0; j < 64; ++j) d += sq[h * 64 + j] * (float)kp[j];
            sc += sw[h] * fmaxf(d, 0.f); }
        sk[s] = fkey(sc);
    }
    __syncthreads();
    for (int s = tid; s <= t; s += 256) {
        bool sel = true;
        if (t >= TOPK) { const unsigned me = sk[s]; int rank = 0;
            for (int j = 0; j <= t; ++j) { const unsigned o = sk[j]; rank += (o > me || (o == me && j < s)) ? 1 : 0; }
            sel = rank < TOPK; }
        if (sel) atomicOr(&sm[s >> 5], 1u << (s & 31));
    }
    __syncthreads();
    if (tid < 64) MASK[((size_t)b * 64 + tid) * SEQ + t] = sm[tid];
}
__global__ void __launch_bounds__(256) k_attnA_ref(const h16* __restrict__ QA, const h16* __restrict__ KA, const h16* __restrict__ VA, const h16* __restrict__ GA,
                                                   const unsigned* __restrict__ MASK, const float* __restrict__ rel_bias, h16* __restrict__ MIX) {
    __shared__ float sp[2048]; __shared__ float sq[64]; __shared__ float red[256]; __shared__ float so[4][64];
    const int row = blockIdx.x, b = row / SEQ, t = row % SEQ, tid = threadIdx.x;
    for (int h = 0; h < 8; ++h) {
        if (tid < 64) sq[tid] = (float)QA[(size_t)row * 512 + h * 64 + tid];
        __syncthreads();
        float mx = -INFINITY;
        for (int s = tid; s <= t; s += 256) {
            const unsigned w = MASK[((size_t)b * 64 + (s >> 5)) * SEQ + t];
            float lg = -INFINITY;
            if ((w >> (s & 31)) & 1u) { const h16* kp = KA + (size_t)(b * SEQ + s) * 512 + h * 64; float d = 0.f;
                for (int j = 0; j < 64; ++j) d += sq[j] * (float)kp[j];
                const int dist = t - s; const int bk = T5_BUCKET[dist < 127 ? dist : 127];
                lg = d + rel_bias[bk * 8 + h] * LOG2E; }
            sp[s] = lg; mx = fmaxf(mx, lg);
        }
        red[tid] = mx; __syncthreads();
        for (int o = 128; o > 0; o >>= 1) { if (tid < o) red[tid] = fmaxf(red[tid], red[tid + o]); __syncthreads(); }
        mx = red[0]; __syncthreads();
        float sum = 0.f;
        for (int s = tid; s <= t; s += 256) { const float p = exp2f(sp[s] - mx); sp[s] = p; sum += p; }
        red[tid] = sum; __syncthreads();
        for (int o = 128; o > 0; o >>= 1) { if (tid < o) red[tid] += red[tid + o]; __syncthreads(); }
        sum = red[0]; __syncthreads();
        const int d = tid & 63, part = tid >> 6; float acc = 0.f;
        for (int s = part; s <= t; s += 4) { const float p = sp[s]; if (p != 0.f) acc += p * (float)VA[(size_t)(b * SEQ + s) * 512 + h * 64 + d]; }
        so[part][d] = acc; __syncthreads();
        if (tid < 64) { const float o = (so[0][tid] + so[1][tid] + so[2][tid] + so[3][tid]) / sum;
            MIX[(size_t)row * 1024 + h * 64 + tid] = (h16)(o * (float)GA[(size_t)row * 512 + h * 64 + tid]); }
        __syncthreads();
    }
}
__global__ void __launch_bounds__(256) k_attnB_ref(const h16* __restrict__ QB, const h16* __restrict__ KB, const h16* __restrict__ VB, const h16* __restrict__ GB, h16* __restrict__ MIX) {
    __shared__ float sz[2048]; __shared__ float sa[2048]; __shared__ float sq[64]; __shared__ float so[4][64];
    const int row = blockIdx.x, b = row / SEQ, t = row % SEQ, tid = threadIdx.x;
    for (int h = 0; h < 8; ++h) {
        if (tid < 64) sq[tid] = (float)QB[(size_t)row * 512 + h * 64 + tid];
        __syncthreads();
        for (int s = tid; s < t; s += 256) { const h16* kp = KB + (size_t)(b * SEQ + s) * 512 + h * 64; float d = 0.f;
            for (int j = 0; j < 64; ++j) d += sq[j] * (float)kp[j];
            sz[s] = d; }
        __syncthreads();
        if (tid == 0) { float c = 0.f;
            for (int s = t - 1; s >= 0; --s) { const float z = sz[s]; const float l = (z > 30.f) ? z : log2f(1.f + exp2f(z)); c += l; sa[s] = exp2f(z - c); } }
        __syncthreads();
        const int d = tid & 63, part = tid >> 6; float acc = 0.f;
        for (int s = part; s < t; s += 4) acc += sa[s] * (float)VB[(size_t)(b * SEQ + s) * 512 + h * 64 + d];
        so[part][d] = acc; __syncthreads();
        if (tid < 64) { const float o = so[0][tid] + so[1][tid] + so[2][tid] + so[3][tid];
            MIX[(size_t)row * 1024 + 512 + h * 64 + tid] = (h16)(o * (float)GB[(size_t)row * 512 + h * 64 + tid]); }
        __syncthreads();
    }
}
__global__ void __launch_bounds__(256) k_out_ref(const float* __restrict__ C, const float* __restrict__ x, float* __restrict__ out) {
    const size_t idx = (size_t)blockIdx.x * 256 + threadIdx.x;
    out[idx] = x[idx] + C[idx];
}

extern "C" void kernel_launch(void* const* d_in, const int* in_sizes, int n_in, void* d_out, int out_size, void* d_ws, size_t ws_size, hipStream_t stream) {
    const float* x = (const float*)d_in[0]; const float* norm_gain = (const float*)d_in[1]; const float* w_in = (const float*)d_in[2];
    const float* qg = (const float*)d_in[3]; const float* kg = (const float*)d_in[4]; const float* rel_bias = (const float*)d_in[5]; const float* w_out = (const float*)d_in[6];
    char* ws = (char*)d_ws; float* out = (float*)d_out;
    h16* HN = (h16*)(ws + WS_HN);
    h16 *QA = (h16*)(ws + WS_QA), *KA = (h16*)(ws + WS_KA), *VA = (h16*)(ws + WS_VA), *GA = (h16*)(ws + WS_GA), *QI = (h16*)(ws + WS_QI), *KI = (h16*)(ws + WS_KI);
    float* WI = (float*)(ws + WS_WI);
    h16 *QB = (h16*)(ws + WS_QB), *KB = (h16*)(ws + WS_KB), *VB = (h16*)(ws + WS_VB), *GB = (h16*)(ws + WS_GB), *MIX = (h16*)(ws + WS_MIX);
    unsigned* MASK = (unsigned*)(ws + WS_MASK);
    float* C32 = out;
    k_rmsnorm<<<MTOK / 4, 256, 0, stream>>>(x, norm_gain, HN);
    struct Seg { int col0, ncols, mode; const float* gain; float scale; h16* O; float* O32; int ldo; };
    const Seg segs[11] = {
        {C_QA, 512, 1, qg, QSCALE, QA, nullptr, 512}, {C_KA, 512, 1, kg, 1.f, KA, nullptr, 512}, {C_VA, 512, 0, nullptr, 1.f, VA, nullptr, 512}, {C_GA, 512, 2, nullptr, 1.f, GA, nullptr, 512},
        {C_QI, 1024, 0, nullptr, 1.f, QI, nullptr, 1024}, {C_KI, 64, 0, nullptr, 1.f, KI, nullptr, 64}, {C_WI, 16, 3, nullptr, IDXS, nullptr, WI, 16},
        {C_QB, 512, 0, nullptr, QSCALE, QB, nullptr, 512}, {C_KB, 512, 0, nullptr, 1.f, KB, nullptr, 512}, {C_VB, 512, 0, nullptr, 1.f, VB, nullptr, 512}, {C_GB, 512, 2, nullptr, 1.f, GB, nullptr, 512}};
    for (int i = 0; i < 11; ++i) { const Seg& s = segs[i];
        k_gemm_ref<<<dim3((s.ncols + 15) / 16, MTOK / 16), 256, 0, stream>>>(HN, w_in, NPROJ, s.col0, s.ncols, DM, C32);
        k_post<<<(unsigned)(((size_t)MTOK * s.ncols + 255) / 256), 256, 0, stream>>>(C32, s.ncols, s.mode, s.gain, s.scale, s.O, s.O32, s.ldo); }
    k_index_ref<<<MTOK, 256, 0, stream>>>(QI, KI, WI, MASK);
    k_attnA_ref<<<MTOK, 256, 0, stream>>>(QA, KA, VA, GA, MASK, rel_bias, MIX);
    k_attnB_ref<<<MTOK, 256, 0, stream>>>(QB, KB, VB, GB, MIX);
    float* C2 = (float*)(ws + WS_QA);
    k_gemm_ref<<<dim3(DM / 16, MTOK / 16), 256, 0, stream>>>(MIX, w_out, DM, 0, DM, DM, C2);
    k_out_ref<<<MTOK * DM / 256, 256, 0, stream>>>(C2, x, out);
}
```

```cpp
#define HYB 7
#include <hip/hip_runtime.h>
#include <stdint.h>

typedef _Float16 h16;

constexpr int NB = 8, SEQ = 2048, DM = 1024, MTOK = NB * SEQ;
constexpr int NPROJ = 5200;
constexpr float LOG2E = 1.4426950408889634f;
constexpr float QSCALE = 0.125f * LOG2E;
constexpr float IDXS = 0.03125f;
constexpr float RMS_EPS = 1e-6f;
constexpr int TOPK = 256;
constexpr int C_QA = 0, C_KA = 512, C_VA = 1024, C_GA = 1536, C_QI = 2048, C_KI = 3072, C_WI = 3136, C_QB = 3152, C_KB = 3664, C_VB = 4176, C_GB = 4688;

constexpr size_t MiB = 1u << 20;
constexpr size_t WS_CTL = 0, WS_HN = 1 * MiB, WS_W1T = 33 * MiB, WS_W2T = 44 * MiB;
constexpr size_t WS_QA = 46 * MiB, WS_KA = 62 * MiB, WS_VA = 78 * MiB, WS_GA = 94 * MiB, WS_QI = 110 * MiB, WS_KI = 142 * MiB, WS_WI = 144 * MiB;
constexpr size_t WS_QB = 145 * MiB, WS_KB = 161 * MiB, WS_VB = 177 * MiB, WS_GB = 193 * MiB, WS_MASK = 209 * MiB, WS_MIX = 213 * MiB, WS_FREE = 245 * MiB;

__device__ const unsigned char T5_BUCKET[128] = {0, 1, 2, 3, 4, 5, 6, 7, 8, 9, 10, 11, 12, 13, 14, 15, 16, 16, 16, 17, 17, 18, 18, 18, 19, 19, 19, 20, 20, 20, 20, 21, 21, 21, 21, 22, 22, 22, 22, 22, 23, 23, 23, 23, 23, 23, 24, 24, 24, 24, 24, 24, 25, 25, 25, 25, 25, 25, 25, 26, 26, 26, 26, 26, 26, 26, 26, 27, 27, 27, 27, 27, 27, 27, 27, 27, 27, 28, 28, 28, 28, 28, 28, 28, 28, 28, 28, 29, 29, 29, 29, 29, 29, 29, 29, 29, 29, 29, 29, 30, 30, 30, 30, 30, 30, 30, 30, 30, 30, 30, 30, 30, 30, 31, 31, 31, 31, 31, 31, 31, 31, 31, 31, 31, 31, 31, 31, 31};

__device__ __forceinline__ float wave_sum(float v) {
#pragma unroll
    for (int o = 1; o < 64; o <<= 1) v += __shfl_xor(v, o);
    return v;
}
__global__ void __launch_bounds__(256) k_rmsnorm(const float* __restrict__ x, const float* __restrict__ gain, h16* __restrict__ HN) {
    const int row = blockIdx.x * 4 + (threadIdx.x >> 6), lane = threadIdx.x & 63;
    const float4* xr = (const float4*)(x + (size_t)row * DM);
    float4 v[4]; float s = 0.f;
#pragma unroll
    for (int j = 0; j < 4; ++j) { v[j] = xr[lane + 64 * j]; s += v[j].x * v[j].x + v[j].y * v[j].y + v[j].z * v[j].z + v[j].w * v[j].w; }
    const float r = rsqrtf(wave_sum(s) * (1.f / DM) + RMS_EPS);
#pragma unroll
    for (int j = 0; j < 4; ++j) {
        const float4 g = ((const float4*)gain)[lane + 64 * j];
        h16* o = HN + (size_t)row * DM + 4 * (lane + 64 * j);
        o[0] = (h16)(v[j].x * r * g.x); o[1] = (h16)(v[j].y * r * g.y); o[2] = (h16)(v[j].z * r * g.z); o[3] = (h16)(v[j].w * r * g.w);
    }
}
__global__ void __launch_bounds__(256) k_gemm_ref(const h16* __restrict__ A, const float* __restrict__ Bm, int ldb, int col0, int ncols, int K, float* __restrict__ C) {
    __shared__ float sA[16][17], sB[16][17];
    const int tx = threadIdx.x & 15, ty = threadIdx.x >> 4;
    const int n = blockIdx.x * 16 + tx, m = blockIdx.y * 16 + ty;
    float acc = 0.f;
    for (int k0 = 0; k0 < K; k0 += 16) {
        sA[ty][tx] = (float)A[(size_t)m * K + k0 + tx];
        const int nn = blockIdx.x * 16 + tx;
        sB[ty][tx] = nn < ncols ? (float)(h16)Bm[(size_t)(k0 + ty) * ldb + col0 + nn] : 0.f;
        __syncthreads();
#pragma unroll
        for (int k = 0; k < 16; ++k) acc += sA[ty][k] * sB[k][tx];
        __syncthreads();
    }
    if (n < ncols) C[(size_t)m * ncols + n] = acc;
}
__global__ void __launch_bounds__(256) k_post(const float* __restrict__ C, int ncols, int mode, const float* __restrict__ gain, float scale, h16* __restrict__ O, float* __restrict__ O32, int ldo) {
    const size_t idx = (size_t)blockIdx.x * 256 + threadIdx.x;
    const int m = (int)(idx / ncols), n = (int)(idx % ncols);
    if (m >= MTOK) return;
    const float v = C[idx];
    if (mode == 0) O[(size_t)m * ldo + n] = (h16)(v * scale);
    else if (mode == 2) O[(size_t)m * ldo + n] = (h16)(v / (1.f + __expf(-v)));
    else if (mode == 3) O32[(size_t)m * ldo + n] = v * scale;
    else {
        const float* hp = C + (size_t)m * ncols + (n & ~63); float s = 0.f;
        for (int j = 0; j < 64; ++j) s += hp[j] * hp[j];
        O[(size_t)m * ldo + n] = (h16)(v * rsqrtf(s * (1.f / 64.f) + RMS_EPS) * gain[n & 63] * scale);
    }
}
__device__ __forceinline__ unsigned fkey(float f) { const unsigned u = __float_as_uint(f); return (u & 0x80000000u) ? ~u : (u | 0x80000000u); }
__global__ void __launch_bounds__(256) k_index_ref(const h16* __restrict__ QI, const h16* __restrict__ KI, const float* __restrict__ WI, unsigned* __restrict__ MASK) {
    __shared__ float sq[1024]; __shared__ float sw[16]; __shared__ unsigned sk[2048]; __shared__ unsigned sm[64];
    const int row = blockIdx.x, b = row / SEQ, t = row % SEQ, tid = threadIdx.x;
    for (int i = tid; i < 1024; i += 256) sq[i] = (float)QI[(size_t)row * 1024 + i];
    if (tid < 16) sw[tid] = WI[(size_t)row * 16 + tid];
    if (tid < 64) sm[tid] = 0u;
    __syncthreads();
    for (int s = tid; s <= t; s += 256) {
        const h16* kp = KI + (size_t)(b * SEQ + s) * 64;
        float sc = 0.f;
        for (int h = 0; h < 16; ++h) { float d = 0.f;
            for (int j = 0; j < 64; ++j) d += sq[h * 64 + j] * (float)kp[j];
            sc += sw[h] * fmaxf(d, 0.f); }
        sk[s] = fkey(sc);
    }
    __syncthreads();
    for (int s = tid; s <= t; s += 256) {
        bool sel = true;
        if (t >= TOPK) { const unsigned me = sk[s]; int rank = 0;
            for (int j = 0; j <= t; ++j) { const unsigned o = sk[j]; rank += (o > me || (o == me && j < s)) ? 1 : 0; }
            sel = rank < TOPK; }
        if (sel) atomicOr(&sm[s >> 5], 1u << (s & 31));
    }
    __syncthreads();
    if (tid < 64) MASK[((size_t)b * 64 + tid) * SEQ + t] = sm[tid];
}
__global__ void __launch_bounds__(256) k_attnA_ref(const h16* __restrict__ QA, const h16* __restrict__ KA, const h16* __restrict__ VA, const h16* __restrict__ GA,
                                                   const unsigned* __restrict__ MASK, const float* __restrict__ rel_bias, h16* __restrict__ MIX) {
    __shared__ float sp[2048]; __shared__ float sq[64]; __shared__ float red[256]; __shared__ float so[4][64];
    const int row = blockIdx.x, b = row / SEQ, t = row % SEQ, tid = threadIdx.x;
    for (int h = 0; h < 8; ++h) {
        if (tid < 64) sq[tid] = (float)QA[(size_t)row * 512 + h * 64 + tid];
        __syncthreads();
        float mx = -INFINITY;
        for (int s = tid; s <= t; s += 256) {
            const unsigned w = MASK[((size_t)b * 64 + (s >> 5)) * SEQ + t];
            float lg = -INFINITY;
            if ((w >> (s & 31)) & 1u) { const h16* kp = KA + (size_t)(b * SEQ + s) * 512 + h * 64; float d = 0.f;
                for (int j = 0; j < 64; ++j) d += sq[j] * (float)kp[j];
                const int dist = t - s; const int bk = T5_BUCKET[dist < 127 ? dist : 127];
                lg = d + rel_bias[bk * 8 + h] * LOG2E; }
            sp[s] = lg; mx = fmaxf(mx, lg);
        }
        red[tid] = mx; __syncthreads();
        for (int o = 128; o > 0; o >>= 1) { if (tid < o) red[tid] = fmaxf(red[tid], red[tid + o]); __syncthreads(); }
        mx = red[0]; __syncthreads();
        float sum = 0.f;
        for (int s = tid; s <= t; s += 256) { const float p = exp2f(sp[s] - mx); sp[s] = p; sum += p; }
        red[tid] = sum; __syncthreads();
        for (int o = 128; o > 0; o >>= 1) { if (tid < o) red[tid] += red[tid + o]; __syncthreads(); }
        sum = red[0]; __syncthreads();
        const int d = tid & 63, part = tid >> 6; float acc = 0.f;
        for (int s = part; s <= t; s += 4) { const float p = sp[s]; if (p != 0.f) acc += p * (float)VA[(size_t)(b * SEQ + s) * 512 + h * 64 + d]; }
        so[part][d] = acc; __syncthreads();
        if (tid < 64) { const float o = (so[0][tid] + so[1][tid] + so[2][tid] + so[3][tid]) / sum;
            MIX[(size_t)row * 1024 + h * 64 + tid] = (h16)(o * (float)GA[(size_t)row * 512 + h * 64 + tid]); }
        __syncthreads();
    }
}
__global__ void __launch_bounds__(256) k_attnB_ref(const h16* __restrict__ QB, const h16* __restrict__ KB, const h16* __restrict__ VB, const h16* __restrict__ GB, h16* __restrict__ MIX) {
    __shared__ float sz[2048]; __shared__ float sa[2048]; __shared__ float sq[64]; __shared__ float so[4][64];
    const int row = blockIdx.x, b = row / SEQ, t = row % SEQ, tid = threadIdx.x;
    for (int h = 0; h < 8; ++h) {
        if (tid < 64) sq[tid] = (float)QB[(size_t)row * 512 + h * 64 + tid];
        __syncthreads();
        for (int s = tid; s < t; s += 256) { const h16* kp = KB + (size_t)(b * SEQ + s) * 512 + h * 64; float d = 0.f;
            for (int j = 0; j < 64; ++j) d += sq[j] * (float)kp[j];
            sz[s] = d; }
        __syncthreads();
        if (tid == 0) { float c = 0.f;
            for (int s = t - 1; s >= 0; --s) { const float z = sz[s]; const float l = (z > 30.f) ? z : log2f(1.f + exp2f(z)); c += l; sa[s] = exp2f(z - c); } }
        __syncthreads();
        const int d = tid & 63, part = tid >> 6; float acc = 0.f;
        for (int s = part; s < t; s += 4) acc += sa[s] * (float)VB[(size_t)(b * SEQ + s) * 512 + h * 64 + d];
        so[part][d] = acc; __syncthreads();
        if (tid < 64) { const float o = so[0][tid] + so[1][tid] + so[2][tid] + so[3][tid];
            MIX[(size_t)row * 1024 + 512 + h * 64 + tid] = (h16)(o * (float)GB[(size_t)row * 512 + h * 64 + tid]); }
        __syncthreads();
    }
}
__global__ void __launch_bounds__(256) k_out_ref(const float* __restrict__ C, const float* __restrict__ x, float* __restrict__ out) {
    const size_t idx = (size_t)blockIdx.x * 256 + threadIdx.x;
    out[idx] = x[idx] + C[idx];
}

#define LAS __attribute__((address_space(3)))
typedef _Float16 h16x8 __attribute__((ext_vector_type(8)));
typedef _Float16 h16x4 __attribute__((ext_vector_type(4)));
typedef _Float16 h16x2 __attribute__((ext_vector_type(2)));
typedef float f32x2 __attribute__((ext_vector_type(2)));
typedef float f32x4 __attribute__((ext_vector_type(4)));
typedef float f32x16 __attribute__((ext_vector_type(16)));
typedef unsigned u32x4 __attribute__((ext_vector_type(4)));
typedef unsigned u32x2 __attribute__((ext_vector_type(2)));
typedef short s16x4 __attribute__((ext_vector_type(4)));

constexpr int NTHR = 512, NWAVE = 8;
constexpr int N1PAD = 5376;
constexpr int LDS_BYTES = 147456;

struct Params {
    const float *x, *norm_gain, *w_in, *qg, *kg, *rel_bias, *w_out;
    float* out; unsigned char* ws;
};

__device__ __forceinline__ unsigned pk2h(float lo, float hi) { f32x2 v = {lo, hi}; h16x2 h = __builtin_convertvector(v, h16x2); return __builtin_bit_cast(unsigned, h); }

__host__ __device__ __forceinline__ int phys_of_logical(int lt) { const int wc = lt >> 6, fq = (lt >> 4) & 3, bj = (lt >> 3) & 1, n = (lt >> 2) & 1, reg = lt & 3; return 128 * bj + 32 * wc + 16 * n + 4 * fq + reg; }
__host__ __device__ __forceinline__ int w1_row_of_col(int c) {
    int pn, lt;
    if (c < 3072) { pn = c >> 8; lt = c & 255; } else if (c < 3152) { pn = 20; lt = c - 3072; } else { const int cc = c - 3152; pn = 12 + (cc >> 8); lt = cc & 255; }
    return 256 * pn + phys_of_logical(lt);
}

namespace pg8 {
constexpr int BM = 256, BK = 64, HALF = 128, HTB = HALF * BK * 2, STAGE_BYTES = 8 * HTB, NXCD = 8, WGM = 8;
__host__ __device__ __forceinline__ int lds_byte(int r, int c) { const int st = (r >> 4) * 2 + (c >> 5), rr = r & 15, cc = c & 31, ob = rr * 64 + cc * 2; return st * 1024 + (ob ^ (((ob >> 9) & 1) << 5)); }
__host__ __device__ __forceinline__ void stage_rc(int b, int& R, int& C) { const int st = b / 1024, sb = b % 1024, swz = sb ^ (((sb >> 9) & 1) << 5); R = (st >> 1) * 16 + swz / 64; C = (st & 1) * 32 + (swz % 64) / 2; }
struct Unit { int pm, pn; };
struct Gemm { const h16* A; const h16* Bt; int M, N, K; };
struct StaticOrder {
    int nM, nN, nwg, G, c;
    __host__ __device__ void init(int M, int N, int G_, int c_) { nM = M / BM; nN = N / BM; nwg = nM * nN; G = G_; c = c_; }
    __host__ __device__ bool next(int i, Unit& u) const {
        const long L = (long)i * G + c; if (L >= nwg) return false;
        int wgid = (int)L; { const int q = nwg / NXCD, r = nwg % NXCD, xcd = wgid % NXCD, off = wgid / NXCD; wgid = (xcd < r ? xcd * (q + 1) : r * (q + 1) + (xcd - r) * q) + off; }
        const int nig = WGM * nN, gid = wgid / nig, fm = gid * WGM, gsz = (nM - fm) < WGM ? (nM - fm) : WGM;
        u.pm = fm + ((wgid % nig) % gsz); u.pn = (wgid % nig) / gsz; return true;
    }
};
template <class Epi, class Sched, bool ALIGN_EPI = false, bool SP2 = false>
__device__ __forceinline__ void gemm_phase(LAS unsigned char* lds, const Gemm g, const Sched& S, const Epi& E) {
    const int tid = threadIdx.x, wid = __builtin_amdgcn_readfirstlane(tid >> 6), lane = tid & 63, wr = wid >> 2, wc = wid & 3, fr = lane & 15, fq = lane >> 4;
    const int K = g.K, nt = K / BK;
    unsigned voffA[2], voffB[2];
#pragma unroll
    for (int i = 0; i < 2; ++i) { int R, C; stage_rc(tid * 16 + i * 8192, R, C); voffA[i] = (unsigned)(R * K + C) * 2u; voffB[i] = (unsigned)(R * K + C) * 2u; }
    const size_t kstep = (size_t)(BK * 2);
    const size_t hstep = (size_t)HALF * K * 2;
    const size_t tstep = 2 * hstep;
    const unsigned ldsw = (unsigned)wid * 1024u;
    const int aoff = lds_byte(wr * 64 + fr, fq * 8), boff = lds_byte(wc * 32 + fr, fq * 8);
#define PG8_SA(b, h) (((b) * 2 + (h)) * HTB)
#define PG8_SB(b, h) ((4 + (b) * 2 + (h)) * HTB)
#define PG8_STAGE(bufoff, gbase, voff) do { _Pragma("unroll") for (int _i = 0; _i < 2; ++_i) \
        __builtin_amdgcn_global_load_lds((const unsigned*)((const char*)(gbase) + (voff)[_i]), (LAS unsigned*)(lds + (bufoff) + ldsw + _i * 8192), 16, 0, 0); } while (0)
#define PG8_LDA(dst, b, h) do { _Pragma("unroll") for (int m = 0; m < 4; ++m) _Pragma("unroll") for (int k = 0; k < 2; ++k) dst[m][k] = *(const LAS h16x8*)(lds + PG8_SA(b, h) + aoff + m * 2048 + k * 1024); } while (0)
#define PG8_LDB(dst, b, h) do { _Pragma("unroll") for (int n = 0; n < 2; ++n) _Pragma("unroll") for (int k = 0; k < 2; ++k) dst[n][k] = *(const LAS h16x8*)(lds + PG8_SB(b, h) + boff + n * 2048 + k * 1024); } while (0)
#define PG8_MMA(ai, bj, At, Bt) do { __builtin_amdgcn_s_setprio(1); _Pragma("unroll") for (int m = 0; m < 4; ++m) _Pragma("unroll") for (int n = 0; n < 2; ++n) _Pragma("unroll") for (int k = 0; k < 2; ++k) \
        acc[ai][bj][m][n] = __builtin_amdgcn_mfma_f32_16x16x32_f16(Bt[n][k], At[m][k], acc[ai][bj][m][n], 0, 0, 0); __builtin_amdgcn_s_setprio(0); } while (0)
#define PG8_WAIT_V(n) asm volatile("s_waitcnt vmcnt(" #n ")" ::: "memory")
#define PG8_WAIT_L(n) asm volatile("s_waitcnt lgkmcnt(" #n ")" ::: "memory")
#define PG8_BAR __builtin_amdgcn_s_barrier()
#define PG8_SCHED __builtin_amdgcn_sched_barrier(0)
    Unit cur, nxt; int ui = 0;
    if (!S.next(0, cur)) return;
    f32x4 acc[2][2][4][2];
#pragma unroll
    for (int a = 0; a < 2; ++a)
#pragma unroll
        for (int b = 0; b < 2; ++b)
#pragma unroll
            for (int m = 0; m < 4; ++m)
#pragma unroll
                for (int n = 0; n < 2; ++n) acc[a][b][m][n] = (f32x4){0.f, 0.f, 0.f, 0.f};
    h16x8 At[4][2], B0[2][2], B1[2][2];
    const char* cA = (const char*)g.A + (size_t)cur.pm * tstep; const char* cB = (const char*)g.Bt + (size_t)cur.pn * tstep;
    if constexpr (SP2) {
        PG8_STAGE(PG8_SB(0, 0), cB, voffB); PG8_STAGE(PG8_SB(0, 1), cB + hstep, voffB); PG8_STAGE(PG8_SA(0, 0), cA, voffA); PG8_STAGE(PG8_SA(0, 1), cA + hstep, voffA);
        if (wr == 1) PG8_BAR;
        PG8_WAIT_V(2); PG8_BAR;
        PG8_STAGE(PG8_SB(1, 0), cB + kstep, voffB); PG8_STAGE(PG8_SA(1, 0), cA + kstep, voffA); PG8_STAGE(PG8_SB(1, 1), cB + hstep + kstep, voffB);
        PG8_WAIT_V(6); PG8_BAR;
    } else {
        PG8_STAGE(PG8_SB(0, 0), cB, voffB); PG8_STAGE(PG8_SA(0, 0), cA, voffA); PG8_STAGE(PG8_SB(0, 1), cB + hstep, voffB); PG8_STAGE(PG8_SA(0, 1), cA + hstep, voffA);
        if (wr == 1) PG8_BAR;
        PG8_WAIT_V(4); PG8_BAR;
        PG8_STAGE(PG8_SB(1, 0), cB + kstep, voffB); PG8_STAGE(PG8_SA(1, 0), cA + kstep, voffA); PG8_STAGE(PG8_SB(1, 1), cB + hstep + kstep, voffB);
        PG8_WAIT_V(6); PG8_BAR;
    }
    for (;;) {
        const bool has_next = S.next(ui + 1, nxt);
        const char* nA = has_next ? (const char*)g.A + (size_t)nxt.pm * tstep : cA; const char* nB = has_next ? (const char*)g.Bt + (size_t)nxt.pn * tstep : cB;
        for (int t = 0; t < nt; t += 2) {
            const bool last = (t == nt - 2);
            const char* a1 = cA + (size_t)(t + 1) * kstep;
            const char* a2 = last ? nA : cA + (size_t)(t + 2) * kstep; const char* b2 = last ? nB : cB + (size_t)(t + 2) * kstep;
            const char* a3 = a2 + kstep; const char* b3 = b2 + kstep;
            if constexpr (SP2) {
            PG8_LDB(B0, 0, 0); PG8_LDB(B1, 0, 1); PG8_SCHED; PG8_LDA(At, 0, 0); PG8_STAGE(PG8_SA(1, 1), a1 + hstep, voffA);
            PG8_WAIT_V(8); PG8_WAIT_L(0); PG8_BAR; PG8_MMA(0, 0, At, B0); PG8_MMA(0, 1, At, B1); PG8_BAR; PG8_SCHED;
            PG8_LDA(At, 0, 1); PG8_STAGE(PG8_SB(0, 0), b2, voffB); PG8_STAGE(PG8_SB(0, 1), b2 + hstep, voffB); PG8_STAGE(PG8_SA(0, 0), a2, voffA);
            PG8_WAIT_V(8); PG8_WAIT_L(0); PG8_BAR; PG8_MMA(1, 0, At, B0); PG8_MMA(1, 1, At, B1); PG8_BAR; PG8_SCHED;
            PG8_LDB(B0, 1, 0); PG8_LDB(B1, 1, 1); PG8_SCHED; PG8_LDA(At, 1, 0); PG8_STAGE(PG8_SA(0, 1), a2 + hstep, voffA);
            PG8_WAIT_V(8); PG8_WAIT_L(0); PG8_BAR; PG8_MMA(0, 0, At, B0); PG8_MMA(0, 1, At, B1); PG8_BAR; PG8_SCHED;
            PG8_LDA(At, 1, 1); PG8_STAGE(PG8_SB(1, 0), b3, voffB); PG8_STAGE(PG8_SB(1, 1), b3 + hstep, voffB); PG8_STAGE(PG8_SA(1, 0), a3, voffA);
            PG8_WAIT_V(8); PG8_WAIT_L(0); PG8_BAR; PG8_MMA(1, 0, At, B0); PG8_MMA(1, 1, At, B1); PG8_BAR; PG8_SCHED;
            } else {
            PG8_LDB(B0, 0, 0); PG8_SCHED; PG8_LDA(At, 0, 0); PG8_STAGE(PG8_SA(1, 1), a1 + hstep, voffA);
            PG8_WAIT_L(8); PG8_BAR; PG8_WAIT_L(0); PG8_MMA(0, 0, At, B0); PG8_BAR; PG8_SCHED;
            PG8_LDB(B1, 0, 1); PG8_STAGE(PG8_SB(0, 0), b2, voffB);
            PG8_BAR; PG8_WAIT_L(0); PG8_MMA(0, 1, At, B1); PG8_BAR;
            PG8_LDA(At, 0, 1); PG8_STAGE(PG8_SA(0, 0), a2, voffA);
            PG8_BAR; PG8_WAIT_L(0); PG8_MMA(1, 0, At, B0); PG8_BAR; PG8_SCHED;
            PG8_STAGE(PG8_SB(0, 1), b2 + hstep, voffB);
            PG8_WAIT_V(6); PG8_BAR; PG8_MMA(1, 1, At, B1); PG8_BAR;
            PG8_LDB(B0, 1, 0); PG8_SCHED; PG8_LDA(At, 1, 0); PG8_STAGE(PG8_SA(0, 1), a2 + hstep, voffA);
            PG8_WAIT_L(8); PG8_BAR; PG8_WAIT_L(0); PG8_MMA(0, 0, At, B0); PG8_BAR; PG8_SCHED;
            PG8_LDB(B1, 1, 1); PG8_STAGE(PG8_SB(1, 0), b3, voffB);
            PG8_BAR; PG8_WAIT_L(0); PG8_MMA(0, 1, At, B1); PG8_BAR;
            PG8_LDA(At, 1, 1); PG8_STAGE(PG8_SA(1, 0), a3, voffA);
            PG8_BAR; PG8_WAIT_L(0); PG8_MMA(1, 0, At, B0); PG8_BAR; PG8_SCHED;
            PG8_STAGE(PG8_SB(1, 1), b3 + hstep, voffB);
            PG8_WAIT_V(6); PG8_BAR; PG8_MMA(1, 1, At, B1); PG8_BAR;
            }
        }
        if constexpr (ALIGN_EPI) { if (wr == 0) PG8_BAR; }
        E(acc, cur, wr, wc, fr, fq);
        if (!has_next) break;
#pragma unroll
        for (int a = 0; a < 2; ++a)
#pragma unroll
            for (int b = 0; b < 2; ++b)
#pragma unroll
                for (int m = 0; m < 4; ++m)
#pragma unroll
                    for (int n = 0; n < 2; ++n) acc[a][b][m][n] = (f32x4){0.f, 0.f, 0.f, 0.f};
        cur = nxt; cA = nA; cB = nB; ++ui;
        if constexpr (ALIGN_EPI) { if (wr == 1) PG8_BAR; }
    }
    PG8_WAIT_V(0);
    if constexpr (!ALIGN_EPI) { if (wr == 0) PG8_BAR; }
    PG8_BAR;
#undef PG8_SA
#undef PG8_SB
#undef PG8_STAGE
#undef PG8_LDA
#undef PG8_LDB
#undef PG8_MMA
#undef PG8_WAIT_V
#undef PG8_WAIT_L
#undef PG8_BAR
#undef PG8_SCHED
}
}

struct EpiProj {
    unsigned char* ws; const float* qg; const float* kg;
    __device__ __forceinline__ void operator()(const f32x4 (&acc)[2][2][4][2], const pg8::Unit& u, int wr, int wc, int fr, int fq) const {
        const int pn = u.pn;
        int kind = 0; float scale = 1.f; const float* gain = nullptr; h16* dst; int ld = 512, tcol = 0;
        if (pn < 8) { const int t = pn >> 1; tcol = (pn & 1) * 256; dst = (h16*)(ws + WS_QA + (size_t)t * (16 * MiB));
            if (t == 0) { kind = 1; gain = qg; scale = QSCALE; } else if (t == 1) { kind = 1; gain = kg; } else if (t == 3) kind = 2; }
        else if (pn < 12) { dst = (h16*)(ws + WS_QI); ld = 1024; tcol = (pn - 8) * 256; }
        else if (pn < 20) { const int t = (pn - 12) >> 1; tcol = (pn & 1) * 256; dst = (h16*)(ws + WS_QB + (size_t)t * (16 * MiB)); if (t == 0) scale = QSCALE; else if (t == 3) kind = 2; }
        else { dst = (h16*)(ws + WS_KI); ld = 64; if (wc > 1 || (wc == 1 && fq != 0)) return; }
        const int col = tcol + 64 * wc + 16 * fq;
        float gv[16];
        if (kind == 1) {
#pragma unroll
            for (int i = 0; i < 16; ++i) gv[i] = gain[16 * fq + i] * scale;
        }
#pragma unroll
        for (int ai = 0; ai < 2; ++ai)
#pragma unroll
            for (int m = 0; m < 4; ++m) {
                const int row = u.pm * 256 + ai * 128 + wr * 64 + m * 16 + fr;
                float v[16];
#pragma unroll
                for (int bj = 0; bj < 2; ++bj)
#pragma unroll
                    for (int n = 0; n < 2; ++n)
#pragma unroll
                        for (int r = 0; r < 4; ++r) v[8 * bj + 4 * n + r] = acc[ai][bj][m][n][r];
                if (pn == 20 && wc == 1) {
                    float* wo = (float*)(ws + WS_WI) + (size_t)row * 16;
#pragma unroll
                    for (int i = 0; i < 4; ++i) *(f32x4*)(wo + 4 * i) = (f32x4){v[4 * i] * IDXS, v[4 * i + 1] * IDXS, v[4 * i + 2] * IDXS, v[4 * i + 3] * IDXS};
                    continue;
                }
                if (kind == 1) {
                    float s = 0.f;
#pragma unroll
                    for (int i = 0; i < 16; ++i) s += v[i] * v[i];
                    s += __shfl_xor(s, 16); s += __shfl_xor(s, 32);
                    const float rs = rsqrtf(s * (1.f / 64.f) + RMS_EPS);
#pragma unroll
                    for (int i = 0; i < 16; ++i) v[i] = v[i] * rs * gv[i];
                } else if (kind == 2) {
#pragma unroll
                    for (int i = 0; i < 16; ++i) v[i] = v[i] * __builtin_amdgcn_rcpf(1.f + __builtin_amdgcn_exp2f(-v[i] * LOG2E));
                } else {
#pragma unroll
                    for (int i = 0; i < 16; ++i) v[i] *= scale;
                }
                h16* o = dst + (size_t)row * ld + col;
                u32x4 w0, w1;
                w0.x = pk2h(v[0], v[1]); w0.y = pk2h(v[2], v[3]); w0.z = pk2h(v[4], v[5]); w0.w = pk2h(v[6], v[7]);
                w1.x = pk2h(v[8], v[9]); w1.y = pk2h(v[10], v[11]); w1.z = pk2h(v[12], v[13]); w1.w = pk2h(v[14], v[15]);
                *(u32x4*)o = w0; *(u32x4*)(o + 8) = w1;
            }
    }
};
struct EpiOut {
    const float* x; float* out;
    __device__ __forceinline__ void operator()(const f32x4 (&acc)[2][2][4][2], const pg8::Unit& u, int wr, int wc, int fr, int fq) const {
        const int col = u.pn * 256 + 64 * wc + 16 * fq;
#pragma unroll
        for (int ai = 0; ai < 2; ++ai)
#pragma unroll
            for (int m = 0; m < 4; ++m) {
                const size_t off = (size_t)(u.pm * 256 + ai * 128 + wr * 64 + m * 16 + fr) * DM + col;
#pragma unroll
                for (int bj = 0; bj < 2; ++bj)
#pragma unroll
                    for (int n = 0; n < 2; ++n) { const f32x4 xv = *(const f32x4*)(x + off + 8 * bj + 4 * n); *(f32x4*)(out + off + 8 * bj + 4 * n) = xv + acc[ai][bj][m][n]; }
            }
    }
};

template <class RowOf>
__device__ __forceinline__ void transpose_item(const float* W, int K, int N, h16* WT, LAS float* scr, int item, int lane, RowOf row_of) {
    const int nblk = (N + 31) / 32, kb = item / nblk, nb = item % nblk, k0 = 64 * kb, n0 = 32 * nb;
    const int nc = n0 + (lane & 31);
#pragma unroll 8
    for (int i = 0; i < 32; ++i) { const int kk = 2 * i + (lane >> 5); scr[kk * 33 + (lane & 31)] = nc < N ? W[(size_t)(k0 + kk) * N + nc] : 0.f; }
    asm volatile("s_waitcnt lgkmcnt(0)" ::: "memory");
    const int c = lane & 7;
#pragma unroll
    for (int j = 0; j < 4; ++j) { const int n = (lane >> 3) + 8 * j; const LAS float* s = scr + (8 * c) * 33 + n;
        u32x4 o; o.x = pk2h(s[0 * 33], s[1 * 33]); o.y = pk2h(s[2 * 33], s[3 * 33]); o.z = pk2h(s[4 * 33], s[5 * 33]); o.w = pk2h(s[6 * 33], s[7 * 33]);
        if (n0 + n < N) *(u32x4*)(WT + (size_t)row_of(n0 + n) * K + k0 + 8 * c) = o; }
    asm volatile("s_waitcnt lgkmcnt(0)" ::: "memory");
}
__device__ __forceinline__ void rms_row(const float* __restrict__ xrow, const float* __restrict__ gain, h16* __restrict__ orow, int lane) {
    const f32x4* xr = (const f32x4*)xrow + lane;
    f32x4 v[4]; float s = 0.f;
#pragma unroll
    for (int j = 0; j < 4; ++j) { v[j] = xr[64 * j]; s += (v[j].x * v[j].x + v[j].y * v[j].y) + (v[j].z * v[j].z + v[j].w * v[j].w); }
    const float r = rsqrtf(wave_sum(s) * (1.f / DM) + RMS_EPS);
    u32x2* o8 = (u32x2*)orow + lane;
#pragma unroll
    for (int j = 0; j < 4; ++j) { const f32x4 g = ((const f32x4*)gain)[lane + 64 * j]; u32x2 w; w.x = pk2h(v[j].x * r * g.x, v[j].y * r * g.y); w.y = pk2h(v[j].z * r * g.z, v[j].w * r * g.w); o8[64 * j] = w; }
}
__device__ __forceinline__ void phase_prologue(const Params& p, LAS unsigned char* lds, int bid, int nblk) {
    const int tid = threadIdx.x, lane = tid & 63, wave = tid >> 6;
    LAS float* scr = (LAS float*)(lds + wave * 16384);
    const int gw = bid * NWAVE + wave, NGW = nblk * NWAVE;
    h16* W1T = (h16*)(p.ws + WS_W1T); h16* W2T = (h16*)(p.ws + WS_W2T); h16* HN = (h16*)(p.ws + WS_HN);
    constexpr int I1 = (DM / 64) * ((NPROJ + 31) / 32), I2 = (DM / 64) * (DM / 32);
    for (int it = gw; it < I1 + I2; it += NGW) {
        if (it < I1) transpose_item(p.w_in, DM, NPROJ, W1T, scr, it, lane, [](int c) { return w1_row_of_col(c); });
        else transpose_item(p.w_out, DM, DM, W2T, scr, it - I1, lane, [](int c) { return (c & ~255) + phys_of_logical(c & 255); });
    }
    for (int m = gw; m < MTOK; m += NGW) rms_row(p.x + (size_t)m * DM, p.norm_gain, HN + (size_t)m * DM, lane);
}
__device__ __forceinline__ void phase_gemm1(const Params& p, LAS unsigned char* lds, int bid, int nblk) {
    pg8::Gemm g{(const h16*)(p.ws + WS_HN), (const h16*)(p.ws + WS_W1T), MTOK, N1PAD, DM};
    pg8::StaticOrder S; S.init(MTOK, N1PAD, nblk, bid);
    EpiProj E{p.ws, p.qg, p.kg};
    pg8::gemm_phase<EpiProj, pg8::StaticOrder, true, true>(lds, g, S, E);
}
__device__ __forceinline__ void phase_gemm2(const Params& p, LAS unsigned char* lds, int bid, int nblk) {
    pg8::Gemm g{(const h16*)(p.ws + WS_MIX), (const h16*)(p.ws + WS_W2T), MTOK, DM, DM};
    pg8::StaticOrder S; S.init(MTOK, DM, nblk, bid);
    EpiOut E{p.x, p.out};
    pg8::gemm_phase<EpiOut, pg8::StaticOrder, true, true>(lds, g, S, E);
}
__device__ __forceinline__ int crow(int r, int hi) { return (r & 3) + 8 * (r >> 2) + 4 * hi; }
constexpr int KSTR = 144, VSTR = 192;
constexpr int KT_BYTES = 64 * KSTR, VT_BYTES = 64 * VSTR;
constexpr int ATT_BUF = KT_BYTES + VT_BYTES;
constexpr int ATT_TAB = 2 * ATT_BUF;
__device__ __forceinline__ s16x4 vtr(LAS const unsigned char* p) { return __builtin_amdgcn_ds_read_tr16_b64_v4i16((LAS s16x4*)p); }
__device__ __forceinline__ h16x8 mk8(s16x4 a, s16x4 b) { typedef short s16x8 __attribute__((ext_vector_type(8))); s16x8 r = {a[0], a[1], a[2], a[3], b[0], b[1], b[2], b[3]}; return __builtin_bit_cast(h16x8, r); }
__device__ __forceinline__ h16x8 pack8(float a0, float a1, float a2, float a3, float a4, float a5, float a6, float a7) {
    u32x4 w; w.x = pk2h(a0, a1); w.y = pk2h(a2, a3); w.z = pk2h(a4, a5); w.w = pk2h(a6, a7); return __builtin_bit_cast(h16x8, w); }

struct KVStage { u32x4 k, v; };
__device__ __forceinline__ void kv_load(KVStage& st, const h16* Kg, const h16* Vg, int tile, int tid) {
    const size_t off = (size_t)(tile * 64 + (tid >> 3)) * 512 + (tid & 7) * 8;
    st.k = *(const u32x4*)(Kg + off); st.v = *(const u32x4*)(Vg + off);
}
__device__ __forceinline__ void kv_store(const KVStage& st, LAS unsigned char* buf, int tid) {
    *(LAS u32x4*)(buf + (tid >> 3) * KSTR + (tid & 7) * 16) = st.k;
    *(LAS u32x4*)(buf + KT_BYTES + (tid >> 3) * VSTR + (tid & 7) * 16) = st.v;
}
__device__ __forceinline__ f32x16 qk_tile(LAS const unsigned char* kb, int sub, const h16x8 (&qf)[4], f32x16 c0, int r32, int hh) {
    LAS const unsigned char* kp = kb + (sub * 32 + r32) * KSTR + hh * 16;
    f32x16 acc = c0;
#pragma unroll
    for (int ks = 0; ks < 4; ++ks) { const h16x8 kf = *(LAS const h16x8*)(kp + ks * 32); acc = __builtin_amdgcn_mfma_f32_32x32x16_f16(kf, qf[ks], acc, 0, 0, 0); }
    return acc;
}
__device__ __forceinline__ void pv_tile(f32x16 (&o)[2], LAS const unsigned char* vb, int sub, const h16x8 (&pa)[2], int lane) {
    const int g = lane >> 4, i = lane & 15, q = i >> 2, pp = i & 3;
    LAS const unsigned char* vp = vb + (sub * 32 + 4 * (g >> 1) + q) * VSTR + (16 * (g & 1) + 4 * pp) * 2;
#pragma unroll
    for (int db = 0; db < 2; ++db)
#pragma unroll
        for (int s2 = 0; s2 < 2; ++s2) {
            const s16x4 lo = vtr(vp + (16 * s2) * VSTR + db * 64), hi = vtr(vp + (16 * s2 + 8) * VSTR + db * 64);
            o[db] = __builtin_amdgcn_mfma_f32_32x32x16_f16(pa[s2], mk8(lo, hi), o[db], 0, 0, 0);
        }
}
__device__ __forceinline__ void att_unit(int u, int& b, int& h, int& qb) { const int bh = u & 63, k = u >> 6; b = bh >> 3; h = bh & 7; qb = 7 - k; }

__device__ __forceinline__ void sb_unit(const Params& p, LAS unsigned char* lds, int b, int h, int qb) {
    const int tid = threadIdx.x, lane = tid & 63, wv = __builtin_amdgcn_readfirstlane(tid >> 6), r32 = lane & 31, hh = lane >> 5;
    const h16* Qg = (const h16*)(p.ws + WS_QB) + (size_t)b * SEQ * 512 + h * 64;
    const h16* Kg = (const h16*)(p.ws + WS_KB) + (size_t)b * SEQ * 512 + h * 64;
    const h16* Vg = (const h16*)(p.ws + WS_VB) + (size_t)b * SEQ * 512 + h * 64;
    const h16* Gg = (const h16*)(p.ws + WS_GB) + (size_t)b * SEQ * 512 + h * 64;
    h16* Og = (h16*)(p.ws + WS_MIX) + (size_t)b * SEQ * 1024 + 512 + h * 64;
    const int q0 = qb * 256, qw = q0 + wv * 32;
    h16x8 qf[4];
#pragma unroll
    for (int ks = 0; ks < 4; ++ks) qf[ks] = *(const h16x8*)(Qg + (size_t)(qw + r32) * 512 + ks * 16 + hh * 8);
    h16x8 tri[2];
#pragma unroll
    for (int s2 = 0; s2 < 2; ++s2)
#pragma unroll
        for (int jj = 0; jj < 8; ++jj) { const int j = 16 * s2 + 8 * (jj >> 2) + 4 * hh + (jj & 3); tri[s2][jj] = (j >= r32) ? (h16)1.0f : (h16)0.0f; }
    f32x16 o[2]; o[0] = f32x16{}; o[1] = f32x16{};
    float carry = 0.f;
    const int jmax = qb * 4 + 3, diag = qw >> 5;
    KVStage st; kv_load(st, Kg, Vg, jmax, tid);
    int cur = 0;
    kv_store(st, lds, tid);
    __syncthreads();
    for (int j = jmax; j >= 0; --j) {
        if (j > 0) kv_load(st, Kg, Vg, j - 1, tid);
        LAS const unsigned char* kb = lds + cur * ATT_BUF; LAS const unsigned char* vb = kb + KT_BYTES;
#pragma unroll
        for (int sub = 1; sub >= 0; --sub) {
            const int si = 2 * j + sub;
            if (si <= diag) {
                f32x16 z = qk_tile(kb, sub, qf, f32x16{}, r32, hh);
                float L[16];
#pragma unroll
                for (int r = 0; r < 16; ++r) { float l = __builtin_amdgcn_logf(1.f + __builtin_amdgcn_exp2f(z[r])); if (si == diag && crow(r, hh) >= r32) l = 0.f; L[r] = l; }
                h16x8 lf[2]; lf[0] = pack8(L[0], L[1], L[2], L[3], L[4], L[5], L[6], L[7]); lf[1] = pack8(L[8], L[9], L[10], L[11], L[12], L[13], L[14], L[15]);
                f32x16 y;
#pragma unroll
                for (int r = 0; r < 16; ++r) y[r] = carry;
                y = __builtin_amdgcn_mfma_f32_32x32x16_f16(tri[0], lf[0], y, 0, 0, 0);
                y = __builtin_amdgcn_mfma_f32_32x32x16_f16(tri[1], lf[1], y, 0, 0, 0);
                float A[16];
#pragma unroll
                for (int r = 0; r < 16; ++r) { float a = __builtin_amdgcn_exp2f(z[r] - y[r]); if (si == diag && crow(r, hh) >= r32) a = 0.f; A[r] = a; }
                { const unsigned y0 = __float_as_uint(y[0]); auto rr = __builtin_amdgcn_permlane32_swap(y0, y0, false, false); carry = __uint_as_float(rr[0]); }
                h16x8 pa[2]; pa[0] = pack8(A[0], A[1], A[2], A[3], A[4], A[5], A[6], A[7]); pa[1] = pack8(A[8], A[9], A[10], A[11], A[12], A[13], A[14], A[15]);
                pv_tile(o, vb, sub, pa, lane);
            }
        }
        if (j > 0) kv_store(st, lds + (cur ^ 1) * ATT_BUF, tid);
        __syncthreads();
        cur ^= 1;
    }
#pragma unroll
    for (int db = 0; db < 2; ++db)
#pragma unroll
        for (int r = 0; r < 16; ++r) { const size_t tok = (size_t)(qw + crow(r, hh)); const int d = 32 * db + r32;
            const float g = (float)Gg[tok * 512 + d]; Og[tok * 1024 + d] = (h16)(o[db][r] * g); }
}
__device__ __forceinline__ void phase_sb(const Params& p, LAS unsigned char* lds, int bid, int nblk) {
    for (int u = bid; u < 512; u += nblk) { int b, h, qb; att_unit(u, b, h, qb); sb_unit(p, lds, b, h, qb); }
}

__device__ __forceinline__ void sa_unit(const Params& p, LAS unsigned char* lds, int b, int h, int qb) {
    const int tid = threadIdx.x, lane = tid & 63, wv = __builtin_amdgcn_readfirstlane(tid >> 6), r32 = lane & 31, hh = lane >> 5;
    const h16* Qg = (const h16*)(p.ws + WS_QA) + (size_t)b * SEQ * 512 + h * 64;
    const h16* Kg = (const h16*)(p.ws + WS_KA) + (size_t)b * SEQ * 512 + h * 64;
    const h16* Vg = (const h16*)(p.ws + WS_VA) + (size_t)b * SEQ * 512 + h * 64;
    const h16* Gg = (const h16*)(p.ws + WS_GA) + (size_t)b * SEQ * 512 + h * 64;
    h16* Og = (h16*)(p.ws + WS_MIX) + (size_t)b * SEQ * 1024 + h * 64;
    const unsigned* Mg = (const unsigned*)(p.ws + WS_MASK) + (size_t)b * 64 * SEQ;
    LAS float* btab = (LAS float*)(lds + ATT_TAB);
    LAS float* lx = (LAS float*)(lds + ATT_TAB + 512);
    const int q0 = qb * 256, qw = q0 + wv * 32;
    float gq = 0.f, gk = 0.f, bm = -1e30f;
    for (int i = 0; i < 64; ++i) { gq = fmaxf(gq, fabsf(p.qg[i])); gk = fmaxf(gk, fabsf(p.kg[i])); }
    for (int i = 0; i < 32; ++i) bm = fmaxf(bm, p.rel_bias[i * 8 + h]);
    const float coff = (8.f * gq * gk * 1.002f + bm) * LOG2E - 15.f;
    __syncthreads();
    if (tid < 128) btab[tid] = p.rel_bias[T5_BUCKET[tid] * 8 + h] * LOG2E - coff;
    const float bfar = p.rel_bias[31 * 8 + h] * LOG2E - coff;
    h16x8 qf[4];
#pragma unroll
    for (int ks = 0; ks < 4; ++ks) qf[ks] = *(const h16x8*)(Qg + (size_t)(qw + r32) * 512 + ks * 16 + hh * 8);
    f32x16 o[2]; o[0] = f32x16{}; o[1] = f32x16{};
    float lsum = 0.f;
    const int jmax = qb * 4 + 3, diag = qw >> 5;
    const int tq = qw + r32;
    KVStage st; kv_load(st, Kg, Vg, 0, tid);
    int cur = 0;
    kv_store(st, lds, tid);
    __syncthreads();
    for (int j = 0; j <= jmax; ++j) {
        if (j < jmax) kv_load(st, Kg, Vg, j + 1, tid);
        LAS const unsigned char* kb = lds + cur * ATT_BUF; LAS const unsigned char* vb = kb + KT_BYTES;
#pragma unroll
        for (int sub = 0; sub < 2; ++sub) {
            const int si = 2 * j + sub;
            if (si <= diag) {
                const unsigned mw = Mg[(size_t)si * SEQ + tq] >> (4 * hh);
                f32x16 s = qk_tile(kb, sub, qf, f32x16{}, r32, hh);
                float P[16];
                const bool nearby = (qw - (32 * si + 31)) < 113;
                if (nearby) {
#pragma unroll
                    for (int r = 0; r < 16; ++r) { int d = tq - (32 * si + crow(r, hh)); d = d < 0 ? 0 : (d > 127 ? 127 : d); P[r] = __builtin_amdgcn_exp2f(s[r] + btab[d]); }
                } else {
#pragma unroll
                    for (int r = 0; r < 16; ++r) P[r] = __builtin_amdgcn_exp2f(s[r] + bfar);
                }
#pragma unroll
                for (int r = 0; r < 16; ++r) { const int bit = (r & 3) + 8 * (r >> 2); P[r] = ((mw >> bit) & 1u) ? P[r] : 0.f; lsum += P[r]; }
                h16x8 pa[2]; pa[0] = pack8(P[0], P[1], P[2], P[3], P[4], P[5], P[6], P[7]); pa[1] = pack8(P[8], P[9], P[10], P[11], P[12], P[13], P[14], P[15]);
                pv_tile(o, vb, sub, pa, lane);
            }
        }
        if (j < jmax) kv_store(st, lds + (cur ^ 1) * ATT_BUF, tid);
        __syncthreads();
        cur ^= 1;
    }
    { const unsigned lu = __float_as_uint(lsum); auto rr = __builtin_amdgcn_permlane32_swap(lu, lu, false, false); const float tot = __uint_as_float(rr[0]) + __uint_as_float(rr[1]);
      if (hh == 0) lx[wv * 32 + r32] = tot; }
    asm volatile("s_waitcnt lgkmcnt(0)" ::: "memory");
#pragma unroll
    for (int db = 0; db < 2; ++db)
#pragma unroll
        for (int r = 0; r < 16; ++r) { const int qi = crow(r, hh); const size_t tok = (size_t)(qw + qi); const int d = 32 * db + r32;
            const float g = (float)Gg[tok * 512 + d]; Og[tok * 1024 + d] = (h16)(o[db][r] * g / lx[wv * 32 + qi]); }
}
__device__ __forceinline__ void phase_sa(const Params& p, LAS unsigned char* lds, int bid, int nblk) {
    for (int u = bid; u < 512; u += nblk) { int b, h, qb; att_unit(u, b, h, qb); sa_unit(p, lds, b, h, qb); }
}
__device__ __forceinline__ int half_sum(int v) {
#pragma unroll
    for (int o = 1; o < 32; o <<= 1) v += __shfl_xor(v, o);
    return v;
}
__device__ __forceinline__ void idx_unit(const Params& p, int b, int qt) {
    const int tid = threadIdx.x, lane = tid & 63, wv = __builtin_amdgcn_readfirstlane(tid >> 6), c = lane & 31, hi = lane >> 5;
    const h16* QI = (const h16*)(p.ws + WS_QI) + (size_t)b * SEQ * 1024;
    const h16* KI = (const h16*)(p.ws + WS_KI) + (size_t)b * SEQ * 64;
    const float* WI = (const float*)(p.ws + WS_WI) + (size_t)b * SEQ * 16;
    unsigned* Mg = (unsigned*)(p.ws + WS_MASK) + (size_t)b * 64 * SEQ;
    const int t0 = qt * 16 + wv * 2, t = t0 + hi;
    h16x8 aq[4];
    { const int rq = (c >> 2) & 1, rh = (c & 3) + 4 * (c >> 3);
#pragma unroll
      for (int ks = 0; ks < 4; ++ks) aq[ks] = *(const h16x8*)(QI + (size_t)(t0 + rq) * 1024 + rh * 64 + ks * 16 + hi * 8); }
    float wq[16];
#pragma unroll
    for (int i = 0; i < 4; ++i) { const f32x4 w4 = *(const f32x4*)(WI + (size_t)t * 16 + 4 * i); wq[4 * i] = w4.x; wq[4 * i + 1] = w4.y; wq[4 * i + 2] = w4.z; wq[4 * i + 3] = w4.w; }
    const int ntile = ((t0 + 1) >> 5) + 1;
    unsigned u[64];
#pragma unroll
    for (int j = 0; j < 64; ++j) u[j] = 0u;
    h16x8 bk[4];
#pragma unroll
    for (int ks = 0; ks < 4; ++ks) bk[ks] = *(const h16x8*)(KI + (size_t)c * 64 + ks * 16 + hi * 8);
#pragma unroll
    for (int j = 0; j < 64; ++j) {
        if (j < ntile) {
            h16x8 bn[4];
            const int jn = (j + 1 < ntile) ? j + 1 : j;
#pragma unroll
            for (int ks = 0; ks < 4; ++ks) bn[ks] = *(const h16x8*)(KI + (size_t)(32 * jn + c) * 64 + ks * 16 + hi * 8);
            f32x16 acc = f32x16{};
#pragma unroll
            for (int ks = 0; ks < 4; ++ks) acc = __builtin_amdgcn_mfma_f32_32x32x16_f16(aq[ks], bk[ks], acc, 0, 0, 0);
            float sc = 0.f;
#pragma unroll
            for (int r = 0; r < 16; ++r) sc += wq[r] * fmaxf(acc[r], 0.f);
            u[j] = (32 * j + c <= t) ? fkey(sc) : 0u;
#pragma unroll
            for (int ks = 0; ks < 4; ++ks) bk[ks] = bn[ks];
        }
    }
    unsigned T = 1u; bool exact = true;
    if (t0 >= TOPK) {
        T = 0u; exact = false;
        for (int bit = 31; bit >= 0; --bit) {
            const unsigned cand = T | (1u << bit);
            int cnt = 0;
#pragma unroll
            for (int j = 0; j < 64; ++j) cnt += (u[j] >= cand) ? 1 : 0;
            cnt = half_sum(cnt);
            if (!exact && cnt >= TOPK) { T = cand; exact = (cnt == TOPK); }
            if (__all(exact)) break;
        }
    }
    if (__all(exact)) {
#pragma unroll
        for (int j = 0; j < 64; ++j) { const unsigned long long bal = __ballot(u[j] >= T);
            if (lane == 0) *(unsigned long long*)(Mg + (size_t)j * SEQ + t0) = bal; }
    } else {
        int ngt = 0;
#pragma unroll
        for (int j = 0; j < 64; ++j) ngt += (u[j] > T) ? 1 : 0;
        ngt = half_sum(ngt);
        const int need = exact ? (1 << 30) : TOPK - ngt;
        int base = 0;
#pragma unroll
        for (int j = 0; j < 64; ++j) {
            const bool eq = (u[j] == T);
            const unsigned long long be = __ballot(eq);
            const unsigned mh = hi ? (unsigned)(be >> 32) : (unsigned)be;
            const int rank = base + __popc(mh & ((1u << c) - 1u));
            const bool sel = (u[j] > T) || (eq && rank < need);
            base += __popc(mh);
            const unsigned long long bal = __ballot(sel);
            if (lane == 0) *(unsigned long long*)(Mg + (size_t)j * SEQ + t0) = bal;
        }
    }
}
__device__ __forceinline__ void phase_idx(const Params& p, int bid, int nblk) {
    for (int u = bid; u < 1024; u += nblk) { const int b = u & 7, qt = 127 - (u >> 3); idx_unit(p, b, qt); }
}
__global__ void __launch_bounds__(NTHR, 2) k_phase(Params p, int which) {
    extern __shared__ __attribute__((aligned(16))) unsigned char lds_raw[];
    LAS unsigned char* lds = (LAS unsigned char*)lds_raw;
    const int bid = blockIdx.x, nblk = gridDim.x;
    if (which == 0) phase_prologue(p, lds, bid, nblk);
    else if (which == 1) phase_gemm1(p, lds, bid, nblk);
    else if (which == 2) phase_idx(p, bid, nblk);
    else if (which == 3) phase_sa(p, lds, bid, nblk);
    else if (which == 4) phase_sb(p, lds, bid, nblk);
    else if (which == 5) phase_gemm2(p, lds, bid, nblk);
}

#ifndef HYB
#define HYB 0
#endif
extern "C" void kernel_launch(void* const* d_in, const int* in_sizes, int n_in, void* d_out, int out_size, void* d_ws, size_t ws_size, hipStream_t stream) {
    const float* x = (const float*)d_in[0]; const float* norm_gain = (const float*)d_in[1]; const float* w_in = (const float*)d_in[2];
    const float* qg = (const float*)d_in[3]; const float* kg = (const float*)d_in[4]; const float* rel_bias = (const float*)d_in[5]; const float* w_out = (const float*)d_in[6];
    char* ws = (char*)d_ws; float* out = (float*)d_out;
    h16 *QA = (h16*)(ws + WS_QA), *KA = (h16*)(ws + WS_KA), *VA = (h16*)(ws + WS_VA), *GA = (h16*)(ws + WS_GA), *QI = (h16*)(ws + WS_QI), *KI = (h16*)(ws + WS_KI);
    float* WI = (float*)(ws + WS_WI);
    h16 *QB = (h16*)(ws + WS_QB), *KB = (h16*)(ws + WS_KB), *VB = (h16*)(ws + WS_VB), *GB = (h16*)(ws + WS_GB), *MIX = (h16*)(ws + WS_MIX);
    unsigned* MASK = (unsigned*)(ws + WS_MASK);
    static bool attr_set = false;
    if (!attr_set) { (void)hipFuncSetAttribute((const void*)k_phase, hipFuncAttributeMaxDynamicSharedMemorySize, LDS_BYTES); attr_set = true; }
    Params p{}; p.x = x; p.norm_gain = norm_gain; p.w_in = w_in; p.qg = qg; p.kg = kg; p.rel_bias = rel_bias; p.w_out = w_out; p.out = out; p.ws = (unsigned char*)d_ws;
    const int grid = 256;
    k_phase<<<grid, NTHR, LDS_BYTES, stream>>>(p, 0);
    k_phase<<<grid, NTHR, LDS_BYTES, stream>>>(p, 1);
    if (HYB & 1) k_phase<<<grid, NTHR, LDS_BYTES, stream>>>(p, 2); else k_index_ref<<<MTOK, 256, 0, stream>>>(QI, KI, WI, MASK);
    if (HYB & 2) k_phase<<<grid, NTHR, LDS_BYTES, stream>>>(p, 3); else k_attnA_ref<<<MTOK, 256, 0, stream>>>(QA, KA, VA, GA, MASK, rel_bias, MIX);
    if (HYB & 4) k_phase<<<grid, NTHR, LDS_BYTES, stream>>>(p, 4); else k_attnB_ref<<<MTOK, 256, 0, stream>>>(QB, KB, VB, GB, MIX);
    k_phase<<<grid, NTHR, LDS_BYTES, stream>>>(p, 5);
}
```

```cpp
#include <hip/hip_runtime.h>
#include <stdint.h>

typedef _Float16 h16;

constexpr int NB = 8, SEQ = 2048, DM = 1024, MTOK = NB * SEQ;
constexpr int NPROJ = 5200;
constexpr float LOG2E = 1.4426950408889634f;
constexpr float QSCALE = 0.125f * LOG2E;
constexpr float IDXS = 0.03125f;
constexpr float RMS_EPS = 1e-6f;
constexpr int TOPK = 256;
constexpr int C_QA = 0, C_KA = 512, C_VA = 1024, C_GA = 1536, C_QI = 2048, C_KI = 3072, C_WI = 3136, C_QB = 3152, C_KB = 3664, C_VB = 4176, C_GB = 4688;

constexpr size_t MiB = 1u << 20;
constexpr size_t WS_CTL = 0, WS_HN = 1 * MiB, WS_W1T = 33 * MiB, WS_W2T = 44 * MiB;
constexpr size_t WS_QA = 46 * MiB, WS_KA = 62 * MiB, WS_VA = 78 * MiB, WS_GA = 94 * MiB, WS_QI = 110 * MiB, WS_KI = 142 * MiB, WS_WI = 144 * MiB;
constexpr size_t WS_QB = 145 * MiB, WS_KB = 161 * MiB, WS_VB = 177 * MiB, WS_GB = 193 * MiB, WS_MASK = 209 * MiB, WS_MIX = WS_HN, WS_FREE = 213 * MiB;

__device__ const unsigned char T5_BUCKET[128] = {0, 1, 2, 3, 4, 5, 6, 7, 8, 9, 10, 11, 12, 13, 14, 15, 16, 16, 16, 17, 17, 18, 18, 18, 19, 19, 19, 20, 20, 20, 20, 21, 21, 21, 21, 22, 22, 22, 22, 22, 23, 23, 23, 23, 23, 23, 24, 24, 24, 24, 24, 24, 25, 25, 25, 25, 25, 25, 25, 26, 26, 26, 26, 26, 26, 26, 26, 27, 27, 27, 27, 27, 27, 27, 27, 27, 27, 28, 28, 28, 28, 28, 28, 28, 28, 28, 28, 29, 29, 29, 29, 29, 29, 29, 29, 29, 29, 29, 29, 30, 30, 30, 30, 30, 30, 30, 30, 30, 30, 30, 30, 30, 30, 31, 31, 31, 31, 31, 31, 31, 31, 31, 31, 31, 31, 31, 31, 31};

__device__ __forceinline__ float wave_sum(float v) {
#pragma unroll
    for (int o = 1; o < 64; o <<= 1) v += __shfl_xor(v, o);
    return v;
}
__device__ __forceinline__ unsigned fkey(float f) { const unsigned u = __float_as_uint(f); return (u & 0x80000000u) ? ~u : (u | 0x80000000u); }
#define LAS __attribute__((address_space(3)))
typedef _Float16 h16x8 __attribute__((ext_vector_type(8)));
typedef _Float16 h16x4 __attribute__((ext_vector_type(4)));
typedef _Float16 h16x2 __attribute__((ext_vector_type(2)));
typedef float f32x2 __attribute__((ext_vector_type(2)));
typedef float f32x4 __attribute__((ext_vector_type(4)));
typedef float f32x16 __attribute__((ext_vector_type(16)));
typedef unsigned u32x4 __attribute__((ext_vector_type(4)));
typedef unsigned u32x2 __attribute__((ext_vector_type(2)));
typedef short s16x4 __attribute__((ext_vector_type(4)));

constexpr int NTHR = 512, NWAVE = 8;
constexpr int N1PAD = 5120;
constexpr int W3ROW = 5120;
constexpr int LDS_BYTES = 147456;

struct Params {
    const float *x, *norm_gain, *w_in, *qg, *kg, *rel_bias, *w_out;
    float* out; unsigned char* ws; int use_cg, pad;
};

__device__ __forceinline__ int opaque_tid() { int t = threadIdx.x; asm volatile("" : "+v"(t)); return t; }
typedef __bf16 bf16x2_t __attribute__((ext_vector_type(2)));
__device__ __forceinline__ unsigned pk2b(float lo, float hi) { f32x2 v = {lo, hi}; bf16x2_t b = __builtin_convertvector(v, bf16x2_t); return __builtin_bit_cast(unsigned, b); }
__device__ __forceinline__ unsigned pk2h(float lo, float hi) { f32x2 v = {lo, hi}; h16x2 h = __builtin_convertvector(v, h16x2); return __builtin_bit_cast(unsigned, h); }

__host__ __device__ __forceinline__ int phys_of_logical(int lt) { const int wc = lt >> 6, bj = (lt >> 5) & 1, fq = (lt >> 3) & 3, n = (lt >> 2) & 1, reg = lt & 3; return 128 * bj + 32 * wc + 16 * n + 4 * fq + reg; }
__host__ __device__ __forceinline__ int phys_of_logical2(int lt) { const int wc = lt >> 6, bj = (lt >> 5) & 1, n = (lt >> 4) & 1, fq = (lt >> 2) & 3, reg = lt & 3; return 128 * bj + 32 * wc + 16 * n + 4 * fq + reg; }
__host__ __device__ __forceinline__ int w1_row_of_col(int c) {
    int pn, lt;
    if (c < 3072) { pn = c >> 8; lt = c & 255; } else if (c < 3152) { return W3ROW + (c - 3072); } else { const int cc = c - 3152; pn = 12 + (cc >> 8); lt = cc & 255; }
    return 256 * pn + phys_of_logical(lt);
}

namespace pg8 {
constexpr int BM = 256, BK = 64, HALF = 128, HTB = HALF * BK * 2, STAGE_BYTES = 8 * HTB, NXCD = 8, WGM = 8;
__host__ __device__ __forceinline__ int lds_byte(int r, int c) { const int st = (r >> 4) * 2 + (c >> 5), rr = r & 15, cc = c & 31, ob = rr * 64 + cc * 2; return st * 1024 + (ob ^ (((ob >> 9) & 1) << 5)); }
__host__ __device__ __forceinline__ void stage_rc(int b, int& R, int& C) { const int st = b / 1024, sb = b % 1024, swz = sb ^ (((sb >> 9) & 1) << 5); R = (st >> 1) * 16 + swz / 64; C = (st & 1) * 32 + (swz % 64) / 2; }
struct Unit { int pm, pn; };
struct Gemm { const h16* A; const h16* Bt; int M, N, K; };
struct StaticOrder {
    int nM, nN, nwg, G, c;
    __host__ __device__ void init(int M, int N, int G_, int c_) { nM = M / BM; nN = N / BM; nwg = nM * nN; G = G_; c = c_; }
    __host__ __device__ bool next(int i, Unit& u) const {
        const long L = (long)i * G + c; if (L >= nwg) return false;
        int wgid = (int)L; { const int q = nwg / NXCD, r = nwg % NXCD, xcd = wgid % NXCD, off = wgid / NXCD; wgid = (xcd < r ? xcd * (q + 1) : r * (q + 1) + (xcd - r) * q) + off; }
        const int nig = WGM * nN, gid = wgid / nig, fm = gid * WGM, gsz = (nM - fm) < WGM ? (nM - fm) : WGM;
        u.pm = fm + ((wgid % nig) % gsz); u.pn = (wgid % nig) / gsz; return true;
    }
};
template <class Epi, class Sched, bool ALIGN_EPI = false, bool SP2 = false, int AUXA = 0>
__device__ __forceinline__ void gemm_phase(LAS unsigned char* lds, const Gemm g, const Sched& S, const Epi& E) {
    const int tid = opaque_tid(), wid = __builtin_amdgcn_readfirstlane(tid >> 6), lane = tid & 63, wr = wid >> 2, wc = wid & 3, fr = lane & 15, fq = lane >> 4;
    const int K = g.K, nt = K / BK;
    unsigned voffA[2], voffB[2];
#pragma unroll
    for (int i = 0; i < 2; ++i) { int R, C; stage_rc(tid * 16 + i * 8192, R, C); voffA[i] = (unsigned)(R * K + C) * 2u; voffB[i] = (unsigned)(R * K + C) * 2u; }
    const size_t kstep = (size_t)(BK * 2);
    const size_t hstep = (size_t)HALF * K * 2;
    const size_t tstep = 2 * hstep;
    const unsigned ldsw = (unsigned)wid * 1024u;
    const int aoff = lds_byte(wr * 64 + fr, fq * 8), boff = lds_byte(wc * 32 + fr, fq * 8);
#define PG8_SA(b, h) (((b) * 2 + (h)) * HTB)
#define PG8_SB(b, h) ((4 + (b) * 2 + (h)) * HTB)
#define PG8_STAGE(bufoff, gbase, voff) do { _Pragma("unroll") for (int _i = 0; _i < 2; ++_i) { \
        if constexpr (AUXA != 0) { if ((bufoff) < 4 * HTB) __builtin_amdgcn_global_load_lds((const unsigned*)((const char*)(gbase) + (voff)[_i]), (LAS unsigned*)(lds + (bufoff) + ldsw + _i * 8192), 16, 0, AUXA); \
                                   else __builtin_amdgcn_global_load_lds((const unsigned*)((const char*)(gbase) + (voff)[_i]), (LAS unsigned*)(lds + (bufoff) + ldsw + _i * 8192), 16, 0, 0); } \
        else __builtin_amdgcn_global_load_lds((const unsigned*)((const char*)(gbase) + (voff)[_i]), (LAS unsigned*)(lds + (bufoff) + ldsw + _i * 8192), 16, 0, 0); } } while (0)
#define PG8_LDA(dst, b, h) do { _Pragma("unroll") for (int m = 0; m < 4; ++m) _Pragma("unroll") for (int k = 0; k < 2; ++k) dst[m][k] = *(const LAS h16x8*)(lds + PG8_SA(b, h) + aoff + m * 2048 + k * 1024); } while (0)
#define PG8_LDB(dst, b, h) do { _Pragma("unroll") for (int n = 0; n < 2; ++n) _Pragma("unroll") for (int k = 0; k < 2; ++k) dst[n][k] = *(const LAS h16x8*)(lds + PG8_SB(b, h) + boff + n * 2048 + k * 1024); } while (0)
#define PG8_MMA(ai, bj, At, Bt) do { __builtin_amdgcn_s_setprio(1); _Pragma("unroll") for (int m = 0; m < 4; ++m) _Pragma("unroll") for (int n = 0; n < 2; ++n) _Pragma("unroll") for (int k = 0; k < 2; ++k) \
        acc[ai][bj][m][n] = __builtin_amdgcn_mfma_f32_16x16x32_f16(Bt[n][k], At[m][k], acc[ai][bj][m][n], 0, 0, 0); __builtin_amdgcn_s_setprio(0); } while (0)
#define PG8_WAIT_V(n) asm volatile("s_waitcnt vmcnt(" #n ")" ::: "memory")
#define PG8_WAIT_L(n) asm volatile("s_waitcnt lgkmcnt(" #n ")" ::: "memory")
#define PG8_BAR __builtin_amdgcn_s_barrier()
#define PG8_SCHED __builtin_amdgcn_sched_barrier(0)
    Unit cur, nxt; int ui = 0;
    if (!S.next(0, cur)) return;
    f32x4 acc[2][2][4][2];
#pragma unroll
    for (int a = 0; a < 2; ++a)
#pragma unroll
        for (int b = 0; b < 2; ++b)
#pragma unroll
            for (int m = 0; m < 4; ++m)
#pragma unroll
                for (int n = 0; n < 2; ++n) acc[a][b][m][n] = (f32x4){0.f, 0.f, 0.f, 0.f};
    h16x8 At[4][2], B0[2][2], B1[2][2];
    const char* cA = (const char*)g.A + (size_t)cur.pm * tstep; const char* cB = (const char*)g.Bt + (size_t)cur.pn * tstep;
    if constexpr (SP2) {
        PG8_STAGE(PG8_SB(0, 0), cB, voffB); PG8_STAGE(PG8_SB(0, 1), cB + hstep, voffB); PG8_STAGE(PG8_SA(0, 0), cA, voffA); PG8_STAGE(PG8_SA(0, 1), cA + hstep, voffA);
        if (wr == 1) PG8_BAR;
        PG8_WAIT_V(2); PG8_BAR;
        PG8_STAGE(PG8_SB(1, 0), cB + kstep, voffB); PG8_STAGE(PG8_SA(1, 0), cA + kstep, voffA); PG8_STAGE(PG8_SB(1, 1), cB + hstep + kstep, voffB);
        PG8_WAIT_V(6); PG8_BAR;
    } else {
        PG8_STAGE(PG8_SB(0, 0), cB, voffB); PG8_STAGE(PG8_SA(0, 0), cA, voffA); PG8_STAGE(PG8_SB(0, 1), cB + hstep, voffB); PG8_STAGE(PG8_SA(0, 1), cA + hstep, voffA);
        if (wr == 1) PG8_BAR;
        PG8_WAIT_V(4); PG8_BAR;
        PG8_STAGE(PG8_SB(1, 0), cB + kstep, voffB); PG8_STAGE(PG8_SA(1, 0), cA + kstep, voffA); PG8_STAGE(PG8_SB(1, 1), cB + hstep + kstep, voffB);
        PG8_WAIT_V(6); PG8_BAR;
    }
    for (;;) {
        const bool has_next = S.next(ui + 1, nxt);
        const char* nA = has_next ? (const char*)g.A + (size_t)nxt.pm * tstep : cA; const char* nB = has_next ? (const char*)g.Bt + (size_t)nxt.pn * tstep : cB;
        for (int t = 0; t < nt; t += 2) {
            const bool last = (t == nt - 2);
            const char* a1 = cA + (size_t)(t + 1) * kstep;
            const char* a2 = last ? nA : cA + (size_t)(t + 2) * kstep; const char* b2 = last ? nB : cB + (size_t)(t + 2) * kstep;
            const char* a3 = a2 + kstep; const char* b3 = b2 + kstep;
            if constexpr (SP2) {
            PG8_LDB(B0, 0, 0); PG8_LDB(B1, 0, 1); PG8_SCHED; PG8_LDA(At, 0, 0); PG8_STAGE(PG8_SA(1, 1), a1 + hstep, voffA);
            PG8_WAIT_V(8); PG8_WAIT_L(0); PG8_BAR; PG8_MMA(0, 0, At, B0); PG8_MMA(0, 1, At, B1); PG8_BAR; PG8_SCHED;
            PG8_LDA(At, 0, 1); PG8_STAGE(PG8_SB(0, 0), b2, voffB); PG8_STAGE(PG8_SB(0, 1), b2 + hstep, voffB); PG8_STAGE(PG8_SA(0, 0), a2, voffA);
            PG8_WAIT_V(8); PG8_WAIT_L(0); PG8_BAR; PG8_MMA(1, 0, At, B0); PG8_MMA(1, 1, At, B1); PG8_BAR; PG8_SCHED;
            PG8_LDB(B0, 1, 0); PG8_LDB(B1, 1, 1); PG8_SCHED; PG8_LDA(At, 1, 0); PG8_STAGE(PG8_SA(0, 1), a2 + hstep, voffA);
            PG8_WAIT_V(8); PG8_WAIT_L(0); PG8_BAR; PG8_MMA(0, 0, At, B0); PG8_MMA(0, 1, At, B1); PG8_BAR; PG8_SCHED;
            PG8_LDA(At, 1, 1); PG8_STAGE(PG8_SB(1, 0), b3, voffB); PG8_STAGE(PG8_SB(1, 1), b3 + hstep, voffB); PG8_STAGE(PG8_SA(1, 0), a3, voffA);
            PG8_WAIT_V(8); PG8_WAIT_L(0); PG8_BAR; PG8_MMA(1, 0, At, B0); PG8_MMA(1, 1, At, B1); PG8_BAR; PG8_SCHED;
            } else {
            PG8_LDB(B0, 0, 0); PG8_SCHED; PG8_LDA(At, 0, 0); PG8_STAGE(PG8_SA(1, 1), a1 + hstep, voffA);
            PG8_WAIT_L(8); PG8_BAR; PG8_WAIT_L(0); PG8_MMA(0, 0, At, B0); PG8_BAR; PG8_SCHED;
            PG8_LDB(B1, 0, 1); PG8_STAGE(PG8_SB(0, 0), b2, voffB);
            PG8_BAR; PG8_WAIT_L(0); PG8_MMA(0, 1, At, B1); PG8_BAR;
            PG8_LDA(At, 0, 1); PG8_STAGE(PG8_SA(0, 0), a2, voffA);
            PG8_BAR; PG8_WAIT_L(0); PG8_MMA(1, 0, At, B0); PG8_BAR; PG8_SCHED;
            PG8_STAGE(PG8_SB(0, 1), b2 + hstep, voffB);
            PG8_WAIT_V(6); PG8_BAR; PG8_MMA(1, 1, At, B1); PG8_BAR;
            PG8_LDB(B0, 1, 0); PG8_SCHED; PG8_LDA(At, 1, 0); PG8_STAGE(PG8_SA(0, 1), a2 + hstep, voffA);
            PG8_WAIT_L(8); PG8_BAR; PG8_WAIT_L(0); PG8_MMA(0, 0, At, B0); PG8_BAR; PG8_SCHED;
            PG8_LDB(B1, 1, 1); PG8_STAGE(PG8_SB(1, 0), b3, voffB);
            PG8_BAR; PG8_WAIT_L(0); PG8_MMA(0, 1, At, B1); PG8_BAR;
            PG8_LDA(At, 1, 1); PG8_STAGE(PG8_SA(1, 0), a3, voffA);
            PG8_BAR; PG8_WAIT_L(0); PG8_MMA(1, 0, At, B0); PG8_BAR; PG8_SCHED;
            PG8_STAGE(PG8_SB(1, 1), b3 + hstep, voffB);
            PG8_WAIT_V(6); PG8_BAR; PG8_MMA(1, 1, At, B1); PG8_BAR;
            }
        }
        if constexpr (ALIGN_EPI) { if (wr == 0) PG8_BAR; }
        E(acc, cur, wr, wc, fr, fq);
        if (!has_next) break;
#pragma unroll
        for (int a = 0; a < 2; ++a)
#pragma unroll
            for (int b = 0; b < 2; ++b)
#pragma unroll
                for (int m = 0; m < 4; ++m)
#pragma unroll
                    for (int n = 0; n < 2; ++n) acc[a][b][m][n] = (f32x4){0.f, 0.f, 0.f, 0.f};
        cur = nxt; cA = nA; cB = nB; ++ui;
        if constexpr (ALIGN_EPI) { if (wr == 1) PG8_BAR; }
    }
    PG8_WAIT_V(0);
    if constexpr (!ALIGN_EPI) { if (wr == 0) PG8_BAR; }
    PG8_BAR;
#undef PG8_SA
#undef PG8_SB
#undef PG8_STAGE
#undef PG8_LDA
#undef PG8_LDB
#undef PG8_MMA
#undef PG8_WAIT_V
#undef PG8_WAIT_L
#undef PG8_BAR
#undef PG8_SCHED
}
}

struct EpiProj {
    unsigned char* ws; const float* qg; const float* kg;
    __device__ __forceinline__ void operator()(const f32x4 (&acc)[2][2][4][2], const pg8::Unit& u, int wr, int wc, int fr, int fq) const {
        const int pn = u.pn;
        int kind = 0; float scale = 1.f; const float* gain = nullptr; h16* dst; int ld = 512, tcol = 0;
        if (pn < 8) { const int t = pn >> 1; tcol = (pn & 1) * 256; dst = (h16*)(ws + WS_QA + (size_t)t * (16 * MiB));
            if (t == 0) { kind = 1; gain = qg; scale = QSCALE; } else if (t == 1) { kind = 1; gain = kg; } else if (t == 2) kind = 3; else kind = 2; }
        else if (pn < 12) { dst = (h16*)(ws + WS_QI); ld = 1024; tcol = (pn - 8) * 256; }
        else { const int t = (pn - 12) >> 1; tcol = (pn & 1) * 256; dst = (h16*)(ws + WS_QB + (size_t)t * (16 * MiB)); if (t == 0) scale = QSCALE; else if (t == 3) kind = 2; }
        const int col = tcol + 64 * wc + 8 * fq;
        float gv[16];
        if (kind == 1) {
#pragma unroll
            for (int i = 0; i < 16; ++i) gv[i] = gain[32 * (i >> 3) + 8 * fq + (i & 7)] * scale;
        }
#pragma unroll
        for (int ai = 0; ai < 2; ++ai)
#pragma unroll
            for (int m = 0; m < 4; ++m) {
                const int row = u.pm * 256 + ai * 128 + wr * 64 + m * 16 + fr;
                float v[16];
#pragma unroll
                for (int bj = 0; bj < 2; ++bj)
#pragma unroll
                    for (int n = 0; n < 2; ++n)
#pragma unroll
                        for (int r = 0; r < 4; ++r) v[8 * bj + 4 * n + r] = acc[ai][bj][m][n][r];
                if (kind == 1) {
                    float s = 0.f;
#pragma unroll
                    for (int i = 0; i < 16; ++i) s += v[i] * v[i];
                    s += __shfl_xor(s, 16); s += __shfl_xor(s, 32);
                    const float rs = rsqrtf(s * (1.f / 64.f) + RMS_EPS);
#pragma unroll
                    for (int i = 0; i < 16; ++i) v[i] = v[i] * rs * gv[i];
                } else if (kind == 2) {
#pragma unroll
                    for (int i = 0; i < 16; ++i) v[i] = v[i] * __builtin_amdgcn_rcpf(1.f + __builtin_amdgcn_exp2f(-v[i] * LOG2E));
                } else {
#pragma unroll
                    for (int i = 0; i < 16; ++i) v[i] *= scale;
                }
                h16* o = dst + (size_t)row * ld + col;
                u32x4 w0, w1;
                if (kind == 3) { w0.x = pk2b(v[0], v[1]); w0.y = pk2b(v[2], v[3]); w0.z = pk2b(v[4], v[5]); w0.w = pk2b(v[6], v[7]);
                                 w1.x = pk2b(v[8], v[9]); w1.y = pk2b(v[10], v[11]); w1.z = pk2b(v[12], v[13]); w1.w = pk2b(v[14], v[15]); }
                else { w0.x = pk2h(v[0], v[1]); w0.y = pk2h(v[2], v[3]); w0.z = pk2h(v[4], v[5]); w0.w = pk2h(v[6], v[7]);
                       w1.x = pk2h(v[8], v[9]); w1.y = pk2h(v[10], v[11]); w1.z = pk2h(v[12], v[13]); w1.w = pk2h(v[14], v[15]); }
                *(u32x4*)o = w0; *(u32x4*)(o + 32) = w1;
            }
    }
};
struct EpiOut {
    const float* x; float* out;
    __device__ __forceinline__ void operator()(const f32x4 (&acc)[2][2][4][2], const pg8::Unit& u, int wr, int wc, int fr, int fq) const {
        const int col = u.pn * 256 + 64 * wc + 4 * fq;
#pragma unroll
        for (int ai = 0; ai < 2; ++ai) {
            f32x4 xv[4][2][2];
#pragma unroll
            for (int m = 0; m < 4; ++m) { const size_t off = (size_t)(u.pm * 256 + ai * 128 + wr * 64 + m * 16 + fr) * DM + col;
#pragma unroll
                for (int bj = 0; bj < 2; ++bj)
#pragma unroll
                    for (int n = 0; n < 2; ++n) xv[m][bj][n] = *(const f32x4*)(x + off + 32 * bj + 16 * n); }
#pragma unroll
            for (int m = 0; m < 4; ++m) { const size_t off = (size_t)(u.pm * 256 + ai * 128 + wr * 64 + m * 16 + fr) * DM + col;
#pragma unroll
                for (int bj = 0; bj < 2; ++bj)
#pragma unroll
                    for (int n = 0; n < 2; ++n) *(f32x4*)(out + off + 32 * bj + 16 * n) = xv[m][bj][n] + acc[ai][bj][m][n]; }
        }
    }
};

template <class RowOf>
__device__ __forceinline__ void transpose_item(const float* W, int K, int N, h16* WT, LAS float* scr, int item, int lane, RowOf row_of) {
    const int nblk = (N + 31) / 32, kb = item / nblk, nb = item % nblk, k0 = 64 * kb, n0 = 32 * nb;
    const int nc = n0 + (lane & 31);
    float wv_[32];
#pragma unroll
    for (int i = 0; i < 32; ++i) { const int kk = 2 * i + (lane >> 5); wv_[i] = nc < N ? W[(size_t)(k0 + kk) * N + nc] : 0.f; }
#pragma unroll
    for (int i = 0; i < 32; ++i) { const int kk = 2 * i + (lane >> 5); scr[kk * 33 + (lane & 31)] = wv_[i]; }
    asm volatile("s_waitcnt lgkmcnt(0)" ::: "memory");
    const int c = lane & 7;
#pragma unroll
    for (int j = 0; j < 4; ++j) { const int n = (lane >> 3) + 8 * j; const LAS float* s = scr + (8 * c) * 33 + n;
        u32x4 o; o.x = pk2h(s[0 * 33], s[1 * 33]); o.y = pk2h(s[2 * 33], s[3 * 33]); o.z = pk2h(s[4 * 33], s[5 * 33]); o.w = pk2h(s[6 * 33], s[7 * 33]);
        if (n0 + n < N) *(u32x4*)(WT + (size_t)row_of(n0 + n) * K + k0 + 8 * c) = o; }
    asm volatile("s_waitcnt lgkmcnt(0)" ::: "memory");
}
__device__ __forceinline__ void rms_row(const float* __restrict__ xrow, const float* __restrict__ gain, h16* __restrict__ orow, int lane) {
    const f32x4* xr = (const f32x4*)xrow + lane;
    f32x4 v[4]; float s = 0.f;
#pragma unroll
    for (int j = 0; j < 4; ++j) { v[j] = xr[64 * j]; s += (v[j].x * v[j].x + v[j].y * v[j].y) + (v[j].z * v[j].z + v[j].w * v[j].w); }
    const float r = rsqrtf(wave_sum(s) * (1.f / DM) + RMS_EPS);
    u32x2* o8 = (u32x2*)orow + lane;
#pragma unroll
    for (int j = 0; j < 4; ++j) { const f32x4 g = ((const f32x4*)gain)[lane + 64 * j]; u32x2 w; w.x = pk2h(v[j].x * r * g.x, v[j].y * r * g.y); w.y = pk2h(v[j].z * r * g.z, v[j].w * r * g.w); o8[64 * j] = w; }
}
__device__ __forceinline__ void phase_prologue(const Params& p, LAS unsigned char* lds, int bid, int nblk) {
    const int tid = opaque_tid(), lane = tid & 63, wave = tid >> 6;
    LAS float* scr = (LAS float*)(lds + wave * 16384);
    const int gw = bid * NWAVE + wave, NGW = nblk * NWAVE;
    h16* W1T = (h16*)(p.ws + WS_W1T); h16* W2T = (h16*)(p.ws + WS_W2T); h16* HN = (h16*)(p.ws + WS_HN);
    constexpr int I1 = (DM / 64) * ((NPROJ + 31) / 32), I2 = (DM / 64) * (DM / 32);
    for (int it = gw; it < I1 + I2; it += NGW) {
        if (it < I1) transpose_item(p.w_in, DM, NPROJ, W1T, scr, it, lane, [](int c) { return w1_row_of_col(c); });
        else transpose_item(p.w_out, DM, DM, W2T, scr, it - I1, lane, [](int c) { return (c & ~255) + phys_of_logical2(c & 255); });
    }
    for (int m = gw; m < MTOK; m += 4 * NGW) {
        f32x4 v[4][4];
#pragma unroll
        for (int r = 0; r < 4; ++r)
#pragma unroll
            for (int j = 0; j < 4; ++j) v[r][j] = ((const f32x4*)(p.x + (size_t)(m + r * NGW) * DM))[lane + 64 * j];
#pragma unroll
        for (int r = 0; r < 4; ++r) {
            float ss = 0.f;
#pragma unroll
            for (int j = 0; j < 4; ++j) ss += (v[r][j].x * v[r][j].x + v[r][j].y * v[r][j].y) + (v[r][j].z * v[r][j].z + v[r][j].w * v[r][j].w);
            const float rs = rsqrtf(wave_sum(ss) * (1.f / DM) + RMS_EPS);
            u32x2* o8 = (u32x2*)(HN + (size_t)(m + r * NGW) * DM) + lane;
#pragma unroll
            for (int j = 0; j < 4; ++j) { const f32x4 g = ((const f32x4*)p.norm_gain)[lane + 64 * j]; u32x2 w; w.x = pk2h(v[r][j].x * rs * g.x, v[r][j].y * rs * g.y); w.y = pk2h(v[r][j].z * rs * g.z, v[r][j].w * rs * g.w); o8[64 * j] = w; }
        }
    }
}
__device__ __forceinline__ void phase_gemm1(const Params& p, LAS unsigned char* lds, int bid, int nblk) {
    pg8::Gemm g{(const h16*)(p.ws + WS_HN), (const h16*)(p.ws + WS_W1T), MTOK, N1PAD, DM};
    pg8::StaticOrder S; S.init(MTOK, N1PAD, nblk, bid);
    EpiProj E{p.ws, p.qg, p.kg};
    pg8::gemm_phase<EpiProj, pg8::StaticOrder, true, true>(lds, g, S, E);
}

constexpr int KW_STR = 528;
__device__ __forceinline__ void phase_kiwi(const Params& p, LAS unsigned char* lds, int bid, int nblk) {
    const int tid = opaque_tid(), lane = tid & 63, wv = __builtin_amdgcn_readfirstlane(tid >> 6), r32 = lane & 31, hh = lane >> 5;
    const h16* HN = (const h16*)(p.ws + WS_HN); const h16* W3 = (const h16*)(p.ws + WS_W1T) + (size_t)W3ROW * DM;
    const int rt = wv & 1, ct = wv >> 1;
    for (int blk = bid; blk < MTOK / 64; blk += nblk) {
        const int tok0 = blk * 64;
        f32x16 acc = f32x16{};
        u32x4 stg[10];
#define KW_LOAD(KC) _Pragma("unroll") for (int i = 0; i < 10; ++i) { const int idx = tid + 512 * i; const int row = idx >> 5, ch = idx & 31; \
                const h16* src = row < 64 ? HN + (size_t)(tok0 + row) * DM + (KC) * 256 + ch * 8 : W3 + (size_t)(row - 64) * DM + (KC) * 256 + ch * 8; stg[i] = *(const u32x4*)src; }
        KW_LOAD(0)
        for (int kc = 0; kc < 4; ++kc) {
            __syncthreads();
#pragma unroll
            for (int i = 0; i < 10; ++i) { const int idx = tid + 512 * i; *(LAS u32x4*)(lds + (idx >> 5) * KW_STR + (idx & 31) * 16) = stg[i]; }
            if (kc < 3) { KW_LOAD(kc + 1) }
            asm volatile("s_waitcnt lgkmcnt(0)\n\ts_barrier" ::: "memory");
            if (ct < 3) {
                LAS const unsigned char* ap = lds + (64 + ct * 32 + r32) * KW_STR + hh * 16;
                LAS const unsigned char* bp = lds + (rt * 32 + r32) * KW_STR + hh * 16;
#pragma unroll
                for (int ks = 0; ks < 16; ++ks) acc = __builtin_amdgcn_mfma_f32_32x32x16_f16(*(LAS const h16x8*)(ap + ks * 32), *(LAS const h16x8*)(bp + ks * 32), acc, 0, 0, 0);
            }
        }
#undef KW_LOAD
        const size_t tok = (size_t)(tok0 + rt * 32 + r32);
        if (ct < 2) {
            h16* o = (h16*)(p.ws + WS_KI) + tok * 64 + ct * 32 + 4 * hh;
#pragma unroll
            for (int g = 0; g < 4; ++g) { u32x2 w; w.x = pk2h(acc[4 * g], acc[4 * g + 1]); w.y = pk2h(acc[4 * g + 2], acc[4 * g + 3]); *(u32x2*)(o + 8 * g) = w; }
        } else if (ct == 2) {
            float* o = (float*)(p.ws + WS_WI) + tok * 16 + 4 * hh;
#pragma unroll
            for (int g = 0; g < 2; ++g) *(f32x4*)(o + 8 * g) = (f32x4){acc[4 * g] * IDXS, acc[4 * g + 1] * IDXS, acc[4 * g + 2] * IDXS, acc[4 * g + 3] * IDXS};
        }
    }
}
__device__ __forceinline__ void phase_gemm2(const Params& p, LAS unsigned char* lds, int bid, int nblk) {
    pg8::Gemm g{(const h16*)(p.ws + WS_MIX), (const h16*)(p.ws + WS_W2T), MTOK, DM, DM};
    pg8::StaticOrder S; S.init(MTOK, DM, nblk, bid);
    EpiOut E{p.x, p.out};
    pg8::gemm_phase<EpiOut, pg8::StaticOrder, true, true, 16>(lds, g, S, E);
}
#define XB_TMO      128
#define XB_XCNT(j)  (256  + 64 * (j))
#define XB_XSUB(j)  (1280 + 64 * (j))
#define XB_XGEN(j)  (2304 + 64 * (j))
#define XB_TOP      3328
#define XB_TOPGEN   3392
#define XCD_BAR_WORDS 3456
#define XB_SPIN_CAP (1u << 22)
__device__ __forceinline__ unsigned xb_ld(unsigned* p)              { return __hip_atomic_load(p, __ATOMIC_RELAXED, __HIP_MEMORY_SCOPE_AGENT); }
__device__ __forceinline__ unsigned xb_add(unsigned* p, unsigned v) { return __hip_atomic_fetch_add(p, v, __ATOMIC_RELAXED, __HIP_MEMORY_SCOPE_AGENT); }
__device__ __forceinline__ unsigned xb_xcc_id() { return (unsigned)__builtin_amdgcn_s_getreg((3 << 11) | 20) & 0xFu; }
#define XB_SPIN(cond, bar) do { unsigned _sp = 0; while (cond) { __builtin_amdgcn_s_sleep(1); \
    if ((++_sp & 255u) == 0u) { if (xb_ld(&(bar)[XB_TMO])) break; if (_sp > XB_SPIN_CAP) { atomicAdd(&(bar)[XB_TMO], 1u); break; } } } } while (0)
struct XcdBarrier { unsigned* bar; unsigned x; volatile LAS unsigned* st; };
__device__ __forceinline__ XcdBarrier xcd_barrier_post(unsigned* bar, volatile LAS unsigned* st) {
    XcdBarrier b; b.bar = bar; b.x = xb_xcc_id(); b.st = st;
    if (threadIdx.x == 0) (void)xb_add(&bar[XB_XCNT(b.x)], 1u);
    return b;
}
__device__ __forceinline__ void xcd_barrier_complete(unsigned* bar, unsigned x, unsigned& nloc, unsigned& nx) {
    const unsigned G = gridDim.x * gridDim.y * gridDim.z;
    unsigned sum, cnt, mine, sp = 0u;
    for (;;) {
        sum = 0u; cnt = 0u; mine = 0u;
#pragma unroll
        for (unsigned j = 0; j < 16; ++j) { const unsigned c = xb_ld(&bar[XB_XCNT(j)]); sum += c; cnt += (c > 0u) ? 1u : 0u; mine = (j == x) ? c : mine; }
        if (sum == G) break;
        __builtin_amdgcn_s_sleep(1);
        if ((++sp & 255u) == 0u) { if (xb_ld(&bar[XB_TMO])) break; if (sp > XB_SPIN_CAP) { atomicAdd(&bar[XB_TMO], 1u); break; } }
    }
    nloc = mine > 0u ? mine : 1u; nx = cnt > 0u ? cnt : 1u;
}
template <bool REL = true, bool ACQ = true>
__device__ __forceinline__ void xcd_barrier(const XcdBarrier& b) {
    asm volatile("s_waitcnt vmcnt(0)" ::: "memory");
    __syncthreads();
    if (threadIdx.x == 0) {
        unsigned* bar = b.bar;
        __builtin_amdgcn_s_waitcnt(0);
        unsigned nloc = b.st[0], nx = b.st[1];
        if (nloc == 0u) { xcd_barrier_complete(bar, b.x, nloc, nx); b.st[0] = nloc; b.st[1] = nx; }
        const unsigned old = xb_add(&bar[XB_XSUB(b.x)], 1u);
        const unsigned gen = old / nloc;
        if (old + 1u == (gen + 1u) * nloc) {
            if constexpr (REL) __builtin_amdgcn_fence(__ATOMIC_RELEASE, "agent");
            asm volatile("s_waitcnt vmcnt(0)" ::: "memory");
            const unsigned og = xb_add(&bar[XB_TOP], 1u);
            const unsigned tg = og / nx;
            if (og + 1u == (tg + 1u) * nx) xb_add(&bar[XB_TOPGEN], 1u);
            else XB_SPIN(xb_ld(&bar[XB_TOPGEN]) == tg, bar);
            xb_add(&bar[XB_XGEN(b.x)], 1u);
            if constexpr (ACQ) __builtin_amdgcn_fence(__ATOMIC_ACQUIRE, "agent");
            asm volatile("s_waitcnt vmcnt(0)" ::: "memory");
        } else {
            XB_SPIN(xb_ld(&bar[XB_XGEN(b.x)]) == gen, bar);
            if constexpr (ACQ) __builtin_amdgcn_fence(__ATOMIC_ACQUIRE, "agent");
            asm volatile("s_waitcnt vmcnt(0)" ::: "memory");
        }
    }
    __syncthreads();
}
#define XB_FLAT(k)  (3520 + 64 * (k))
__device__ __forceinline__ void flat_arrive(const XcdBarrier& b, int k) {
    asm volatile("s_waitcnt vmcnt(0)" ::: "memory");
    __syncthreads();
    if (threadIdx.x == 0) (void)xb_add(&b.bar[XB_FLAT(k)], 1u);
}
__device__ __forceinline__ void flat_wait(const XcdBarrier& b, int k) {
    if (threadIdx.x == 0) { const unsigned G = gridDim.x * gridDim.y * gridDim.z; XB_SPIN(xb_ld(&b.bar[XB_FLAT(k)]) < G, b.bar); }
    __syncthreads();
}
__device__ __forceinline__ int crow(int r, int hi) { return (r & 3) + 8 * (r >> 2) + 4 * hi; }
constexpr int KSTR = 144, VSTR = 192;
constexpr int KT_BYTES = 64 * KSTR, VT_BYTES = 64 * VSTR;
constexpr int MT_BYTES = 2048;
constexpr int ATT_BUF = KT_BYTES + VT_BYTES + MT_BYTES;
constexpr int ATT_TAB = 2 * ATT_BUF;
constexpr int OSTR = 144, ATT_OST = ATT_TAB + 2304;
constexpr float SB_EXIT = 64.f;
__device__ __forceinline__ s16x4 vtr(LAS const unsigned char* p) { return __builtin_amdgcn_ds_read_tr16_b64_v4i16((LAS s16x4*)p); }
__device__ __forceinline__ h16x8 mk8(s16x4 a, s16x4 b) { typedef short s16x8 __attribute__((ext_vector_type(8))); s16x8 r = {a[0], a[1], a[2], a[3], b[0], b[1], b[2], b[3]}; return __builtin_bit_cast(h16x8, r); }
__device__ __forceinline__ h16x8 pack8(float a0, float a1, float a2, float a3, float a4, float a5, float a6, float a7) {
    u32x4 w; w.x = pk2h(a0, a1); w.y = pk2h(a2, a3); w.z = pk2h(a4, a5); w.w = pk2h(a6, a7); return __builtin_bit_cast(h16x8, w); }
__device__ __forceinline__ float bcast_lo(float v) { const unsigned u = __float_as_uint(v); auto rr = __builtin_amdgcn_permlane32_swap(u, u, false, false); return __uint_as_float(rr[0]); }
__device__ __forceinline__ f32x16 splat16(float v) { f32x16 r;
#pragma unroll
    for (int i = 0; i < 16; ++i) r[i] = v;
    return r; }

struct KVStage { u32x4 k, v; unsigned m; };
template <bool MASK>
__device__ __forceinline__ void kv_load(KVStage& st, const h16* Kg, const h16* Vg, const unsigned* Mg, int tile, int tid) {
    const size_t off = (size_t)(tile * 64 + (tid >> 3)) * 512 + (tid & 7) * 8;
    const h16* kp = Kg + off; const h16* vp = Vg + off;
    asm volatile("global_load_dwordx4 %0, %1, off" : "=v"(st.k) : "v"(kp) : "memory");
    asm volatile("global_load_dwordx4 %0, %1, off" : "=v"(st.v) : "v"(vp) : "memory");
    if (MASK) { const unsigned* mp = Mg + (size_t)(2 * tile + (tid >> 8)) * SEQ + (tid & 255); asm volatile("global_load_dword %0, %1, off" : "=v"(st.m) : "v"(mp) : "memory"); }
}
template <int N>
__device__ __forceinline__ void kv_wait(KVStage& st) {
    asm volatile("s_waitcnt vmcnt(%0)" :: "n"(N) : "memory");
    asm volatile("" : "+v"(st.k), "+v"(st.v), "+v"(st.m));
}
template <bool MASK>
__device__ __forceinline__ void kv_store(const KVStage& st, LAS unsigned char* buf, int tid) {
    *(LAS u32x4*)(buf + (tid >> 3) * KSTR + (tid & 7) * 16) = st.k;
    *(LAS u32x4*)(buf + KT_BYTES + (tid >> 3) * VSTR + (tid & 7) * 16) = st.v;
    if (MASK) *(LAS unsigned*)(buf + KT_BYTES + VT_BYTES + tid * 4) = st.m;
}
__device__ __forceinline__ f32x16 qk_tile(LAS const unsigned char* kb, int sub, const h16x8 (&qf)[4], int r32, int hh, f32x16 cinit = f32x16{}) {
    LAS const unsigned char* kp = kb + (sub * 32 + r32) * KSTR + hh * 16;
    f32x16 acc = cinit;
#pragma unroll
    for (int ks = 0; ks < 4; ++ks) { const h16x8 kf = *(LAS const h16x8*)(kp + ks * 32); acc = __builtin_amdgcn_mfma_f32_32x32x16_f16(kf, qf[ks], acc, 0, 0, 0); }
    return acc;
}
__device__ __forceinline__ void pv_tile(f32x16 (&o)[2], LAS const unsigned char* vb, int sub, const h16x8 (&pa)[2], int lane) {
    const int g = lane >> 4, i = lane & 15, q = i >> 2, pp = i & 3;
    LAS const unsigned char* vp = vb + (sub * 32 + 4 * (g >> 1) + q) * VSTR + (16 * (g & 1) + 4 * pp) * 2;
#pragma unroll
    for (int db = 0; db < 2; ++db)
#pragma unroll
        for (int s2 = 0; s2 < 2; ++s2) {
            const s16x4 lo = vtr(vp + (16 * s2) * VSTR + db * 64), hi = vtr(vp + (16 * s2 + 8) * VSTR + db * 64);
            o[db] = __builtin_amdgcn_mfma_f32_32x32x16_f16(pa[s2], mk8(lo, hi), o[db], 0, 0, 0);
        }
}
__device__ __forceinline__ void st16_wt(void* p, const u32x4& v) { asm volatile("global_store_dwordx4 %0, %1, off sc1\n\ts_nop 1" :: "v"(p), "v"(v) : "memory"); }
__device__ __forceinline__ void att_store(const f32x16 (&o)[2], LAS unsigned char* ost, const LAS float* rs, const h16* Gg, h16* Og, int qw, int lane) {
    const int r32 = lane & 31, hh = lane >> 5;
#pragma unroll
    for (int db = 0; db < 2; ++db)
#pragma unroll
        for (int r = 0; r < 16; ++r) *(LAS h16*)(ost + crow(r, hh) * OSTR + (32 * db + r32) * 2) = (h16)o[db][r];
    asm volatile("s_waitcnt lgkmcnt(0)" ::: "memory");
    const int ch = lane & 7;
#pragma unroll
    for (int i = 0; i < 4; ++i) {
        const int row = 8 * i + (lane >> 3);
        const float sc = rs ? 1.f / rs[row] : 1.f;
        const size_t tok = (size_t)(qw + row);
        const h16x8 ov = *(const LAS h16x8*)(ost + row * OSTR + ch * 16);
        const h16x8 gv = *(const h16x8*)(Gg + tok * 512 + ch * 8);
        u32x4 w;
        w.x = pk2h((float)ov[0] * sc * (float)gv[0], (float)ov[1] * sc * (float)gv[1]); w.y = pk2h((float)ov[2] * sc * (float)gv[2], (float)ov[3] * sc * (float)gv[3]);
        w.z = pk2h((float)ov[4] * sc * (float)gv[4], (float)ov[5] * sc * (float)gv[5]); w.w = pk2h((float)ov[6] * sc * (float)gv[6], (float)ov[7] * sc * (float)gv[7]);
        st16_wt(Og + tok * 1024 + ch * 8, w);
    }
}
__device__ __forceinline__ void k_frags(h16x8 (&kf)[4], LAS const unsigned char* kb, int sub, int r32, int hh) {
    LAS const unsigned char* kp = kb + (sub * 32 + r32) * KSTR + hh * 16;
#pragma unroll
    for (int ks = 0; ks < 4; ++ks) kf[ks] = *(LAS const h16x8*)(kp + ks * 32);
}
__device__ __forceinline__ void v_frags(h16x8 (&vf)[2][2], LAS const unsigned char* vb, int sub, int lane) {
    const int g = lane >> 4, i = lane & 15, q = i >> 2, pp = i & 3;
    LAS const unsigned char* vp = vb + (sub * 32 + 4 * (g >> 1) + q) * VSTR + (16 * (g & 1) + 4 * pp) * 2;
#pragma unroll
    for (int db = 0; db < 2; ++db)
#pragma unroll
        for (int s2 = 0; s2 < 2; ++s2) vf[db][s2] = mk8(vtr(vp + (16 * s2) * VSTR + db * 64), vtr(vp + (16 * s2 + 8) * VSTR + db * 64));
}
__device__ __forceinline__ f32x16 qk_mma(const h16x8 (&kf)[4], const h16x8 (&qf)[4], f32x16 acc) {
#pragma unroll
    for (int ks = 0; ks < 4; ++ks) acc = __builtin_amdgcn_mfma_f32_32x32x16_f16(kf[ks], qf[ks], acc, 0, 0, 0);
    return acc;
}
__device__ __forceinline__ void pv_mma(f32x16 (&o)[2], const h16x8 (&vf)[2][2], const h16x8 (&pa)[2]) {
#pragma unroll
    for (int db = 0; db < 2; ++db)
#pragma unroll
        for (int s2 = 0; s2 < 2; ++s2) o[db] = __builtin_amdgcn_mfma_f32_32x32x16_f16(pa[s2], vf[db][s2], o[db], 0, 0, 0);
}

typedef short b16x8 __attribute__((ext_vector_type(8)));
__device__ __forceinline__ b16x8 pack8b(float a0, float a1, float a2, float a3, float a4, float a5, float a6, float a7) {
    u32x4 w; w.x = pk2b(a0, a1); w.y = pk2b(a2, a3); w.z = pk2b(a4, a5); w.w = pk2b(a6, a7); return __builtin_bit_cast(b16x8, w); }
__device__ __forceinline__ void pv_mma_b(f32x16 (&o)[2], const h16x8 (&vf)[2][2], const b16x8 (&pa)[2]) {
#pragma unroll
    for (int db = 0; db < 2; ++db)
#pragma unroll
        for (int s2 = 0; s2 < 2; ++s2) o[db] = __builtin_amdgcn_mfma_f32_32x32x16_bf16(pa[s2], __builtin_bit_cast(b16x8, vf[db][s2]), o[db], 0, 0, 0);
}
#define SCHED_FENCE() __builtin_amdgcn_sched_barrier(0)
#define LDS_BARRIER() asm volatile("s_waitcnt lgkmcnt(0)\n\ts_barrier" ::: "memory")
__device__ __forceinline__ void att_unit(int u, int& b, int& h, int& qb) { const int pass = u >> 8, x = u & 7, m = (u >> 3) & 31; h = x; b = 4 * pass + (m & 3); qb = pass ? (m >> 2) : 7 - (m >> 2); }


constexpr int HALF_LDS = 65536;
constexpr int MISC_OFF = 131072;
struct Half { int hf, ht, hw, lane; LAS unsigned char* lds; LAS unsigned* bar; unsigned tgt; };
__device__ __forceinline__ Half half_init(LAS unsigned char* lds_all) {
    const int tid = opaque_tid(); Half H;
    H.hf = __builtin_amdgcn_readfirstlane(tid >> 8); H.ht = tid & 255; H.hw = __builtin_amdgcn_readfirstlane((tid >> 6) & 3); H.lane = tid & 63;
    H.lds = lds_all + H.hf * HALF_LDS; H.bar = (LAS unsigned*)(lds_all + MISC_OFF + 64 + 64 * H.hf); H.tgt = 0u;
    return H;
}
__device__ __forceinline__ void half_barrier(Half& H) {
    asm volatile("s_waitcnt lgkmcnt(0)" ::: "memory");
    H.tgt += 4u;
    if (H.lane == 0) (void)__hip_atomic_fetch_add(H.bar, 1u, __ATOMIC_RELAXED, __HIP_MEMORY_SCOPE_WORKGROUP);
    while (__hip_atomic_load(H.bar, __ATOMIC_RELAXED, __HIP_MEMORY_SCOPE_WORKGROUP) < H.tgt) __builtin_amdgcn_s_sleep(1);
    asm volatile("" ::: "memory");
}
constexpr int H_MT = 1024;
constexpr int H_BUF = KT_BYTES + VT_BYTES + H_MT;
constexpr int H_MISC = 2 * H_BUF;
constexpr int H_OST = H_MISC + 2048;
struct KV2 { u32x4 k[2], v[2]; unsigned m; };
template <bool MASK>
__device__ __forceinline__ void kv2_load(KV2& st, const h16* Kg, const h16* Vg, const unsigned* Mq, int tile, int ht) {
#pragma unroll
    for (int i = 0; i < 2; ++i) { const int idx = ht + 256 * i; const size_t off = (size_t)(tile * 64 + (idx >> 3)) * 512 + (idx & 7) * 8; st.k[i] = *(const u32x4*)(Kg + off); st.v[i] = *(const u32x4*)(Vg + off); }
    if (MASK) st.m = Mq[(size_t)(2 * tile + (ht >> 7)) * SEQ + (ht & 127)];
}
template <bool MASK>
__device__ __forceinline__ void kv2_store(const KV2& st, LAS unsigned char* buf, int ht) {
#pragma unroll
    for (int i = 0; i < 2; ++i) { const int idx = ht + 256 * i; *(LAS u32x4*)(buf + (idx >> 3) * KSTR + (idx & 7) * 16) = st.k[i]; *(LAS u32x4*)(buf + KT_BYTES + (idx >> 3) * VSTR + (idx & 7) * 16) = st.v[i]; }
    if (MASK) *(LAS unsigned*)(buf + KT_BYTES + VT_BYTES + ht * 4) = st.m;
}
__device__ __forceinline__ void att2_unit(int u, int& b, int& h, int& q16) {
    const int pass = u >> 9, v = u & 511, hf = v & 1, blk = v >> 1, x = blk & 7, e = 2 * (blk >> 3) + hf;
    h = x; b = 4 * pass + (e & 3); q16 = pass ? (e >> 2) : 15 - (e >> 2);
}
__device__ __forceinline__ void sb_softplus(const f32x16& z, h16x8 (&lf)[2], bool dg, int r32, int hh) {
    float L[16];
#pragma unroll
    for (int r = 0; r < 16; ++r) { float l = __builtin_amdgcn_logf(1.f + __builtin_amdgcn_exp2f(z[r])); if (dg && crow(r, hh) >= r32) l = 0.f; L[r] = l; }
    lf[0] = pack8(L[0], L[1], L[2], L[3], L[4], L[5], L[6], L[7]); lf[1] = pack8(L[8], L[9], L[10], L[11], L[12], L[13], L[14], L[15]);
}
__device__ __forceinline__ void sb_weights(const f32x16& z, const f32x16& y, h16x8 (&pa)[2], bool dg, int r32, int hh) {
    float A[16];
#pragma unroll
    for (int r = 0; r < 16; ++r) { float a = __builtin_amdgcn_exp2f(z[r] - y[r]); if (dg && crow(r, hh) >= r32) a = 0.f; A[r] = a; }
    pa[0] = pack8(A[0], A[1], A[2], A[3], A[4], A[5], A[6], A[7]); pa[1] = pack8(A[8], A[9], A[10], A[11], A[12], A[13], A[14], A[15]);
}
__device__ __forceinline__ f32x16 sb_cum(const h16x8 (&tri)[2], const h16x8 (&lf)[2], float carry) {
    f32x16 y = splat16(carry);
    y = __builtin_amdgcn_mfma_f32_32x32x16_f16(tri[0], lf[0], y, 0, 0, 0);
    y = __builtin_amdgcn_mfma_f32_32x32x16_f16(tri[1], lf[1], y, 0, 0, 0);
    return y;
}

__device__ __forceinline__ void sb2_unit(const Params& p, Half& H, int b, int h, int q16) {
    const int lane = H.lane, hw = H.hw, ht = H.ht, r32 = lane & 31, hh = lane >> 5;
    LAS unsigned char* lds = H.lds;
    const h16* Qg = (const h16*)(p.ws + WS_QB) + (size_t)b * SEQ * 512 + h * 64;
    const h16* Kg = (const h16*)(p.ws + WS_KB) + (size_t)b * SEQ * 512 + h * 64;
    const h16* Vg = (const h16*)(p.ws + WS_VB) + (size_t)b * SEQ * 512 + h * 64;
    const h16* Gg = (const h16*)(p.ws + WS_GB) + (size_t)b * SEQ * 512 + h * 64;
    h16* Og = (h16*)(p.ws + WS_MIX) + (size_t)b * SEQ * 1024 + 512 + h * 64;
    const int q0 = q16 * 128, qw = q0 + hw * 32;
    const int jmax = 2 * q16 + 1, diag = qw >> 5;
    KV2 st; kv2_load<false>(st, Kg, Vg, nullptr, jmax, ht);
    h16x8 qf[4];
#pragma unroll
    for (int ks = 0; ks < 4; ++ks) qf[ks] = *(const h16x8*)(Qg + (size_t)(qw + r32) * 512 + ks * 16 + hh * 8);
    h16x8 tri[2];
#pragma unroll
    for (int s2 = 0; s2 < 2; ++s2)
#pragma unroll
        for (int jj = 0; jj < 8; ++jj) { const int j = 16 * s2 + 8 * (jj >> 2) + 4 * hh + (jj & 3); tri[s2][jj] = (j >= r32) ? (h16)1.0f : (h16)0.0f; }
    f32x16 o[2]; o[0] = f32x16{}; o[1] = f32x16{};
    LAS unsigned* flg = (LAS unsigned*)(lds + H_MISC + 1536);
    float carry = 0.f;
    asm volatile("" : "+v"(qf[0]), "+v"(qf[1]), "+v"(qf[2]), "+v"(qf[3]));
    int cur = 0;
    kv2_store<false>(st, lds, ht);
    half_barrier(H);
    const int jd = diag >> 1;
    int j = jmax; bool fin = false;
#define SB_STAGE_IN()  if (j > 0) kv2_load<false>(st, Kg, Vg, nullptr, j - 1, ht); \
        LAS const unsigned char* kb = lds + cur * H_BUF; LAS const unsigned char* vb = kb + KT_BYTES;
#define SB_STAGE_OUT() if (j > 0) kv2_store<false>(st, lds + (cur ^ 1) * H_BUF, ht); \
        if (lane == 0) flg[(j & 1) * 4 + hw] = (2 * j <= diag && __all(carry > SB_EXIT)) ? 1u : 0u; \
        half_barrier(H); \
        cur ^= 1; \
        { const unsigned f = flg[(j & 1) * 4 + (lane & 3)]; if (__all(f != 0u)) fin = true; }
    for (; j > jd && !fin; --j) { SB_STAGE_IN() (void)kb; (void)vb; SB_STAGE_OUT() }
    if (!fin && j == jd) {
        SB_STAGE_IN()
#pragma unroll
        for (int sub = 1; sub >= 0; --sub) {
            const int si = 2 * j + sub;
            if (si <= diag) {
                const bool dg = (si == diag);
                const f32x16 z = qk_tile(kb, sub, qf, r32, hh);
                h16x8 lf[2], pa[2];
                sb_softplus(z, lf, dg, r32, hh);
                const f32x16 y = sb_cum(tri, lf, carry);
                sb_weights(z, y, pa, dg, r32, hh);
                carry = bcast_lo(y[0]);
                pv_tile(o, vb, sub, pa, lane);
            }
        }
        SB_STAGE_OUT()
        --j;
    }
    for (; j >= 0 && !fin; --j) {
        SB_STAGE_IN()
        const f32x16 z1 = qk_tile(kb, 1, qf, r32, hh);
        const f32x16 z0 = qk_tile(kb, 0, qf, r32, hh);
        h16x8 lf1[2], lf0[2], pa1[2], pa0[2];
        sb_softplus(z1, lf1, false, r32, hh);
        const f32x16 y1 = sb_cum(tri, lf1, carry);
        sb_softplus(z0, lf0, false, r32, hh);
        const float c1 = bcast_lo(y1[0]);
        const f32x16 y0 = sb_cum(tri, lf0, c1);
        sb_weights(z1, y1, pa1, false, r32, hh);
        pv_tile(o, vb, 1, pa1, lane);
        sb_weights(z0, y0, pa0, false, r32, hh);
        pv_tile(o, vb, 0, pa0, lane);
        carry = bcast_lo(y0[0]);
        SB_STAGE_OUT()
    }
#undef SB_STAGE_IN
#undef SB_STAGE_OUT
    att_store(o, lds + H_OST + hw * (32 * OSTR), nullptr, Gg, Og, qw, lane);
}
__device__ __forceinline__ void phase_sb2(const Params& p, Half& H, int bid, int nblk) {
    for (int u = 2 * bid + H.hf; u < 1024; u += 2 * nblk) { int b, h, q16; att2_unit(u, b, h, q16); sb2_unit(p, H, b, h, q16); }
}
__device__ __forceinline__ void sa_probs(const f32x16& s, unsigned mw, const LAS float* btab, bool nearby, b16x8 (&pa)[2], f32x16& osum, const b16x8& ones, int hh) {
    float P[16];
    if (nearby) {
#pragma unroll
        for (int r = 0; r < 16; ++r) P[r] = __builtin_amdgcn_exp2f(s[r] + btab[27 - ((r & 3) + 8 * (r >> 2))]);
    } else {
#pragma unroll
        for (int r = 0; r < 16; ++r) P[r] = __builtin_amdgcn_exp2f(s[r]);
    }
#pragma unroll
    for (int r = 0; r < 16; ++r) { const int bit = (r & 3) + 8 * (r >> 2); unsigned m_; asm("v_bfe_i32 %0, %1, %2, 1" : "=v"(m_) : "v"(mw), "n"(bit)); P[r] = __uint_as_float(__float_as_uint(P[r]) & m_); }
    pa[0] = pack8b(P[0], P[1], P[2], P[3], P[4], P[5], P[6], P[7]); pa[1] = pack8b(P[8], P[9], P[10], P[11], P[12], P[13], P[14], P[15]);
    osum = __builtin_amdgcn_mfma_f32_32x32x16_bf16(pa[0], ones, osum, 0, 0, 0);
    osum = __builtin_amdgcn_mfma_f32_32x32x16_bf16(pa[1], ones, osum, 0, 0, 0);
}
constexpr int A_KT = 128 * KSTR, A_VT = 128 * VSTR, A_MT = 4096;
constexpr int A_BUF = A_KT + A_VT + A_MT;
constexpr int A_TAB = 2 * A_BUF;
struct KV1 { u32x4 k[2], v[2]; unsigned m[2]; };
__device__ __forceinline__ void kv1_load(KV1& st, const h16* Kg, const h16* Vg, const unsigned* Mq, int tile, int tid) {
#pragma unroll
    for (int i = 0; i < 2; ++i) { const int idx = tid + 512 * i; const size_t off = (size_t)(tile * 128 + (idx >> 3)) * 512 + (idx & 7) * 8;
        st.k[i] = *(const u32x4*)(Kg + off); st.v[i] = *(const u32x4*)(Vg + off);
        st.m[i] = __hip_atomic_load(Mq + (size_t)(4 * tile + (idx >> 8)) * SEQ + (idx & 255), __ATOMIC_RELAXED, __HIP_MEMORY_SCOPE_AGENT); }
}
__device__ __forceinline__ void kv1_store(const KV1& st, LAS unsigned char* buf, int tid) {
#pragma unroll
    for (int i = 0; i < 2; ++i) { const int idx = tid + 512 * i;
        *(LAS u32x4*)(buf + (idx >> 3) * KSTR + (idx & 7) * 16) = st.k[i];
        *(LAS u32x4*)(buf + A_KT + (idx >> 3) * VSTR + (idx & 7) * 16) = st.v[i];
        *(LAS unsigned*)(buf + A_KT + A_VT + idx * 4) = st.m[i]; }
}
__device__ __forceinline__ void sa_unit(const Params& p, LAS unsigned char* lds, int b, int h, int qb) {
    const int tid = opaque_tid(), lane = tid & 63, wv = __builtin_amdgcn_readfirstlane(tid >> 6), r32 = lane & 31, hh = lane >> 5;
    const h16* Qg = (const h16*)(p.ws + WS_QA) + (size_t)b * SEQ * 512 + h * 64;
    const h16* Kg = (const h16*)(p.ws + WS_KA) + (size_t)b * SEQ * 512 + h * 64;
    const h16* Vg = (const h16*)(p.ws + WS_VA) + (size_t)b * SEQ * 512 + h * 64;
    const h16* Gg = (const h16*)(p.ws + WS_GA) + (size_t)b * SEQ * 512 + h * 64;
    h16* Og = (h16*)(p.ws + WS_MIX) + (size_t)b * SEQ * 1024 + h * 64;
    const int q0 = qb * 256, qw = q0 + wv * 32;
    const unsigned* Mq = (const unsigned*)(p.ws + WS_MASK) + (size_t)b * 64 * SEQ + q0;
    LAS float* btab = (LAS float*)(lds + A_TAB);
    LAS float* lx = (LAS float*)(lds + A_TAB + 1280);
    const int jmax = 2 * qb + 1, diag = qw >> 5;
    KV1 st; kv1_load(st, Kg, Vg, Mq, 0, tid);
    __syncthreads();
    if (tid < 320) { const int d = tid - 32; btab[tid] = (p.rel_bias[T5_BUCKET[d < 0 ? 0 : (d > 127 ? 127 : d)] * 8 + h] - p.rel_bias[31 * 8 + h]) * LOG2E; }
    h16x8 qf[4];
#pragma unroll
    for (int ks = 0; ks < 4; ++ks) qf[ks] = *(const h16x8*)(Qg + (size_t)(qw + r32) * 512 + ks * 16 + hh * 8);
    f32x16 o[2]; o[0] = f32x16{}; o[1] = f32x16{};
    f32x16 osum = f32x16{};
    b16x8 ones;
#pragma unroll
    for (int i = 0; i < 8; ++i) ones[i] = (short)0x3F80;
    const int tq = qw + r32;
    asm volatile("" : "+v"(qf[0]), "+v"(qf[1]), "+v"(qf[2]), "+v"(qf[3]));
    int cur = 0;
    kv1_store(st, lds, tid);
    __syncthreads();
    const int jf = (qw - 112) > 0 ? ((qw - 112) >> 7) : 0;
    const int jd = diag >> 2;
    int j = 0;
#define SA_STAGE_IN()  if (j < jmax) kv1_load(st, Kg, Vg, Mq, j + 1, tid); \
        LAS const unsigned char* kb = lds + cur * A_BUF; LAS const unsigned char* vb = kb + A_KT; \
        const LAS unsigned* mb = (const LAS unsigned*)(kb + A_KT + A_VT) + wv * 32 + r32;
#define SA_STAGE_OUT() if (j < jmax) kv1_store(st, lds + (cur ^ 1) * A_BUF, tid); \
        LDS_BARRIER(); \
        cur ^= 1;
    for (; j < jf; ++j) {
        SA_STAGE_IN()
#pragma unroll
        for (int pr = 0; pr < 2; ++pr) {
            const unsigned mw0 = mb[(2 * pr) * 256] >> (4 * hh), mw1 = mb[(2 * pr + 1) * 256] >> (4 * hh);
            h16x8 kf0[4], kf1[4], vf0[2][2], vf1[2][2]; b16x8 pa0[2], pa1[2];
            k_frags(kf0, kb, 2 * pr, r32, hh); k_frags(kf1, kb, 2 * pr + 1, r32, hh); v_frags(vf0, vb, 2 * pr, lane);
            SCHED_FENCE();
            const f32x16 s0 = qk_mma(kf0, qf, f32x16{});
            const f32x16 s1 = qk_mma(kf1, qf, f32x16{});
            v_frags(vf1, vb, 2 * pr + 1, lane);
            SCHED_FENCE();
            sa_probs(s0, mw0, btab, false, pa0, osum, ones, hh);
            pv_mma_b(o, vf0, pa0);
            sa_probs(s1, mw1, btab, false, pa1, osum, ones, hh);
            pv_mma_b(o, vf1, pa1);
        }
        SA_STAGE_OUT()
    }
    for (; j <= jd; ++j) {
        SA_STAGE_IN()
#pragma unroll
        for (int sub = 0; sub < 4; ++sub) {
            const int si = 4 * j + sub;
            if (si <= diag) {
                const unsigned mw = mb[sub * 256] >> (4 * hh);
                const f32x16 s = qk_tile(kb, sub, qf, r32, hh);
                b16x8 pa[2]; h16x8 vfn[2][2];
                v_frags(vfn, vb, sub, lane);
                sa_probs(s, mw, btab + (tq - 32 * si + 5 - 4 * hh), true, pa, osum, ones, hh);
                pv_mma_b(o, vfn, pa);
            }
        }
        SA_STAGE_OUT()
    }
    for (; j <= jmax; ++j) {
        SA_STAGE_IN()
        (void)vb; (void)mb;
        SA_STAGE_OUT()
    }
#undef SA_STAGE_IN
#undef SA_STAGE_OUT
    if (r32 == 0) {
#pragma unroll
        for (int r = 0; r < 16; ++r) lx[wv * 32 + crow(r, hh)] = osum[r];
    }
    att_store(o, lds + wv * (32 * OSTR), lx + wv * 32, Gg, Og, qw, lane);
}
__device__ __forceinline__ void phase_sa(const Params& p, LAS unsigned char* lds, int bid, int nblk) {
    for (int u = bid; u < 512; u += nblk) { int b, h, qb; att_unit(u, b, h, qb); sa_unit(p, lds, b, h, qb); }
}
constexpr int IK_STR = 144, IK_BUF = 256 * IK_STR, IK_SB = 2 * IK_BUF;
__device__ __forceinline__ int half_sum(int v) {
    v += __builtin_amdgcn_update_dpp(0, v, 0xB1, 0xF, 0xF, false);
    v += __builtin_amdgcn_update_dpp(0, v, 0x4E, 0xF, 0xF, false);
    v += __builtin_amdgcn_update_dpp(0, v, 0x141, 0xF, 0xF, false);
    v += __builtin_amdgcn_update_dpp(0, v, 0x140, 0xF, 0xF, false);
    { auto rr = __builtin_amdgcn_permlane16_swap((unsigned)v, (unsigned)v, false, false); v = (int)(rr[0] + rr[1]); }
    return v;
}
__device__ __forceinline__ unsigned half_umax(unsigned v) {
    unsigned o;
    o = (unsigned)__builtin_amdgcn_update_dpp(0, (int)v, 0xB1, 0xF, 0xF, false); v = v > o ? v : o;
    o = (unsigned)__builtin_amdgcn_update_dpp(0, (int)v, 0x4E, 0xF, 0xF, false); v = v > o ? v : o;
    o = (unsigned)__builtin_amdgcn_update_dpp(0, (int)v, 0x141, 0xF, 0xF, false); v = v > o ? v : o;
    o = (unsigned)__builtin_amdgcn_update_dpp(0, (int)v, 0x140, 0xF, 0xF, false); v = v > o ? v : o;
    { auto rr = __builtin_amdgcn_permlane16_swap(v, v, false, false); v = rr[0] > rr[1] ? rr[0] : rr[1]; }
    return v;
}
__device__ __forceinline__ float keyf(unsigned k) { return __uint_as_float((k & 0x80000000u) ? (k ^ 0x80000000u) : ~k); }
__device__ __forceinline__ void ik_load(u32x4 (&sk)[4], const h16* KI, int g, int tid) {
#pragma unroll
    for (int i = 0; i < 4; ++i) { const int idx = tid + 512 * i; sk[i] = *(const u32x4*)(KI + (size_t)(256 * g + (idx >> 3)) * 64 + (idx & 7) * 8); }
}
__device__ __forceinline__ void ik_store(const u32x4 (&sk)[4], LAS unsigned char* buf, int tid) {
#pragma unroll
    for (int i = 0; i < 4; ++i) { const int idx = tid + 512 * i; *(LAS u32x4*)(buf + (idx >> 3) * IK_STR + (idx & 7) * 16) = sk[i]; }
}
struct IdxPre { u32x4 sk[4]; h16x8 aq[4]; };
__device__ __forceinline__ void idx_prefetch(IdxPre& pre, const Params& p, int b, int qt) {
    const int tid = opaque_tid(), lane = tid & 63, wv = __builtin_amdgcn_readfirstlane(tid >> 6), c = lane & 31, hi = lane >> 5;
    const h16* QI = (const h16*)(p.ws + WS_QI) + (size_t)b * SEQ * 1024;
    const h16* KI = (const h16*)(p.ws + WS_KI) + (size_t)b * SEQ * 64;
    const int t0 = qt * 16 + wv * 2;
    ik_load(pre.sk, KI, 0, tid);
    const int rq = (c >> 2) & 1, rh = (c & 3) + 4 * (c >> 3);
#pragma unroll
    for (int ks = 0; ks < 4; ++ks) pre.aq[ks] = *(const h16x8*)(QI + (size_t)(t0 + rq) * 1024 + rh * 64 + ks * 16 + hi * 8);
}
__device__ __forceinline__ void idx_unit(const Params& p, LAS unsigned char* lds, int b, int qt, IdxPre& pre, bool has_next, int nb, int nqt, IdxPre& pre_next) {
    const int tid = opaque_tid(), lane = tid & 63, wv = __builtin_amdgcn_readfirstlane(tid >> 6), c = lane & 31, hi = lane >> 5;
    const h16* KI = (const h16*)(p.ws + WS_KI) + (size_t)b * SEQ * 64;
    unsigned* Mg = (unsigned*)(p.ws + WS_MASK) + (size_t)b * 64 * SEQ;
    const int t0 = qt * 16 + wv * 2, t = t0 + hi;
    u32x4 (&sk)[4] = pre.sk;
    h16x8 aq[4];
#pragma unroll
    for (int ks = 0; ks < 4; ++ks) aq[ks] = pre.aq[ks];
    const float* WI = (const float*)(p.ws + WS_WI) + (size_t)b * SEQ * 16;
    float wq[16];
#pragma unroll
    for (int i = 0; i < 4; ++i) { const f32x4 w4 = *(const f32x4*)(WI + (size_t)t * 16 + 4 * i); wq[4 * i] = w4.x; wq[4 * i + 1] = w4.y; wq[4 * i + 2] = w4.z; wq[4 * i + 3] = w4.w; }
    const int ntile = ((t0 + 1) >> 5) + 1;
    const int ngroup = ((qt * 16 + 15) >> 8) + 1;
    LAS unsigned* sb = (LAS unsigned*)(lds + IK_SB + wv * 2048);
    unsigned u[64];
#pragma unroll
    for (int j = 0; j < 64; ++j) u[j] = 0u;
    asm volatile("" : "+v"(aq[0]), "+v"(aq[1]), "+v"(aq[2]), "+v"(aq[3]));
    ik_store(sk, lds, tid);
    __syncthreads();
#pragma unroll
    for (int i = 0; i < 16; ++i) asm volatile("" : "+v"(wq[i]));
#pragma unroll
    for (int g = 0; g < 8; ++g) {
        if (g < ngroup) {
            if (g + 1 < ngroup) ik_load(sk, KI, g + 1, tid);
            LAS const unsigned char* kb = lds + (g & 1) * IK_BUF + c * IK_STR + hi * 16;
            h16x8 bk[4];
#pragma unroll
            for (int ks = 0; ks < 4; ++ks) bk[ks] = *(LAS const h16x8*)(kb + ks * 32);
#pragma unroll 2
            for (int jj = 0; jj < 8; ++jj) {
                const int j = 8 * g + jj, jn = jj < 7 ? jj + 1 : 7;
                h16x8 bn[4];
#pragma unroll
                for (int ks = 0; ks < 4; ++ks) bn[ks] = *(LAS const h16x8*)(kb + jn * (32 * IK_STR) + ks * 32);
                __builtin_amdgcn_sched_barrier(0);
                unsigned key = 0u;
                if (j < ntile) {
                    f32x16 acc = f32x16{};
#pragma unroll
                    for (int ks = 0; ks < 4; ++ks) acc = __builtin_amdgcn_mfma_f32_32x32x16_f16(aq[ks], bk[ks], acc, 0, 0, 0);
                    float sc = 0.f;
#pragma unroll
                    for (int r = 0; r < 16; ++r) { const int ib = __float_as_int(acc[r]); sc = __builtin_fmaf(wq[r], __int_as_float(ib > 0 ? ib : 0), sc); }
                    key = fkey(sc);
                    if (j == ntile - 1) key = (32 * j + c <= t) ? key : 0u;
                }
                sb[jj * 64 + lane] = key;
#pragma unroll
                for (int ks = 0; ks < 4; ++ks) bk[ks] = bn[ks];
            }
#pragma unroll
            for (int jj = 0; jj < 8; ++jj) u[8 * g + jj] = sb[jj * 64 + lane];
            if (g + 1 < ngroup) ik_store(sk, lds + ((g + 1) & 1) * IK_BUF, tid);
            asm volatile("s_waitcnt lgkmcnt(0)\n\ts_barrier" ::: "memory");
        }
    }
    if (has_next) idx_prefetch(pre_next, p, nb, nqt);
    unsigned T = 1u; bool exact = true;
    if (t0 >= TOPK) {
        unsigned kmax = 0u, kmin1 = 0xFFFFFFFFu;
#define IDX_MM(J0) _Pragma("unroll") for (int j = (J0); j < (J0) + 16; ++j) { kmax = kmax > u[j] ? kmax : u[j]; const unsigned v1 = u[j] - 1u; kmin1 = kmin1 < v1 ? kmin1 : v1; }
        IDX_MM(0)
        if (ntile > 16) { IDX_MM(16) if (ntile > 32) { IDX_MM(32) if (ntile > 48) { IDX_MM(48) } } }
#undef IDX_MM
        kmax = half_umax(kmax); kmin1 = ~half_umax(~kmin1);
        unsigned lo_k = kmin1 + 1u, hi_k = kmax + 1u;
        float lo_f = keyf(lo_k), hi_f = keyf(hi_k);
        float f_lo = (float)(t + 1) - ((float)TOPK - 0.5f), f_hi = -((float)TOPK - 0.5f);
        int side = 0; bool done = false; exact = false; T = lo_k;
        if (hi_k - lo_k <= 1u) done = true;
        for (int it = 0; it < 64; ++it) {
            unsigned mid_k;
            if (it < 24) { const float mid_f = hi_f - (hi_f - lo_f) * (f_hi / (f_hi - f_lo)); mid_k = fkey(mid_f); } else mid_k = lo_k + ((hi_k - lo_k) >> 1);
            mid_k = mid_k < lo_k + 1u ? lo_k + 1u : (mid_k > hi_k - 1u ? hi_k - 1u : mid_k);
            int c0 = 0, c1 = 0, c2 = 0, c3 = 0;
#define IDX_CNT(J0) _Pragma("unroll") for (int j = (J0); j < (J0) + 16; j += 4) { \
                asm volatile("v_cmp_ge_u32_e64 s[20:21], %4, %8\n\tv_cmp_ge_u32_e64 s[22:23], %5, %8\n\tv_cmp_ge_u32_e64 s[24:25], %6, %8\n\tv_cmp_ge_u32_e64 s[26:27], %7, %8\n\t" \
                             "v_addc_co_u32_e64 %0, s[28:29], 0, %0, s[20:21]\n\tv_addc_co_u32_e64 %1, s[28:29], 0, %1, s[22:23]\n\tv_addc_co_u32_e64 %2, s[28:29], 0, %2, s[24:25]\n\tv_addc_co_u32_e64 %3, s[28:29], 0, %3, s[26:27]" \
                             : "+v"(c0), "+v"(c1), "+v"(c2), "+v"(c3) : "v"(u[j]), "v"(u[j + 1]), "v"(u[j + 2]), "v"(u[j + 3]), "v"(mid_k) \
                             : "s20", "s21", "s22", "s23", "s24", "s25", "s26", "s27", "s28", "s29"); }
            IDX_CNT(0)
            if (ntile > 16) { IDX_CNT(16) if (ntile > 32) { IDX_CNT(32) if (ntile > 48) { IDX_CNT(48) } } }
#undef IDX_CNT
            const int cnt = half_sum((c0 + c1) + (c2 + c3));
            if (!done) {
                if (cnt == TOPK) { T = mid_k; exact = true; done = true; }
                else if (cnt > TOPK) { lo_k = mid_k; lo_f = keyf(mid_k); f_lo = (float)cnt - ((float)TOPK - 0.5f); if (side > 0) f_hi *= 0.5f; side = 1; }
                else { hi_k = mid_k; hi_f = keyf(mid_k); f_hi = (float)cnt - ((float)TOPK - 0.5f); if (side < 0) f_lo *= 0.5f; side = -1; }
                if (!done && hi_k - lo_k <= 1u) { T = lo_k; done = true; }
            }
            if (__all(done)) break;
        }
    }
    LAS unsigned long long* tb = (LAS unsigned long long*)(lds + IK_SB + 16384) + wv;
    if (__all(exact)) {
#define IDX_OUT(J0) _Pragma("unroll") for (int j = (J0); j < (J0) + 16; ++j) { const unsigned long long bal = __ballot(u[j] >= T); if (lane == 0) tb[j * 8] = bal; }
        IDX_OUT(0)
        if (ntile > 16) { IDX_OUT(16) if (ntile > 32) { IDX_OUT(32) if (ntile > 48) { IDX_OUT(48) } } }
#undef IDX_OUT
    } else {
        int ngt = 0;
#pragma unroll
        for (int j = 0; j < 64; ++j) ngt += (u[j] > T) ? 1 : 0;
        ngt = half_sum(ngt);
        const int need = exact ? (1 << 30) : TOPK - ngt;
        int base = 0;
#pragma unroll
        for (int j = 0; j < 64; ++j) {
            const bool eq = (u[j] == T);
            const unsigned long long be = __ballot(eq);
            const unsigned mh = hi ? (unsigned)(be >> 32) : (unsigned)be;
            const int rank = base + __popc(mh & ((1u << c) - 1u));
            const bool sel = (u[j] > T) || (eq && rank < need);
            base += __popc(mh);
            const unsigned long long bal = __ballot(sel);
            if (lane == 0) tb[j * 8] = bal;
        }
    }
    __syncthreads();
    __hip_atomic_store((unsigned long long*)(Mg + (size_t)(tid >> 3) * SEQ + qt * 16 + 2 * (tid & 7)), ((LAS const unsigned long long*)(lds + IK_SB + 16384))[tid], __ATOMIC_RELAXED, __HIP_MEMORY_SCOPE_AGENT);
}
__device__ __forceinline__ void idx_deal(int u, int& b, int& qt) {
    b = u & 7; const int kk = (u >> 3) & 31, r = u >> 8; qt = r == 0 ? 127 - kk : (r == 1 ? 64 + kk : (r == 2 ? 63 - kk : kk));
}
__device__ __forceinline__ void phase_idx(const Params& p, LAS unsigned char* lds, int bid, int nblk) {
    IdxPre pa, pb;
    int u = bid; if (u >= 1024) return;
    int b, qt; idx_deal(u, b, qt);
    idx_prefetch(pa, p, b, qt);
    for (;;) {
        int un = u + nblk, nb = 0, nqt = 0; bool hn = un < 1024; if (hn) idx_deal(un, nb, nqt);
        idx_unit(p, lds, b, qt, pa, hn, nb, nqt, pb);
        if (!hn) break;
        u = un; b = nb; qt = nqt; un = u + nblk; hn = un < 1024; if (hn) idx_deal(un, nb, nqt);
        idx_unit(p, lds, b, qt, pb, hn, nb, nqt, pa);
        if (!hn) break;
        u = un; b = nb; qt = nqt;
    }
}
#include <cstdio>
__global__ void __launch_bounds__(NTHR, 2) k_fused(Params p) {
    extern __shared__ __attribute__((aligned(16))) unsigned char lds_raw[];
    LAS unsigned char* lds = (LAS unsigned char*)lds_raw;
    const int bid = blockIdx.x, nblk = gridDim.x;
    volatile LAS unsigned* st = (volatile LAS unsigned*)(lds + MISC_OFF);
    if (threadIdx.x < 64) st[threadIdx.x] = 0u;
    __syncthreads();
    Half H = half_init(lds);
    const XcdBarrier bar = xcd_barrier_post((unsigned*)(p.ws + WS_CTL), st);
    phase_prologue(p, lds, bid, nblk);
    xcd_barrier(bar);
    phase_gemm1(p, lds, bid, nblk);
    phase_kiwi(p, lds, bid, nblk);
    xcd_barrier(bar);
    phase_idx(p, lds, bid, nblk);
    flat_arrive(bar, 0);
    phase_sb2(p, H, bid, nblk);
    flat_wait(bar, 0);
    phase_sa(p, lds, bid, nblk);
    xcd_barrier<false, false>(bar);
    phase_gemm2(p, lds, bid, nblk);
}

extern "C" void kernel_launch(void* const* d_in, const int* in_sizes, int n_in, void* d_out, int out_size, void* d_ws, size_t ws_size, hipStream_t stream) {
    static int grid_blocks = 0;
    if (!grid_blocks) {
        int dev = 0, cus = 0, per_cu = 0;
        (void)hipGetDevice(&dev);
        (void)hipDeviceGetAttribute(&cus, hipDeviceAttributeMultiprocessorCount, dev);
        (void)hipFuncSetAttribute((const void*)k_fused, hipFuncAttributeMaxDynamicSharedMemorySize, LDS_BYTES);
        (void)hipOccupancyMaxActiveBlocksPerMultiprocessor(&per_cu, (const void*)k_fused, NTHR, LDS_BYTES);
        if (per_cu < 1) per_cu = 1;
        if (per_cu > 1) per_cu = 1;
        grid_blocks = cus * per_cu;
    }
    (void)hipMemsetAsync((char*)d_ws + WS_CTL, 0, 16384, stream);
    Params p{};
    p.x = (const float*)d_in[0]; p.norm_gain = (const float*)d_in[1]; p.w_in = (const float*)d_in[2]; p.qg = (const float*)d_in[3]; p.kg = (const float*)d_in[4];
    p.rel_bias = (const float*)d_in[5]; p.w_out = (const float*)d_in[6]; p.out = (float*)d_out; p.ws = (unsigned char*)d_ws; p.use_cg = 0; p.pad = 0;
    void* args[] = {&p};
    hipError_t e = hipLaunchCooperativeKernel((const void*)k_fused, dim3(grid_blocks), dim3(NTHR), args, LDS_BYTES, stream);
    if (e != hipSuccess) fprintf(stderr, "cooperative launch failed: %s (grid %d)\n", hipGetErrorString(e), grid_blocks);
}
```

```cpp
#include <hip/hip_runtime.h>
#include <stdint.h>

typedef _Float16 h16;

constexpr int NB = 8, SEQ = 2048, DM = 1024, MTOK = NB * SEQ;
constexpr int NPROJ = 5200;
constexpr float LOG2E = 1.4426950408889634f;
constexpr float QSCALE = 0.125f * LOG2E;
constexpr float IDXS = 0.03125f;
constexpr float RMS_EPS = 1e-6f;
constexpr int TOPK = 256;
constexpr int C_QA = 0, C_KA = 512, C_VA = 1024, C_GA = 1536, C_QI = 2048, C_KI = 3072, C_WI = 3136, C_QB = 3152, C_KB = 3664, C_VB = 4176, C_GB = 4688;

constexpr size_t MiB = 1u << 20;
constexpr size_t WS_CTL = 0, WS_HN = 1 * MiB, WS_W1T = 33 * MiB, WS_W2T = 44 * MiB;
constexpr size_t WS_QA = 46 * MiB, WS_KA = 62 * MiB, WS_VA = 78 * MiB, WS_GA = 94 * MiB, WS_QI = 110 * MiB, WS_KI = 142 * MiB, WS_WI = 144 * MiB;
constexpr size_t WS_QB = 145 * MiB, WS_KB = 161 * MiB, WS_VB = 177 * MiB, WS_GB = 193 * MiB, WS_MASK = 209 * MiB, WS_MIX = WS_HN, WS_FREE = 213 * MiB;

__device__ const unsigned char T5_BUCKET[128] = {0, 1, 2, 3, 4, 5, 6, 7, 8, 9, 10, 11, 12, 13, 14, 15, 16, 16, 16, 17, 17, 18, 18, 18, 19, 19, 19, 20, 20, 20, 20, 21, 21, 21, 21, 22, 22, 22, 22, 22, 23, 23, 23, 23, 23, 23, 24, 24, 24, 24, 24, 24, 25, 25, 25, 25, 25, 25, 25, 26, 26, 26, 26, 26, 26, 26, 26, 27, 27, 27, 27, 27, 27, 27, 27, 27, 27, 28, 28, 28, 28, 28, 28, 28, 28, 28, 28, 29, 29, 29, 29, 29, 29, 29, 29, 29, 29, 29, 29, 30, 30, 30, 30, 30, 30, 30, 30, 30, 30, 30, 30, 30, 30, 31, 31, 31, 31, 31, 31, 31, 31, 31, 31, 31, 31, 31, 31, 31};

__device__ __forceinline__ float wave_sum(float v) {
#pragma unroll
    for (int o = 1; o < 64; o <<= 1) v += __shfl_xor(v, o);
    return v;
}
__device__ __forceinline__ unsigned fkey(float f) { const unsigned u = __float_as_uint(f); return (u & 0x80000000u) ? ~u : (u | 0x80000000u); }
#define LAS __attribute__((address_space(3)))
typedef _Float16 h16x8 __attribute__((ext_vector_type(8)));
typedef _Float16 h16x4 __attribute__((ext_vector_type(4)));
typedef _Float16 h16x2 __attribute__((ext_vector_type(2)));
typedef float f32x2 __attribute__((ext_vector_type(2)));
typedef float f32x4 __attribute__((ext_vector_type(4)));
typedef float f32x16 __attribute__((ext_vector_type(16)));
typedef unsigned u32x4 __attribute__((ext_vector_type(4)));
typedef unsigned u32x2 __attribute__((ext_vector_type(2)));
typedef short s16x4 __attribute__((ext_vector_type(4)));

constexpr int NTHR = 512, NWAVE = 8;
constexpr int N1PAD = 5120;
constexpr int W3ROW = 5120;
constexpr int LDS_BYTES = 147456;

struct Params {
    const float *x, *norm_gain, *w_in, *qg, *kg, *rel_bias, *w_out;
    float* out; unsigned char* ws; int use_cg, pad;
};

__device__ __forceinline__ int opaque_tid() { int t = threadIdx.x; asm volatile("" : "+v"(t)); return t; }
typedef __bf16 bf16x2_t __attribute__((ext_vector_type(2)));
__device__ __forceinline__ unsigned pk2b(float lo, float hi) { f32x2 v = {lo, hi}; bf16x2_t b = __builtin_convertvector(v, bf16x2_t); return __builtin_bit_cast(unsigned, b); }
__device__ __forceinline__ unsigned pk2h(float lo, float hi) { f32x2 v = {lo, hi}; h16x2 h = __builtin_convertvector(v, h16x2); return __builtin_bit_cast(unsigned, h); }

__host__ __device__ __forceinline__ int phys_of_logical(int lt) { const int wc = lt >> 6, bj = (lt >> 5) & 1, fq = (lt >> 3) & 3, n = (lt >> 2) & 1, reg = lt & 3; return 128 * bj + 32 * wc + 16 * n + 4 * fq + reg; }
__host__ __device__ __forceinline__ int phys_of_logical2(int lt) { const int wc = lt >> 6, bj = (lt >> 5) & 1, n = (lt >> 4) & 1, fq = (lt >> 2) & 3, reg = lt & 3; return 128 * bj + 32 * wc + 16 * n + 4 * fq + reg; }
__host__ __device__ __forceinline__ int w1_row_of_col(int c) {
    int pn, lt;
    if (c < 3072) { pn = c >> 8; lt = c & 255; } else if (c < 3152) { return W3ROW + (c - 3072); } else { const int cc = c - 3152; pn = 12 + (cc >> 8); lt = cc & 255; }
    return 256 * pn + phys_of_logical(lt);
}

namespace pg8 {
constexpr int BM = 256, BK = 64, HALF = 128, HTB = HALF * BK * 2, STAGE_BYTES = 8 * HTB, NXCD = 8, WGM = 8;
__host__ __device__ __forceinline__ int lds_byte(int r, int c) { const int st = (r >> 4) * 2 + (c >> 5), rr = r & 15, cc = c & 31, ob = rr * 64 + cc * 2; return st * 1024 + (ob ^ (((ob >> 9) & 1) << 5)); }
__host__ __device__ __forceinline__ void stage_rc(int b, int& R, int& C) { const int st = b / 1024, sb = b % 1024, swz = sb ^ (((sb >> 9) & 1) << 5); R = (st >> 1) * 16 + swz / 64; C = (st & 1) * 32 + (swz % 64) / 2; }
struct Unit { int pm, pn; };
struct Gemm { const h16* A; const h16* Bt; int M, N, K; };
struct StaticOrder {
    int nM, nN, nwg, G, c;
    __host__ __device__ __forceinline__ void init(int M, int N, int G_, int c_) { nM = M / BM; nN = N / BM; nwg = nM * nN; G = G_; c = c_; }
    __host__ __device__ __forceinline__ bool next(int i, Unit& u) const {
        const long L = (long)i * G + c; if (L >= nwg) return false;
        int wgid = (int)L; { const int q = nwg / NXCD, r = nwg % NXCD, xcd = wgid % NXCD, off = wgid / NXCD; wgid = (xcd < r ? xcd * (q + 1) : r * (q + 1) + (xcd - r) * q) + off; }
        const int nig = WGM * nN, gid = wgid / nig, fm = gid * WGM, gsz = (nM - fm) < WGM ? (nM - fm) : WGM;
        u.pm = fm + ((wgid % nig) % gsz); u.pn = (wgid % nig) / gsz; return true;
    }
};
template <class Epi, class Sched, bool ALIGN_EPI = false, bool SP2 = false>
__device__ __forceinline__ void gemm_phase(LAS unsigned char* lds, const Gemm g, const Sched& S, const Epi& E) {
    const int tid = opaque_tid(), wid = __builtin_amdgcn_readfirstlane(tid >> 6), lane = tid & 63, wr = wid >> 2, wc = wid & 3, fr = lane & 15, fq = lane >> 4;
    const int K = g.K, nt = K / BK;
    unsigned voffA[2], voffB[2];
#pragma unroll
    for (int i = 0; i < 2; ++i) { int R, C; stage_rc(tid * 16 + i * 8192, R, C); voffA[i] = (unsigned)(R * K + C) * 2u; voffB[i] = (unsigned)(R * K + C) * 2u; }
    const size_t kstep = (size_t)(BK * 2);
    const size_t hstep = (size_t)HALF * K * 2;
    const size_t tstep = 2 * hstep;
    const unsigned ldsw = (unsigned)wid * 1024u;
    const int aoff = lds_byte(wr * 64 + fr, fq * 8), boff = lds_byte(wc * 32 + fr, fq * 8);
#define PG8_SA(b, h) (((b) * 2 + (h)) * HTB)
#define PG8_SB(b, h) ((4 + (b) * 2 + (h)) * HTB)
#define PG8_STAGE(bufoff, gbase, voff) do { _Pragma("unroll") for (int _i = 0; _i < 2; ++_i) \
        __builtin_amdgcn_global_load_lds((const unsigned*)((const char*)(gbase) + (voff)[_i]), (LAS unsigned*)(lds + (bufoff) + ldsw + _i * 8192), 16, 0, 0); } while (0)
#define PG8_LDA(dst, b, h) do { _Pragma("unroll") for (int m = 0; m < 4; ++m) _Pragma("unroll") for (int k = 0; k < 2; ++k) dst[m][k] = *(const LAS h16x8*)(lds + PG8_SA(b, h) + aoff + m * 2048 + k * 1024); } while (0)
#define PG8_LDB(dst, b, h) do { _Pragma("unroll") for (int n = 0; n < 2; ++n) _Pragma("unroll") for (int k = 0; k < 2; ++k) dst[n][k] = *(const LAS h16x8*)(lds + PG8_SB(b, h) + boff + n * 2048 + k * 1024); } while (0)
#define PG8_MMA(ai, bj, At, Bt) do { __builtin_amdgcn_s_setprio(1); _Pragma("unroll") for (int m = 0; m < 4; ++m) _Pragma("unroll") for (int n = 0; n < 2; ++n) _Pragma("unroll") for (int k = 0; k < 2; ++k) \
        acc[ai][bj][m][n] = __builtin_amdgcn_mfma_f32_16x16x32_f16(Bt[n][k], At[m][k], acc[ai][bj][m][n], 0, 0, 0); __builtin_amdgcn_s_setprio(0); } while (0)
#define PG8_WAIT_V(n) asm volatile("s_waitcnt vmcnt(" #n ")" ::: "memory")
#define PG8_WAIT_L(n) asm volatile("s_waitcnt lgkmcnt(" #n ")" ::: "memory")
#define PG8_BAR __builtin_amdgcn_s_barrier()
#define PG8_SCHED __builtin_amdgcn_sched_barrier(0)
    Unit cur, nxt; int ui = 0;
    if (!S.next(0, cur)) return;
    f32x4 acc[2][2][4][2];
#pragma unroll
    for (int a = 0; a < 2; ++a)
#pragma unroll
        for (int b = 0; b < 2; ++b)
#pragma unroll
            for (int m = 0; m < 4; ++m)
#pragma unroll
                for (int n = 0; n < 2; ++n) acc[a][b][m][n] = (f32x4){0.f, 0.f, 0.f, 0.f};
    h16x8 At[4][2], B0[2][2], B1[2][2];
    const char* cA = (const char*)g.A + (size_t)cur.pm * tstep; const char* cB = (const char*)g.Bt + (size_t)cur.pn * tstep;
    if constexpr (SP2) {
        PG8_STAGE(PG8_SB(0, 0), cB, voffB); PG8_STAGE(PG8_SB(0, 1), cB + hstep, voffB); PG8_STAGE(PG8_SA(0, 0), cA, voffA); PG8_STAGE(PG8_SA(0, 1), cA + hstep, voffA);
        if (wr == 1) PG8_BAR;
        PG8_WAIT_V(2); PG8_BAR;
        PG8_STAGE(PG8_SB(1, 0), cB + kstep, voffB); PG8_STAGE(PG8_SA(1, 0), cA + kstep, voffA); PG8_STAGE(PG8_SB(1, 1), cB + hstep + kstep, voffB);
        PG8_WAIT_V(6); PG8_BAR;
    } else {
        PG8_STAGE(PG8_SB(0, 0), cB, voffB); PG8_STAGE(PG8_SA(0, 0), cA, voffA); PG8_STAGE(PG8_SB(0, 1), cB + hstep, voffB); PG8_STAGE(PG8_SA(0, 1), cA + hstep, voffA);
        if (wr == 1) PG8_BAR;
        PG8_WAIT_V(4); PG8_BAR;
        PG8_STAGE(PG8_SB(1, 0), cB + kstep, voffB); PG8_STAGE(PG8_SA(1, 0), cA + kstep, voffA); PG8_STAGE(PG8_SB(1, 1), cB + hstep + kstep, voffB);
        PG8_WAIT_V(6); PG8_BAR;
    }
    for (;;) {
        const bool has_next = S.next(ui + 1, nxt);
        const char* nA = has_next ? (const char*)g.A + (size_t)nxt.pm * tstep : cA; const char* nB = has_next ? (const char*)g.Bt + (size_t)nxt.pn * tstep : cB;
        for (int t = 0; t < nt; t += 2) {
            const bool last = (t == nt - 2);
            const char* a1 = cA + (size_t)(t + 1) * kstep;
            const char* a2 = last ? nA : cA + (size_t)(t + 2) * kstep; const char* b2 = last ? nB : cB + (size_t)(t + 2) * kstep;
            const char* a3 = a2 + kstep; const char* b3 = b2 + kstep;
            if constexpr (SP2) {
            PG8_LDB(B0, 0, 0); PG8_LDB(B1, 0, 1); PG8_SCHED; PG8_LDA(At, 0, 0); PG8_STAGE(PG8_SA(1, 1), a1 + hstep, voffA);
            PG8_WAIT_V(8); PG8_WAIT_L(0); PG8_BAR; PG8_MMA(0, 0, At, B0); PG8_MMA(0, 1, At, B1); PG8_BAR; PG8_SCHED;
            PG8_LDA(At, 0, 1); PG8_STAGE(PG8_SB(0, 0), b2, voffB); PG8_STAGE(PG8_SB(0, 1), b2 + hstep, voffB); PG8_STAGE(PG8_SA(0, 0), a2, voffA);
            PG8_WAIT_V(8); PG8_WAIT_L(0); PG8_BAR; PG8_MMA(1, 0, At, B0); PG8_MMA(1, 1, At, B1); PG8_BAR; PG8_SCHED;
            PG8_LDB(B0, 1, 0); PG8_LDB(B1, 1, 1); PG8_SCHED; PG8_LDA(At, 1, 0); PG8_STAGE(PG8_SA(0, 1), a2 + hstep, voffA);
            PG8_WAIT_V(8); PG8_WAIT_L(0); PG8_BAR; PG8_MMA(0, 0, At, B0); PG8_MMA(0, 1, At, B1); PG8_BAR; PG8_SCHED;
            PG8_LDA(At, 1, 1); PG8_STAGE(PG8_SB(1, 0), b3, voffB); PG8_STAGE(PG8_SB(1, 1), b3 + hstep, voffB); PG8_STAGE(PG8_SA(1, 0), a3, voffA);
            PG8_WAIT_V(8); PG8_WAIT_L(0); PG8_BAR; PG8_MMA(1, 0, At, B0); PG8_MMA(1, 1, At, B1); PG8_BAR; PG8_SCHED;
            } else {
            PG8_LDB(B0, 0, 0); PG8_SCHED; PG8_LDA(At, 0, 0); PG8_STAGE(PG8_SA(1, 1), a1 + hstep, voffA);
            PG8_WAIT_L(8); PG8_BAR; PG8_WAIT_L(0); PG8_MMA(0, 0, At, B0); PG8_BAR; PG8_SCHED;
            PG8_LDB(B1, 0, 1); PG8_STAGE(PG8_SB(0, 0), b2, voffB);
            PG8_BAR; PG8_WAIT_L(0); PG8_MMA(0, 1, At, B1); PG8_BAR;
            PG8_LDA(At, 0, 1); PG8_STAGE(PG8_SA(0, 0), a2, voffA);
            PG8_BAR; PG8_WAIT_L(0); PG8_MMA(1, 0, At, B0); PG8_BAR; PG8_SCHED;
            PG8_STAGE(PG8_SB(0, 1), b2 + hstep, voffB);
            PG8_WAIT_V(6); PG8_BAR; PG8_MMA(1, 1, At, B1); PG8_BAR;
            PG8_LDB(B0, 1, 0); PG8_SCHED; PG8_LDA(At, 1, 0); PG8_STAGE(PG8_SA(0, 1), a2 + hstep, voffA);
            PG8_WAIT_L(8); PG8_BAR; PG8_WAIT_L(0); PG8_MMA(0, 0, At, B0); PG8_BAR; PG8_SCHED;
            PG8_LDB(B1, 1, 1); PG8_STAGE(PG8_SB(1, 0), b3, voffB);
            PG8_BAR; PG8_WAIT_L(0); PG8_MMA(0, 1, At, B1); PG8_BAR;
            PG8_LDA(At, 1, 1); PG8_STAGE(PG8_SA(1, 0), a3, voffA);
            PG8_BAR; PG8_WAIT_L(0); PG8_MMA(1, 0, At, B0); PG8_BAR; PG8_SCHED;
            PG8_STAGE(PG8_SB(1, 1), b3 + hstep, voffB);
            PG8_WAIT_V(6); PG8_BAR; PG8_MMA(1, 1, At, B1); PG8_BAR;
            }
        }
        if constexpr (ALIGN_EPI) { if (wr == 0) PG8_BAR; }
        E(acc, cur, wr, wc, fr, fq);
        if (!has_next) break;
#pragma unroll
        for (int a = 0; a < 2; ++a)
#pragma unroll
            for (int b = 0; b < 2; ++b)
#pragma unroll
                for (int m = 0; m < 4; ++m)
#pragma unroll
                    for (int n = 0; n < 2; ++n) acc[a][b][m][n] = (f32x4){0.f, 0.f, 0.f, 0.f};
        cur = nxt; cA = nA; cB = nB; ++ui;
        if constexpr (ALIGN_EPI) { if (wr == 1) PG8_BAR; }
    }
    PG8_WAIT_V(0);
    if constexpr (!ALIGN_EPI) { if (wr == 0) PG8_BAR; }
    PG8_BAR;
#undef PG8_SA
#undef PG8_SB
#undef PG8_STAGE
#undef PG8_LDA
#undef PG8_LDB
#undef PG8_MMA
#undef PG8_WAIT_V
#undef PG8_WAIT_L
#undef PG8_BAR
#undef PG8_SCHED
}
}

struct EpiProj {
    unsigned char* ws; const float* qg; const float* kg;
    __device__ __forceinline__ void operator()(const f32x4 (&acc)[2][2][4][2], const pg8::Unit& u, int wr, int wc, int fr, int fq) const {
        const int pn = u.pn;
        int kind = 0; float scale = 1.f; const float* gain = nullptr; h16* dst; int ld = 512, tcol = 0;
        if (pn < 8) { const int t = pn >> 1; tcol = (pn & 1) * 256; dst = (h16*)(ws + WS_QA + (size_t)t * (16 * MiB));
            if (t == 0) { kind = 1; gain = qg; scale = QSCALE; } else if (t == 1) { kind = 1; gain = kg; } else if (t == 2) kind = 3; else kind = 2; }
        else if (pn < 12) { dst = (h16*)(ws + WS_QI); ld = 1024; tcol = (pn - 8) * 256; }
        else { const int t = (pn - 12) >> 1; tcol = (pn & 1) * 256; dst = (h16*)(ws + WS_QB + (size_t)t * (16 * MiB)); if (t == 0) scale = QSCALE; else if (t == 3) kind = 2; }
        const int col = tcol + 64 * wc + 8 * fq;
        float gv[16];
        if (kind == 1) {
#pragma unroll
            for (int i = 0; i < 16; ++i) gv[i] = gain[32 * (i >> 3) + 8 * fq + (i & 7)] * scale;
        }
#pragma unroll
        for (int ai = 0; ai < 2; ++ai)
#pragma unroll
            for (int m = 0; m < 4; ++m) {
                const int row = u.pm * 256 + ai * 128 + wr * 64 + m * 16 + fr;
                float v[16];
#pragma unroll
                for (int bj = 0; bj < 2; ++bj)
#pragma unroll
                    for (int n = 0; n < 2; ++n)
#pragma unroll
                        for (int r = 0; r < 4; ++r) v[8 * bj + 4 * n + r] = acc[ai][bj][m][n][r];
                if (kind == 1) {
                    float s = 0.f;
#pragma unroll
                    for (int i = 0; i < 16; ++i) s += v[i] * v[i];
                    s += __shfl_xor(s, 16); s += __shfl_xor(s, 32);
                    const float rs = rsqrtf(s * (1.f / 64.f) + RMS_EPS);
#pragma unroll
                    for (int i = 0; i < 16; ++i) v[i] = v[i] * rs * gv[i];
                } else if (kind == 2) {
#pragma unroll
                    for (int i = 0; i < 16; ++i) v[i] = v[i] * __builtin_amdgcn_rcpf(1.f + __builtin_amdgcn_exp2f(-v[i] * LOG2E));
                } else {
#pragma unroll
                    for (int i = 0; i < 16; ++i) v[i] *= scale;
                }
                h16* o = dst + (size_t)row * ld + col;
                u32x4 w0, w1;
                if (kind == 3) { w0.x = pk2b(v[0], v[1]); w0.y = pk2b(v[2], v[3]); w0.z = pk2b(v[4], v[5]); w0.w = pk2b(v[6], v[7]);
                                 w1.x = pk2b(v[8], v[9]); w1.y = pk2b(v[10], v[11]); w1.z = pk2b(v[12], v[13]); w1.w = pk2b(v[14], v[15]); }
                else { w0.x = pk2h(v[0], v[1]); w0.y = pk2h(v[2], v[3]); w0.z = pk2h(v[4], v[5]); w0.w = pk2h(v[6], v[7]);
                       w1.x = pk2h(v[8], v[9]); w1.y = pk2h(v[10], v[11]); w1.z = pk2h(v[12], v[13]); w1.w = pk2h(v[14], v[15]); }
                *(u32x4*)o = w0; *(u32x4*)(o + 32) = w1;
            }
    }
};
struct EpiOut {
    const float* x; float* out;
    __device__ __forceinline__ void operator()(const f32x4 (&acc)[2][2][4][2], const pg8::Unit& u, int wr, int wc, int fr, int fq) const {
        const int col = u.pn * 256 + 64 * wc + 4 * fq;
#pragma unroll
        for (int ai = 0; ai < 2; ++ai) {
            f32x4 xv[4][2][2];
#pragma unroll
            for (int m = 0; m < 4; ++m) { const size_t off = (size_t)(u.pm * 256 + ai * 128 + wr * 64 + m * 16 + fr) * DM + col;
#pragma unroll
                for (int bj = 0; bj < 2; ++bj)
#pragma unroll
                    for (int n = 0; n < 2; ++n) xv[m][bj][n] = *(const f32x4*)(x + off + 32 * bj + 16 * n); }
#pragma unroll
            for (int m = 0; m < 4; ++m) { const size_t off = (size_t)(u.pm * 256 + ai * 128 + wr * 64 + m * 16 + fr) * DM + col;
#pragma unroll
                for (int bj = 0; bj < 2; ++bj)
#pragma unroll
                    for (int n = 0; n < 2; ++n) *(f32x4*)(out + off + 32 * bj + 16 * n) = xv[m][bj][n] + acc[ai][bj][m][n]; }
        }
    }
};

template <class RowOf>
__device__ __forceinline__ void transpose_item(const float* W, int K, int N, h16* WT, LAS float* scr, int item, int lane, RowOf row_of) {
    const int nblk = (N + 31) / 32, kb = item / nblk, nb = item % nblk, k0 = 64 * kb, n0 = 32 * nb;
    const int nc = n0 + (lane & 31);
    float wv_[32];
#pragma unroll
    for (int i = 0; i < 32; ++i) { const int kk = 2 * i + (lane >> 5); wv_[i] = nc < N ? W[(size_t)(k0 + kk) * N + nc] : 0.f; }
#pragma unroll
    for (int i = 0; i < 32; ++i) { const int kk = 2 * i + (lane >> 5); scr[kk * 33 + (lane & 31)] = wv_[i]; }
    asm volatile("s_waitcnt lgkmcnt(0)" ::: "memory");
    const int c = lane & 7;
#pragma unroll
    for (int j = 0; j < 4; ++j) { const int n = (lane >> 3) + 8 * j; const LAS float* s = scr + (8 * c) * 33 + n;
        u32x4 o; o.x = pk2h(s[0 * 33], s[1 * 33]); o.y = pk2h(s[2 * 33], s[3 * 33]); o.z = pk2h(s[4 * 33], s[5 * 33]); o.w = pk2h(s[6 * 33], s[7 * 33]);
        if (n0 + n < N) *(u32x4*)(WT + (size_t)row_of(n0 + n) * K + k0 + 8 * c) = o; }
    asm volatile("s_waitcnt lgkmcnt(0)" ::: "memory");
}
__device__ __forceinline__ void rms_row(const float* __restrict__ xrow, const float* __restrict__ gain, h16* __restrict__ orow, int lane) {
    const f32x4* xr = (const f32x4*)xrow + lane;
    f32x4 v[4]; float s = 0.f;
#pragma unroll
    for (int j = 0; j < 4; ++j) { v[j] = xr[64 * j]; s += (v[j].x * v[j].x + v[j].y * v[j].y) + (v[j].z * v[j].z + v[j].w * v[j].w); }
    const float r = rsqrtf(wave_sum(s) * (1.f / DM) + RMS_EPS);
    u32x2* o8 = (u32x2*)orow + lane;
#pragma unroll
    for (int j = 0; j < 4; ++j) { const f32x4 g = ((const f32x4*)gain)[lane + 64 * j]; u32x2 w; w.x = pk2h(v[j].x * r * g.x, v[j].y * r * g.y); w.y = pk2h(v[j].z * r * g.z, v[j].w * r * g.w); o8[64 * j] = w; }
}
__device__ __forceinline__ void phase_prologue(const Params& p, LAS unsigned char* lds, int bid, int nblk) {
    const int tid = opaque_tid(), lane = tid & 63, wave = tid >> 6;
    LAS float* scr = (LAS float*)(lds + wave * 16384);
    const int gw = bid * NWAVE + wave, NGW = nblk * NWAVE;
    h16* W1T = (h16*)(p.ws + WS_W1T); h16* W2T = (h16*)(p.ws + WS_W2T); h16* HN = (h16*)(p.ws + WS_HN);
    constexpr int I1 = (DM / 64) * ((NPROJ + 31) / 32), I2 = (DM / 64) * (DM / 32);
    for (int it = gw; it < I1 + I2; it += NGW) {
        if (it < I1) transpose_item(p.w_in, DM, NPROJ, W1T, scr, it, lane, [](int c) { return w1_row_of_col(c); });
        else transpose_item(p.w_out, DM, DM, W2T, scr, it - I1, lane, [](int c) { return (c & ~255) + phys_of_logical2(c & 255); });
    }
    for (int m = gw; m < MTOK; m += 4 * NGW) {
        f32x4 v[4][4];
#pragma unroll
        for (int r = 0; r < 4; ++r)
#pragma unroll
            for (int j = 0; j < 4; ++j) v[r][j] = ((const f32x4*)(p.x + (size_t)(m + r * NGW) * DM))[lane + 64 * j];
#pragma unroll
        for (int r = 0; r < 4; ++r) {
            float ss = 0.f;
#pragma unroll
            for (int j = 0; j < 4; ++j) ss += (v[r][j].x * v[r][j].x + v[r][j].y * v[r][j].y) + (v[r][j].z * v[r][j].z + v[r][j].w * v[r][j].w);
            const float rs = rsqrtf(wave_sum(ss) * (1.f / DM) + RMS_EPS);
            u32x2* o8 = (u32x2*)(HN + (size_t)(m + r * NGW) * DM) + lane;
#pragma unroll
            for (int j = 0; j < 4; ++j) { const f32x4 g = ((const f32x4*)p.norm_gain)[lane + 64 * j]; u32x2 w; w.x = pk2h(v[r][j].x * rs * g.x, v[r][j].y * rs * g.y); w.y = pk2h(v[r][j].z * rs * g.z, v[r][j].w * rs * g.w); o8[64 * j] = w; }
        }
    }
}
__device__ __forceinline__ void phase_gemm1(const Params& p, LAS unsigned char* lds, int bid, int nblk) {
    pg8::Gemm g{(const h16*)(p.ws + WS_HN), (const h16*)(p.ws + WS_W1T), MTOK, N1PAD, DM};
    pg8::StaticOrder S; S.init(MTOK, N1PAD, nblk, bid);
    EpiProj E{p.ws, p.qg, p.kg};
    pg8::gemm_phase<EpiProj, pg8::StaticOrder, true, true>(lds, g, S, E);
}

constexpr int KW_STR = 528;
__device__ __forceinline__ void phase_kiwi(const Params& p, LAS unsigned char* lds, int bid, int nblk) {
    const int tid = opaque_tid(), lane = tid & 63, wv = __builtin_amdgcn_readfirstlane(tid >> 6), r32 = lane & 31, hh = lane >> 5;
    const h16* HN = (const h16*)(p.ws + WS_HN); const h16* W3 = (const h16*)(p.ws + WS_W1T) + (size_t)W3ROW * DM;
    const int rt = wv & 1, ct = wv >> 1;
    for (int blk = bid; blk < MTOK / 64; blk += nblk) {
        const int tok0 = blk * 64;
        f32x16 acc = f32x16{};
        u32x4 stg[10];
#define KW_LOAD(KC) _Pragma("unroll") for (int i = 0; i < 10; ++i) { const int idx = tid + 512 * i; const int row = idx >> 5, ch = idx & 31; \
                const h16* src = row < 64 ? HN + (size_t)(tok0 + row) * DM + (KC) * 256 + ch * 8 : W3 + (size_t)(row - 64) * DM + (KC) * 256 + ch * 8; stg[i] = *(const u32x4*)src; }
        KW_LOAD(0)
        for (int kc = 0; kc < 4; ++kc) {
            __syncthreads();
#pragma unroll
            for (int i = 0; i < 10; ++i) { const int idx = tid + 512 * i; *(LAS u32x4*)(lds + (idx >> 5) * KW_STR + (idx & 31) * 16) = stg[i]; }
            if (kc < 3) { KW_LOAD(kc + 1) }
            asm volatile("s_waitcnt lgkmcnt(0)\n\ts_barrier" ::: "memory");
            if (ct < 3) {
                LAS const unsigned char* ap = lds + (64 + ct * 32 + r32) * KW_STR + hh * 16;
                LAS const unsigned char* bp = lds + (rt * 32 + r32) * KW_STR + hh * 16;
#pragma unroll
                for (int ks = 0; ks < 16; ++ks) acc = __builtin_amdgcn_mfma_f32_32x32x16_f16(*(LAS const h16x8*)(ap + ks * 32), *(LAS const h16x8*)(bp + ks * 32), acc, 0, 0, 0);
            }
        }
#undef KW_LOAD
        const size_t tok = (size_t)(tok0 + rt * 32 + r32);
        if (ct < 2) {
            h16* o = (h16*)(p.ws + WS_KI) + tok * 64 + ct * 32 + 4 * hh;
#pragma unroll
            for (int g = 0; g < 4; ++g) { u32x2 w; w.x = pk2h(acc[4 * g], acc[4 * g + 1]); w.y = pk2h(acc[4 * g + 2], acc[4 * g + 3]); *(u32x2*)(o + 8 * g) = w; }
        } else if (ct == 2) {
            float* o = (float*)(p.ws + WS_WI) + tok * 16 + 4 * hh;
#pragma unroll
            for (int g = 0; g < 2; ++g) *(f32x4*)(o + 8 * g) = (f32x4){acc[4 * g] * IDXS, acc[4 * g + 1] * IDXS, acc[4 * g + 2] * IDXS, acc[4 * g + 3] * IDXS};
        }
    }
}
__device__ __forceinline__ void phase_gemm2(const Params& p, LAS unsigned char* lds, int bid, int nblk) {
    pg8::Gemm g{(const h16*)(p.ws + WS_MIX), (const h16*)(p.ws + WS_W2T), MTOK, DM, DM};
    pg8::StaticOrder S; S.init(MTOK, DM, nblk, bid);
    EpiOut E{p.x, p.out};
    pg8::gemm_phase<EpiOut, pg8::StaticOrder, true, true>(lds, g, S, E);
}
#define XB_TMO      128
#define XB_XCNT(j)  (256  + 64 * (j))
#define XB_XSUB(j)  (1280 + 64 * (j))
#define XB_XGEN(j)  (2304 + 64 * (j))
#define XB_TOP      3328
#define XB_TOPGEN   3392
#define XCD_BAR_WORDS 3456
#define XB_SPIN_CAP (1u << 22)
__device__ __forceinline__ unsigned xb_ld(unsigned* p)              { return __hip_atomic_load(p, __ATOMIC_RELAXED, __HIP_MEMORY_SCOPE_AGENT); }
__device__ __forceinline__ unsigned xb_add(unsigned* p, unsigned v) { return __hip_atomic_fetch_add(p, v, __ATOMIC_RELAXED, __HIP_MEMORY_SCOPE_AGENT); }
__device__ __forceinline__ unsigned xb_xcc_id() { return (unsigned)__builtin_amdgcn_s_getreg((3 << 11) | 20) & 0xFu; }
#define XB_SPIN(cond, bar) do { unsigned _sp = 0; while (cond) { __builtin_amdgcn_s_sleep(1); \
    if ((++_sp & 255u) == 0u) { if (xb_ld(&(bar)[XB_TMO])) break; if (_sp > XB_SPIN_CAP) { atomicAdd(&(bar)[XB_TMO], 1u); break; } } } } while (0)
struct XcdBarrier { unsigned* bar; unsigned x; volatile LAS unsigned* st; };
__device__ __forceinline__ XcdBarrier xcd_barrier_post(unsigned* bar, volatile LAS unsigned* st) {
    XcdBarrier b; b.bar = bar; b.x = xb_xcc_id(); b.st = st;
    if (threadIdx.x == 0) (void)xb_add(&bar[XB_XCNT(b.x)], 1u);
    return b;
}
__device__ __forceinline__ void xcd_barrier_complete(unsigned* bar, unsigned x, unsigned& nloc, unsigned& nx) {
    const unsigned G = gridDim.x * gridDim.y * gridDim.z;
    unsigned sum, cnt, mine, sp = 0u;
    for (;;) {
        sum = 0u; cnt = 0u; mine = 0u;
#pragma unroll
        for (unsigned j = 0; j < 16; ++j) { const unsigned c = xb_ld(&bar[XB_XCNT(j)]); sum += c; cnt += (c > 0u) ? 1u : 0u; mine = (j == x) ? c : mine; }
        if (sum == G) break;
        __builtin_amdgcn_s_sleep(1);
        if ((++sp & 255u) == 0u) { if (xb_ld(&bar[XB_TMO])) break; if (sp > XB_SPIN_CAP) { atomicAdd(&bar[XB_TMO], 1u); break; } }
    }
    nloc = mine > 0u ? mine : 1u; nx = cnt > 0u ? cnt : 1u;
}
__device__ __forceinline__ void xcd_barrier(const XcdBarrier& b) {
    asm volatile("s_waitcnt vmcnt(0)" ::: "memory");
    __syncthreads();
    if (threadIdx.x == 0) {
        unsigned* bar = b.bar;
        __builtin_amdgcn_s_waitcnt(0);
        unsigned nloc = b.st[0], nx = b.st[1];
        if (nloc == 0u) { xcd_barrier_complete(bar, b.x, nloc, nx); b.st[0] = nloc; b.st[1] = nx; }
        const unsigned old = xb_add(&bar[XB_XSUB(b.x)], 1u);
        const unsigned gen = old / nloc;
        if (old + 1u == (gen + 1u) * nloc) {
            __builtin_amdgcn_fence(__ATOMIC_RELEASE, "agent");
            asm volatile("s_waitcnt vmcnt(0)" ::: "memory");
            const unsigned og = xb_add(&bar[XB_TOP], 1u);
            const unsigned tg = og / nx;
            if (og + 1u == (tg + 1u) * nx) xb_add(&bar[XB_TOPGEN], 1u);
            else XB_SPIN(xb_ld(&bar[XB_TOPGEN]) == tg, bar);
            xb_add(&bar[XB_XGEN(b.x)], 1u);
            __builtin_amdgcn_fence(__ATOMIC_ACQUIRE, "agent");
            asm volatile("s_waitcnt vmcnt(0)" ::: "memory");
        } else {
            XB_SPIN(xb_ld(&bar[XB_XGEN(b.x)]) == gen, bar);
            __builtin_amdgcn_fence(__ATOMIC_ACQUIRE, "agent");
            asm volatile("s_waitcnt vmcnt(0)" ::: "memory");
        }
    }
    __syncthreads();
}
#define XB_FLAT(k)  (3520 + 64 * (k))
__device__ __forceinline__ void flat_arrive(const XcdBarrier& b, int k) {
    asm volatile("s_waitcnt vmcnt(0)" ::: "memory");
    __syncthreads();
    if (threadIdx.x == 0) (void)xb_add(&b.bar[XB_FLAT(k)], 1u);
}
__device__ __forceinline__ void flat_wait(const XcdBarrier& b, int k) {
    if (threadIdx.x == 0) { const unsigned G = gridDim.x * gridDim.y * gridDim.z; XB_SPIN(xb_ld(&b.bar[XB_FLAT(k)]) < G, b.bar); }
    __syncthreads();
}
__device__ __forceinline__ int crow(int r, int hi) { return (r & 3) + 8 * (r >> 2) + 4 * hi; }
constexpr int KSTR = 144, VSTR = 192;
constexpr int KT_BYTES = 64 * KSTR, VT_BYTES = 64 * VSTR;
constexpr int MT_BYTES = 2048;
constexpr int ATT_BUF = KT_BYTES + VT_BYTES + MT_BYTES;
constexpr int ATT_TAB = 2 * ATT_BUF;
constexpr int OSTR = 144, ATT_OST = ATT_TAB + 2304;
constexpr float SB_EXIT = 64.f;
__device__ __forceinline__ s16x4 vtr(LAS const unsigned char* p) { return __builtin_amdgcn_ds_read_tr16_b64_v4i16((LAS s16x4*)p); }
__device__ __forceinline__ h16x8 mk8(s16x4 a, s16x4 b) { typedef short s16x8 __attribute__((ext_vector_type(8))); s16x8 r = {a[0], a[1], a[2], a[3], b[0], b[1], b[2], b[3]}; return __builtin_bit_cast(h16x8, r); }
__device__ __forceinline__ h16x8 pack8(float a0, float a1, float a2, float a3, float a4, float a5, float a6, float a7) {
    u32x4 w; w.x = pk2h(a0, a1); w.y = pk2h(a2, a3); w.z = pk2h(a4, a5); w.w = pk2h(a6, a7); return __builtin_bit_cast(h16x8, w); }
__device__ __forceinline__ float bcast_lo(float v) { const unsigned u = __float_as_uint(v); auto rr = __builtin_amdgcn_permlane32_swap(u, u, false, false); return __uint_as_float(rr[0]); }
__device__ __forceinline__ f32x16 splat16(float v) { f32x16 r;
#pragma unroll
    for (int i = 0; i < 16; ++i) r[i] = v;
    return r; }

struct KVStage { u32x4 k, v; unsigned m; };
template <bool MASK>
__device__ __forceinline__ void kv_load(KVStage& st, const h16* Kg, const h16* Vg, const unsigned* Mg, int tile, int tid) {
    const size_t off = (size_t)(tile * 64 + (tid >> 3)) * 512 + (tid & 7) * 8;
    const h16* kp = Kg + off; const h16* vp = Vg + off;
    asm volatile("global_load_dwordx4 %0, %1, off" : "=v"(st.k) : "v"(kp) : "memory");
    asm volatile("global_load_dwordx4 %0, %1, off" : "=v"(st.v) : "v"(vp) : "memory");
    if (MASK) { const unsigned* mp = Mg + (size_t)(2 * tile + (tid >> 8)) * SEQ + (tid & 255); asm volatile("global_load_dword %0, %1, off" : "=v"(st.m) : "v"(mp) : "memory"); }
}
template <int N>
__device__ __forceinline__ void kv_wait(KVStage& st) {
    asm volatile("s_waitcnt vmcnt(%0)" :: "n"(N) : "memory");
    asm volatile("" : "+v"(st.k), "+v"(st.v), "+v"(st.m));
}
template <bool MASK>
__device__ __forceinline__ void kv_store(const KVStage& st, LAS unsigned char* buf, int tid) {
    *(LAS u32x4*)(buf + (tid >> 3) * KSTR + (tid & 7) * 16) = st.k;
    *(LAS u32x4*)(buf + KT_BYTES + (tid >> 3) * VSTR + (tid & 7) * 16) = st.v;
    if (MASK) *(LAS unsigned*)(buf + KT_BYTES + VT_BYTES + tid * 4) = st.m;
}
__device__ __forceinline__ f32x16 qk_tile(LAS const unsigned char* kb, int sub, const h16x8 (&qf)[4], int r32, int hh, f32x16 cinit = f32x16{}) {
    LAS const unsigned char* kp = kb + (sub * 32 + r32) * KSTR + hh * 16;
    f32x16 acc = cinit;
#pragma unroll
    for (int ks = 0; ks < 4; ++ks) { const h16x8 kf = *(LAS const h16x8*)(kp + ks * 32); acc = __builtin_amdgcn_mfma_f32_32x32x16_f16(kf, qf[ks], acc, 0, 0, 0); }
    return acc;
}
__device__ __forceinline__ void pv_tile(f32x16 (&o)[2], LAS const unsigned char* vb, int sub, const h16x8 (&pa)[2], int lane) {
    const int g = lane >> 4, i = lane & 15, q = i >> 2, pp = i & 3;
    LAS const unsigned char* vp = vb + (sub * 32 + 4 * (g >> 1) + q) * VSTR + (16 * (g & 1) + 4 * pp) * 2;
#pragma unroll
    for (int db = 0; db < 2; ++db)
#pragma unroll
        for (int s2 = 0; s2 < 2; ++s2) {
            const s16x4 lo = vtr(vp + (16 * s2) * VSTR + db * 64), hi = vtr(vp + (16 * s2 + 8) * VSTR + db * 64);
            o[db] = __builtin_amdgcn_mfma_f32_32x32x16_f16(pa[s2], mk8(lo, hi), o[db], 0, 0, 0);
        }
}
__device__ __forceinline__ void att_store(const f32x16 (&o)[2], LAS unsigned char* ost, const LAS float* rs, const h16* Gg, h16* Og, int qw, int lane) {
    const int r32 = lane & 31, hh = lane >> 5;
#pragma unroll
    for (int db = 0; db < 2; ++db)
#pragma unroll
        for (int r = 0; r < 16; ++r) *(LAS h16*)(ost + crow(r, hh) * OSTR + (32 * db + r32) * 2) = (h16)o[db][r];
    asm volatile("s_waitcnt lgkmcnt(0)" ::: "memory");
    const int ch = lane & 7;
#pragma unroll
    for (int i = 0; i < 4; ++i) {
        const int row = 8 * i + (lane >> 3);
        const float sc = rs ? 1.f / rs[row] : 1.f;
        const size_t tok = (size_t)(qw + row);
        const h16x8 ov = *(const LAS h16x8*)(ost + row * OSTR + ch * 16);
        const h16x8 gv = *(const h16x8*)(Gg + tok * 512 + ch * 8);
        u32x4 w;
        w.x = pk2h((float)ov[0] * sc * (float)gv[0], (float)ov[1] * sc * (float)gv[1]); w.y = pk2h((float)ov[2] * sc * (float)gv[2], (float)ov[3] * sc * (float)gv[3]);
        w.z = pk2h((float)ov[4] * sc * (float)gv[4], (float)ov[5] * sc * (float)gv[5]); w.w = pk2h((float)ov[6] * sc * (float)gv[6], (float)ov[7] * sc * (float)gv[7]);
        *(u32x4*)(Og + tok * 1024 + ch * 8) = w;
    }
}
__device__ __forceinline__ void k_frags(h16x8 (&kf)[4], LAS const unsigned char* kb, int sub, int r32, int hh) {
    LAS const unsigned char* kp = kb + (sub * 32 + r32) * KSTR + hh * 16;
#pragma unroll
    for (int ks = 0; ks < 4; ++ks) kf[ks] = *(LAS const h16x8*)(kp + ks * 32);
}
__device__ __forceinline__ void v_frags(h16x8 (&vf)[2][2], LAS const unsigned char* vb, int sub, int lane) {
    const int g = lane >> 4, i = lane & 15, q = i >> 2, pp = i & 3;
    LAS const unsigned char* vp = vb + (sub * 32 + 4 * (g >> 1) + q) * VSTR + (16 * (g & 1) + 4 * pp) * 2;
#pragma unroll
    for (int db = 0; db < 2; ++db)
#pragma unroll
        for (int s2 = 0; s2 < 2; ++s2) vf[db][s2] = mk8(vtr(vp + (16 * s2) * VSTR + db * 64), vtr(vp + (16 * s2 + 8) * VSTR + db * 64));
}
__device__ __forceinline__ f32x16 qk_mma(const h16x8 (&kf)[4], const h16x8 (&qf)[4], f32x16 acc) {
#pragma unroll
    for (int ks = 0; ks < 4; ++ks) acc = __builtin_amdgcn_mfma_f32_32x32x16_f16(kf[ks], qf[ks], acc, 0, 0, 0);
    return acc;
}
__device__ __forceinline__ void pv_mma(f32x16 (&o)[2], const h16x8 (&vf)[2][2], const h16x8 (&pa)[2]) {
#pragma unroll
    for (int db = 0; db < 2; ++db)
#pragma unroll
        for (int s2 = 0; s2 < 2; ++s2) o[db] = __builtin_amdgcn_mfma_f32_32x32x16_f16(pa[s2], vf[db][s2], o[db], 0, 0, 0);
}

typedef short b16x8 __attribute__((ext_vector_type(8)));
__device__ __forceinline__ b16x8 pack8b(float a0, float a1, float a2, float a3, float a4, float a5, float a6, float a7) {
    u32x4 w; w.x = pk2b(a0, a1); w.y = pk2b(a2, a3); w.z = pk2b(a4, a5); w.w = pk2b(a6, a7); return __builtin_bit_cast(b16x8, w); }
__device__ __forceinline__ void pv_mma_b(f32x16 (&o)[2], const h16x8 (&vf)[2][2], const b16x8 (&pa)[2]) {
#pragma unroll
    for (int db = 0; db < 2; ++db)
#pragma unroll
        for (int s2 = 0; s2 < 2; ++s2) o[db] = __builtin_amdgcn_mfma_f32_32x32x16_bf16(pa[s2], __builtin_bit_cast(b16x8, vf[db][s2]), o[db], 0, 0, 0);
}
#define SCHED_FENCE() __builtin_amdgcn_sched_barrier(0)
#define LDS_BARRIER() asm volatile("s_waitcnt lgkmcnt(0)\n\ts_barrier" ::: "memory")
__device__ __forceinline__ void att_unit(int u, int& b, int& h, int& qb) { const int pass = u >> 8, x = u & 7, m = (u >> 3) & 31; h = x; b = 4 * pass + (m & 3); qb = pass ? (m >> 2) : 7 - (m >> 2); }


constexpr int HALF_LDS = 65536;
constexpr int MISC_OFF = 131072;
struct Half { int hf, ht, hw, lane; LAS unsigned char* lds; LAS unsigned* bar; unsigned tgt; };
__device__ __forceinline__ Half half_init(LAS unsigned char* lds_all) {
    const int tid = opaque_tid(); Half H;
    H.hf = __builtin_amdgcn_readfirstlane(tid >> 8); H.ht = tid & 255; H.hw = __builtin_amdgcn_readfirstlane((tid >> 6) & 3); H.lane = tid & 63;
    H.lds = lds_all + H.hf * HALF_LDS; H.bar = (LAS unsigned*)(lds_all + MISC_OFF + 64 + 64 * H.hf); H.tgt = 0u;
    return H;
}
__device__ __forceinline__ void half_barrier(Half& H) {
    asm volatile("s_waitcnt lgkmcnt(0)" ::: "memory");
    H.tgt += 4u;
    if (H.lane == 0) (void)__hip_atomic_fetch_add(H.bar, 1u, __ATOMIC_RELAXED, __HIP_MEMORY_SCOPE_WORKGROUP);
    while (__hip_atomic_load(H.bar, __ATOMIC_RELAXED, __HIP_MEMORY_SCOPE_WORKGROUP) < H.tgt) __builtin_amdgcn_s_sleep(1);
    asm volatile("" ::: "memory");
}
constexpr int H_MT = 1024;
constexpr int H_BUF = KT_BYTES + VT_BYTES + H_MT;
constexpr int H_MISC = 2 * H_BUF;
constexpr int H_OST = H_MISC + 2048;
struct KV2 { u32x4 k[2], v[2]; unsigned m; };
template <bool MASK>
__device__ __forceinline__ void kv2_load(KV2& st, const h16* Kg, const h16* Vg, const unsigned* Mq, int tile, int ht) {
#pragma unroll
    for (int i = 0; i < 2; ++i) { const int idx = ht + 256 * i; const size_t off = (size_t)(tile * 64 + (idx >> 3)) * 512 + (idx & 7) * 8; st.k[i] = *(const u32x4*)(Kg + off); st.v[i] = *(const u32x4*)(Vg + off); }
    if (MASK) st.m = Mq[(size_t)(2 * tile + (ht >> 7)) * SEQ + (ht & 127)];
}
template <bool MASK>
__device__ __forceinline__ void kv2_store(const KV2& st, LAS unsigned char* buf, int ht) {
#pragma unroll
    for (int i = 0; i < 2; ++i) { const int idx = ht + 256 * i; *(LAS u32x4*)(buf + (idx >> 3) * KSTR + (idx & 7) * 16) = st.k[i]; *(LAS u32x4*)(buf + KT_BYTES + (idx >> 3) * VSTR + (idx & 7) * 16) = st.v[i]; }
    if (MASK) *(LAS unsigned*)(buf + KT_BYTES + VT_BYTES + ht * 4) = st.m;
}
__device__ __forceinline__ void att2_unit(int u, int& b, int& h, int& q16) {
    const int pass = u >> 9, v = u & 511, hf = v & 1, blk = v >> 1, x = blk & 7, e = 2 * (blk >> 3) + hf;
    h = x; b = 4 * pass + (e & 3); q16 = pass ? (e >> 2) : 15 - (e >> 2);
}
__device__ __forceinline__ void sb_softplus(const f32x16& z, h16x8 (&lf)[2], bool dg, int r32, int hh) {
    float L[16];
#pragma unroll
    for (int r = 0; r < 16; ++r) { float l = __builtin_amdgcn_logf(1.f + __builtin_amdgcn_exp2f(z[r])); if (dg && crow(r, hh) >= r32) l = 0.f; L[r] = l; }
    lf[0] = pack8(L[0], L[1], L[2], L[3], L[4], L[5], L[6], L[7]); lf[1] = pack8(L[8], L[9], L[10], L[11], L[12], L[13], L[14], L[15]);
}
__device__ __forceinline__ void sb_weights(const f32x16& z, const f32x16& y, h16x8 (&pa)[2], bool dg, int r32, int hh) {
    float A[16];
#pragma unroll
    for (int r = 0; r < 16; ++r) { float a = __builtin_amdgcn_exp2f(z[r] - y[r]); if (dg && crow(r, hh) >= r32) a = 0.f; A[r] = a; }
    pa[0] = pack8(A[0], A[1], A[2], A[3], A[4], A[5], A[6], A[7]); pa[1] = pack8(A[8], A[9], A[10], A[11], A[12], A[13], A[14], A[15]);
}
__device__ __forceinline__ f32x16 sb_cum(const h16x8 (&tri)[2], const h16x8 (&lf)[2], float carry) {
    f32x16 y = splat16(carry);
    y = __builtin_amdgcn_mfma_f32_32x32x16_f16(tri[0], lf[0], y, 0, 0, 0);
    y = __builtin_amdgcn_mfma_f32_32x32x16_f16(tri[1], lf[1], y, 0, 0, 0);
    return y;
}

__device__ __forceinline__ void sb2_unit(const Params& p, Half& H, int b, int h, int q16) {
    const int lane = H.lane, hw = H.hw, ht = H.ht, r32 = lane & 31, hh = lane >> 5;
    LAS unsigned char* lds = H.lds;
    const h16* Qg = (const h16*)(p.ws + WS_QB) + (size_t)b * SEQ * 512 + h * 64;
    const h16* Kg = (const h16*)(p.ws + WS_KB) + (size_t)b * SEQ * 512 + h * 64;
    const h16* Vg = (const h16*)(p.ws + WS_VB) + (size_t)b * SEQ * 512 + h * 64;
    const h16* Gg = (const h16*)(p.ws + WS_GB) + (size_t)b * SEQ * 512 + h * 64;
    h16* Og = (h16*)(p.ws + WS_MIX) + (size_t)b * SEQ * 1024 + 512 + h * 64;
    const int q0 = q16 * 128, qw = q0 + hw * 32;
    const int jmax = 2 * q16 + 1, diag = qw >> 5;
    KV2 st; kv2_load<false>(st, Kg, Vg, nullptr, jmax, ht);
    h16x8 qf[4];
#pragma unroll
    for (int ks = 0; ks < 4; ++ks) qf[ks] = *(const h16x8*)(Qg + (size_t)(qw + r32) * 512 + ks * 16 + hh * 8);
    h16x8 tri[2];
#pragma unroll
    for (int s2 = 0; s2 < 2; ++s2)
#pragma unroll
        for (int jj = 0; jj < 8; ++jj) { const int j = 16 * s2 + 8 * (jj >> 2) + 4 * hh + (jj & 3); tri[s2][jj] = (j >= r32) ? (h16)1.0f : (h16)0.0f; }
    f32x16 o[2]; o[0] = f32x16{}; o[1] = f32x16{};
    LAS unsigned* flg = (LAS unsigned*)(lds + H_MISC + 1536);
    float carry = 0.f;
    asm volatile("" : "+v"(qf[0]), "+v"(qf[1]), "+v"(qf[2]), "+v"(qf[3]));
    int cur = 0;
    kv2_store<false>(st, lds, ht);
    half_barrier(H);
    const int jd = diag >> 1;
    int j = jmax; bool fin = false;
#define SB_STAGE_IN()  if (j > 0) kv2_load<false>(st, Kg, Vg, nullptr, j - 1, ht); \
        LAS const unsigned char* kb = lds + cur * H_BUF; LAS const unsigned char* vb = kb + KT_BYTES;
#define SB_STAGE_OUT() if (j > 0) kv2_store<false>(st, lds + (cur ^ 1) * H_BUF, ht); \
        if (lane == 0) flg[(j & 1) * 4 + hw] = (2 * j <= diag && __all(carry > SB_EXIT)) ? 1u : 0u; \
        half_barrier(H); \
        cur ^= 1; \
        { const unsigned f = flg[(j & 1) * 4 + (lane & 3)]; if (__all(f != 0u)) fin = true; }
    for (; j > jd && !fin; --j) { SB_STAGE_IN() (void)kb; (void)vb; SB_STAGE_OUT() }
    if (!fin && j == jd) {
        SB_STAGE_IN()
#pragma unroll
        for (int sub = 1; sub >= 0; --sub) {
            const int si = 2 * j + sub;
            if (si <= diag) {
                const bool dg = (si == diag);
                const f32x16 z = qk_tile(kb, sub, qf, r32, hh);
                h16x8 lf[2], pa[2];
                sb_softplus(z, lf, dg, r32, hh);
                const f32x16 y = sb_cum(tri, lf, carry);
                sb_weights(z, y, pa, dg, r32, hh);
                carry = bcast_lo(y[0]);
                pv_tile(o, vb, sub, pa, lane);
            }
        }
        SB_STAGE_OUT()
        --j;
    }
    for (; j >= 0 && !fin; --j) {
        SB_STAGE_IN()
        const f32x16 z1 = qk_tile(kb, 1, qf, r32, hh);
        const f32x16 z0 = qk_tile(kb, 0, qf, r32, hh);
        h16x8 lf1[2], lf0[2], pa1[2], pa0[2];
        sb_softplus(z1, lf1, false, r32, hh);
        const f32x16 y1 = sb_cum(tri, lf1, carry);
        sb_softplus(z0, lf0, false, r32, hh);
        const float c1 = bcast_lo(y1[0]);
        const f32x16 y0 = sb_cum(tri, lf0, c1);
        sb_weights(z1, y1, pa1, false, r32, hh);
        pv_tile(o, vb, 1, pa1, lane);
        sb_weights(z0, y0, pa0, false, r32, hh);
        pv_tile(o, vb, 0, pa0, lane);
        carry = bcast_lo(y0[0]);
        SB_STAGE_OUT()
    }
#undef SB_STAGE_IN
#undef SB_STAGE_OUT
    att_store(o, lds + H_OST + hw * (32 * OSTR), nullptr, Gg, Og, qw, lane);
}
__device__ __forceinline__ void phase_sb2(const Params& p, Half& H, int bid, int nblk) {
    for (int u = 2 * bid + H.hf; u < 1024; u += 2 * nblk) { int b, h, q16; att2_unit(u, b, h, q16); sb2_unit(p, H, b, h, q16); }
}
__device__ __forceinline__ void sa_probs(const f32x16& s, unsigned mw, const LAS float* btab, bool nearby, b16x8 (&pa)[2], f32x16& osum, const b16x8& ones, int hh) {
    float P[16];
    if (nearby) {
#pragma unroll
        for (int r = 0; r < 16; ++r) P[r] = __builtin_amdgcn_exp2f(s[r] + btab[27 - ((r & 3) + 8 * (r >> 2))]);
    } else {
#pragma unroll
        for (int r = 0; r < 16; ++r) P[r] = __builtin_amdgcn_exp2f(s[r]);
    }
#pragma unroll
    for (int r = 0; r < 16; ++r) { const int bit = (r & 3) + 8 * (r >> 2); unsigned m_; asm("v_bfe_i32 %0, %1, %2, 1" : "=v"(m_) : "v"(mw), "n"(bit)); P[r] = __uint_as_float(__float_as_uint(P[r]) & m_); }
    pa[0] = pack8b(P[0], P[1], P[2], P[3], P[4], P[5], P[6], P[7]); pa[1] = pack8b(P[8], P[9], P[10], P[11], P[12], P[13], P[14], P[15]);
    osum = __builtin_amdgcn_mfma_f32_32x32x16_bf16(pa[0], ones, osum, 0, 0, 0);
    osum = __builtin_amdgcn_mfma_f32_32x32x16_bf16(pa[1], ones, osum, 0, 0, 0);
}
constexpr int A_KT = 128 * KSTR, A_VT = 128 * VSTR, A_MT = 4096;
constexpr int A_BUF = A_KT + A_VT + A_MT;
constexpr int A_TAB = 2 * A_BUF;
struct KV1 { u32x4 k[2], v[2]; unsigned m[2]; };
__device__ __forceinline__ void kv1_load(KV1& st, const h16* Kg, const h16* Vg, const unsigned* Mq, int tile, int tid) {
#pragma unroll
    for (int i = 0; i < 2; ++i) { const int idx = tid + 512 * i; const size_t off = (size_t)(tile * 128 + (idx >> 3)) * 512 + (idx & 7) * 8;
        st.k[i] = *(const u32x4*)(Kg + off); st.v[i] = *(const u32x4*)(Vg + off);
        st.m[i] = __hip_atomic_load(Mq + (size_t)(4 * tile + (idx >> 8)) * SEQ + (idx & 255), __ATOMIC_RELAXED, __HIP_MEMORY_SCOPE_AGENT); }
}
__device__ __forceinline__ void kv1_store(const KV1& st, LAS unsigned char* buf, int tid) {
#pragma unroll
    for (int i = 0; i < 2; ++i) { const int idx = tid + 512 * i;
        *(LAS u32x4*)(buf + (idx >> 3) * KSTR + (idx & 7) * 16) = st.k[i];
        *(LAS u32x4*)(buf + A_KT + (idx >> 3) * VSTR + (idx & 7) * 16) = st.v[i];
        *(LAS unsigned*)(buf + A_KT + A_VT + idx * 4) = st.m[i]; }
}
__device__ __forceinline__ void sa_unit(const Params& p, LAS unsigned char* lds, int b, int h, int qb) {
    const int tid = opaque_tid(), lane = tid & 63, wv = __builtin_amdgcn_readfirstlane(tid >> 6), r32 = lane & 31, hh = lane >> 5;
    const h16* Qg = (const h16*)(p.ws + WS_QA) + (size_t)b * SEQ * 512 + h * 64;
    const h16* Kg = (const h16*)(p.ws + WS_KA) + (size_t)b * SEQ * 512 + h * 64;
    const h16* Vg = (const h16*)(p.ws + WS_VA) + (size_t)b * SEQ * 512 + h * 64;
    const h16* Gg = (const h16*)(p.ws + WS_GA) + (size_t)b * SEQ * 512 + h * 64;
    h16* Og = (h16*)(p.ws + WS_MIX) + (size_t)b * SEQ * 1024 + h * 64;
    const int q0 = qb * 256, qw = q0 + wv * 32;
    const unsigned* Mq = (const unsigned*)(p.ws + WS_MASK) + (size_t)b * 64 * SEQ + q0;
    LAS float* btab = (LAS float*)(lds + A_TAB);
    LAS float* lx = (LAS float*)(lds + A_TAB + 1280);
    const int jmax = 2 * qb + 1, diag = qw >> 5;
    KV1 st; kv1_load(st, Kg, Vg, Mq, 0, tid);
    __syncthreads();
    if (tid < 320) { const int d = tid - 32; btab[tid] = (p.rel_bias[T5_BUCKET[d < 0 ? 0 : (d > 127 ? 127 : d)] * 8 + h] - p.rel_bias[31 * 8 + h]) * LOG2E; }
    h16x8 qf[4];
#pragma unroll
    for (int ks = 0; ks < 4; ++ks) qf[ks] = *(const h16x8*)(Qg + (size_t)(qw + r32) * 512 + ks * 16 + hh * 8);
    f32x16 o[2]; o[0] = f32x16{}; o[1] = f32x16{};
    f32x16 osum = f32x16{};
    b16x8 ones;
#pragma unroll
    for (int i = 0; i < 8; ++i) ones[i] = (short)0x3F80;
    const int tq = qw + r32;
    asm volatile("" : "+v"(qf[0]), "+v"(qf[1]), "+v"(qf[2]), "+v"(qf[3]));
    int cur = 0;
    kv1_store(st, lds, tid);
    __syncthreads();
    const int jf = (qw - 112) > 0 ? ((qw - 112) >> 7) : 0;
    const int jd = diag >> 2;
    int j = 0;
#define SA_STAGE_IN()  if (j < jmax) kv1_load(st, Kg, Vg, Mq, j + 1, tid); \
        LAS const unsigned char* kb = lds + cur * A_BUF; LAS const unsigned char* vb = kb + A_KT; \
        const LAS unsigned* mb = (const LAS unsigned*)(kb + A_KT + A_VT) + wv * 32 + r32;
#define SA_STAGE_OUT() if (j < jmax) kv1_store(st, lds + (cur ^ 1) * A_BUF, tid); \
        LDS_BARRIER(); \
        cur ^= 1;
    for (; j < jf; ++j) {
        SA_STAGE_IN()
#pragma unroll
        for (int pr = 0; pr < 2; ++pr) {
            const unsigned mw0 = mb[(2 * pr) * 256] >> (4 * hh), mw1 = mb[(2 * pr + 1) * 256] >> (4 * hh);
            h16x8 kf0[4], kf1[4], vf0[2][2], vf1[2][2]; b16x8 pa0[2], pa1[2];
            k_frags(kf0, kb, 2 * pr, r32, hh); k_frags(kf1, kb, 2 * pr + 1, r32, hh); v_frags(vf0, vb, 2 * pr, lane);
            SCHED_FENCE();
            const f32x16 s0 = qk_mma(kf0, qf, f32x16{});
            const f32x16 s1 = qk_mma(kf1, qf, f32x16{});
            v_frags(vf1, vb, 2 * pr + 1, lane);
            SCHED_FENCE();
            sa_probs(s0, mw0, btab, false, pa0, osum, ones, hh);
            pv_mma_b(o, vf0, pa0);
            sa_probs(s1, mw1, btab, false, pa1, osum, ones, hh);
            pv_mma_b(o, vf1, pa1);
        }
        SA_STAGE_OUT()
    }
    for (; j <= jd; ++j) {
        SA_STAGE_IN()
#pragma unroll
        for (int sub = 0; sub < 4; ++sub) {
            const int si = 4 * j + sub;
            if (si <= diag) {
                const unsigned mw = mb[sub * 256] >> (4 * hh);
                const f32x16 s = qk_tile(kb, sub, qf, r32, hh);
                b16x8 pa[2]; h16x8 vfn[2][2];
                v_frags(vfn, vb, sub, lane);
                sa_probs(s, mw, btab + (tq - 32 * si + 5 - 4 * hh), true, pa, osum, ones, hh);
                pv_mma_b(o, vfn, pa);
            }
        }
        SA_STAGE_OUT()
    }
    for (; j <= jmax; ++j) {
        SA_STAGE_IN()
        (void)vb; (void)mb;
        SA_STAGE_OUT()
    }
#undef SA_STAGE_IN
#undef SA_STAGE_OUT
    if (r32 == 0) {
#pragma unroll
        for (int r = 0; r < 16; ++r) lx[wv * 32 + crow(r, hh)] = osum[r];
    }
    att_store(o, lds + wv * (32 * OSTR), lx + wv * 32, Gg, Og, qw, lane);
}
__device__ __forceinline__ void phase_sa(const Params& p, LAS unsigned char* lds, int bid, int nblk) {
    for (int u = bid; u < 512; u += nblk) { int b, h, qb; att_unit(u, b, h, qb); sa_unit(p, lds, b, h, qb); }
}
constexpr int IK_STR = 144, IK_BUF = 256 * IK_STR, IK_SB = 2 * IK_BUF;
__device__ __forceinline__ int half_sum(int v) {
    v += __builtin_amdgcn_update_dpp(0, v, 0xB1, 0xF, 0xF, false);
    v += __builtin_amdgcn_update_dpp(0, v, 0x4E, 0xF, 0xF, false);
    v += __builtin_amdgcn_update_dpp(0, v, 0x141, 0xF, 0xF, false);
    v += __builtin_amdgcn_update_dpp(0, v, 0x140, 0xF, 0xF, false);
    { auto rr = __builtin_amdgcn_permlane16_swap((unsigned)v, (unsigned)v, false, false); v = (int)(rr[0] + rr[1]); }
    return v;
}
__device__ __forceinline__ unsigned half_umax(unsigned v) {
    unsigned o;
    o = (unsigned)__builtin_amdgcn_update_dpp(0, (int)v, 0xB1, 0xF, 0xF, false); v = v > o ? v : o;
    o = (unsigned)__builtin_amdgcn_update_dpp(0, (int)v, 0x4E, 0xF, 0xF, false); v = v > o ? v : o;
    o = (unsigned)__builtin_amdgcn_update_dpp(0, (int)v, 0x141, 0xF, 0xF, false); v = v > o ? v : o;
    o = (unsigned)__builtin_amdgcn_update_dpp(0, (int)v, 0x140, 0xF, 0xF, false); v = v > o ? v : o;
    { auto rr = __builtin_amdgcn_permlane16_swap(v, v, false, false); v = rr[0] > rr[1] ? rr[0] : rr[1]; }
    return v;
}
__device__ __forceinline__ float keyf(unsigned k) { return __uint_as_float((k & 0x80000000u) ? (k ^ 0x80000000u) : ~k); }
__device__ __forceinline__ void ik_load(u32x4 (&sk)[4], const h16* KI, int g, int tid) {
#pragma unroll
    for (int i = 0; i < 4; ++i) { const int idx = tid + 512 * i; sk[i] = *(const u32x4*)(KI + (size_t)(256 * g + (idx >> 3)) * 64 + (idx & 7) * 8); }
}
__device__ __forceinline__ void ik_store(const u32x4 (&sk)[4], LAS unsigned char* buf, int tid) {
#pragma unroll
    for (int i = 0; i < 4; ++i) { const int idx = tid + 512 * i; *(LAS u32x4*)(buf + (idx >> 3) * IK_STR + (idx & 7) * 16) = sk[i]; }
}
struct IdxPre { u32x4 sk[4]; h16x8 aq[4]; };
__device__ __forceinline__ void idx_prefetch(IdxPre& pre, const Params& p, int b, int qt) {
    const int tid = opaque_tid(), lane = tid & 63, wv = __builtin_amdgcn_readfirstlane(tid >> 6), c = lane & 31, hi = lane >> 5;
    const h16* QI = (const h16*)(p.ws + WS_QI) + (size_t)b * SEQ * 1024;
    const h16* KI = (const h16*)(p.ws + WS_KI) + (size_t)b * SEQ * 64;
    const int t0 = qt * 16 + wv * 2;
    ik_load(pre.sk, KI, 0, tid);
    const int rq = (c >> 2) & 1, rh = (c & 3) + 4 * (c >> 3);
#pragma unroll
    for (int ks = 0; ks < 4; ++ks) pre.aq[ks] = *(const h16x8*)(QI + (size_t)(t0 + rq) * 1024 + rh * 64 + ks * 16 + hi * 8);
}
__device__ __forceinline__ void idx_unit(const Params& p, LAS unsigned char* lds, int b, int qt, IdxPre& pre, bool has_next, int nb, int nqt, IdxPre& pre_next) {
    const int tid = opaque_tid(), lane = tid & 63, wv = __builtin_amdgcn_readfirstlane(tid >> 6), c = lane & 31, hi = lane >> 5;
    const h16* KI = (const h16*)(p.ws + WS_KI) + (size_t)b * SEQ * 64;
    unsigned* Mg = (unsigned*)(p.ws + WS_MASK) + (size_t)b * 64 * SEQ;
    const int t0 = qt * 16 + wv * 2, t = t0 + hi;
    u32x4 (&sk)[4] = pre.sk;
    h16x8 aq[4];
#pragma unroll
    for (int ks = 0; ks < 4; ++ks) aq[ks] = pre.aq[ks];
    const float* WI = (const float*)(p.ws + WS_WI) + (size_t)b * SEQ * 16;
    float wq[16];
#pragma unroll
    for (int i = 0; i < 4; ++i) { const f32x4 w4 = *(const f32x4*)(WI + (size_t)t * 16 + 4 * i); wq[4 * i] = w4.x; wq[4 * i + 1] = w4.y; wq[4 * i + 2] = w4.z; wq[4 * i + 3] = w4.w; }
    const int ntile = ((t0 + 1) >> 5) + 1;
    const int ngroup = ((qt * 16 + 15) >> 8) + 1;
    LAS unsigned* sb = (LAS unsigned*)(lds + IK_SB + wv * 2048);
    unsigned u[64];
#pragma unroll
    for (int j = 0; j < 64; ++j) u[j] = 0u;
    asm volatile("" : "+v"(aq[0]), "+v"(aq[1]), "+v"(aq[2]), "+v"(aq[3]));
    ik_store(sk, lds, tid);
    __syncthreads();
#pragma unroll
    for (int i = 0; i < 16; ++i) asm volatile("" : "+v"(wq[i]));
#pragma unroll
    for (int g = 0; g < 8; ++g) {
        if (g < ngroup) {
            if (g + 1 < ngroup) ik_load(sk, KI, g + 1, tid);
            LAS const unsigned char* kb = lds + (g & 1) * IK_BUF + c * IK_STR + hi * 16;
            h16x8 bk[4];
#pragma unroll
            for (int ks = 0; ks < 4; ++ks) bk[ks] = *(LAS const h16x8*)(kb + ks * 32);
#pragma unroll 2
            for (int jj = 0; jj < 8; ++jj) {
                const int j = 8 * g + jj, jn = jj < 7 ? jj + 1 : 7;
                h16x8 bn[4];
#pragma unroll
                for (int ks = 0; ks < 4; ++ks) bn[ks] = *(LAS const h16x8*)(kb + jn * (32 * IK_STR) + ks * 32);
                __builtin_amdgcn_sched_barrier(0);
                unsigned key = 0u;
                if (j < ntile) {
                    f32x16 acc = f32x16{};
#pragma unroll
                    for (int ks = 0; ks < 4; ++ks) acc = __builtin_amdgcn_mfma_f32_32x32x16_f16(aq[ks], bk[ks], acc, 0, 0, 0);
                    float sc = 0.f;
#pragma unroll
                    for (int r = 0; r < 16; ++r) { const int ib = __float_as_int(acc[r]); sc = __builtin_fmaf(wq[r], __int_as_float(ib > 0 ? ib : 0), sc); }
                    key = fkey(sc);
                    if (j == ntile - 1) key = (32 * j + c <= t) ? key : 0u;
                }
                sb[jj * 64 + lane] = key;
#pragma unroll
                for (int ks = 0; ks < 4; ++ks) bk[ks] = bn[ks];
            }
#pragma unroll
            for (int jj = 0; jj < 8; ++jj) u[8 * g + jj] = sb[jj * 64 + lane];
            if (g + 1 < ngroup) ik_store(sk, lds + ((g + 1) & 1) * IK_BUF, tid);
            asm volatile("s_waitcnt lgkmcnt(0)\n\ts_barrier" ::: "memory");
        }
    }
    if (has_next) idx_prefetch(pre_next, p, nb, nqt);
    unsigned T = 1u; bool exact = true;
    if (t0 >= TOPK) {
        unsigned kmax = 0u, kmin1 = 0xFFFFFFFFu;
#define IDX_MM(J0) _Pragma("unroll") for (int j = (J0); j < (J0) + 16; ++j) { kmax = kmax > u[j] ? kmax : u[j]; const unsigned v1 = u[j] - 1u; kmin1 = kmin1 < v1 ? kmin1 : v1; }
        IDX_MM(0)
        if (ntile > 16) { IDX_MM(16) if (ntile > 32) { IDX_MM(32) if (ntile > 48) { IDX_MM(48) } } }
#undef IDX_MM
        kmax = half_umax(kmax); kmin1 = ~half_umax(~kmin1);
        unsigned lo_k = kmin1 + 1u, hi_k = kmax + 1u;
        float lo_f = keyf(lo_k), hi_f = keyf(hi_k);
        float f_lo = (float)(t + 1) - ((float)TOPK - 0.5f), f_hi = -((float)TOPK - 0.5f);
        int side = 0; bool done = false; exact = false; T = lo_k;
        if (hi_k - lo_k <= 1u) done = true;
        for (int it = 0; it < 64; ++it) {
            unsigned mid_k;
            if (it < 24) { const float mid_f = hi_f - (hi_f - lo_f) * (f_hi / (f_hi - f_lo)); mid_k = fkey(mid_f); } else mid_k = lo_k + ((hi_k - lo_k) >> 1);
            mid_k = mid_k < lo_k + 1u ? lo_k + 1u : (mid_k > hi_k - 1u ? hi_k - 1u : mid_k);
            int c0 = 0, c1 = 0, c2 = 0, c3 = 0;
#define IDX_CNT(J0) _Pragma("unroll") for (int j = (J0); j < (J0) + 16; j += 4) { \
                asm volatile("v_cmp_ge_u32_e64 s[20:21], %4, %8\n\tv_cmp_ge_u32_e64 s[22:23], %5, %8\n\tv_cmp_ge_u32_e64 s[24:25], %6, %8\n\tv_cmp_ge_u32_e64 s[26:27], %7, %8\n\t" \
                             "v_addc_co_u32_e64 %0, s[28:29], 0, %0, s[20:21]\n\tv_addc_co_u32_e64 %1, s[28:29], 0, %1, s[22:23]\n\tv_addc_co_u32_e64 %2, s[28:29], 0, %2, s[24:25]\n\tv_addc_co_u32_e64 %3, s[28:29], 0, %3, s[26:27]" \
                             : "+v"(c0), "+v"(c1), "+v"(c2), "+v"(c3) : "v"(u[j]), "v"(u[j + 1]), "v"(u[j + 2]), "v"(u[j + 3]), "v"(mid_k) \
                             : "s20", "s21", "s22", "s23", "s24", "s25", "s26", "s27", "s28", "s29"); }
            IDX_CNT(0)
            if (ntile > 16) { IDX_CNT(16) if (ntile > 32) { IDX_CNT(32) if (ntile > 48) { IDX_CNT(48) } } }
#undef IDX_CNT
            const int cnt = half_sum((c0 + c1) + (c2 + c3));
            if (!done) {
                if (cnt == TOPK) { T = mid_k; exact = true; done = true; }
                else if (cnt > TOPK) { lo_k = mid_k; lo_f = keyf(mid_k); f_lo = (float)cnt - ((float)TOPK - 0.5f); if (side > 0) f_hi *= 0.5f; side = 1; }
                else { hi_k = mid_k; hi_f = keyf(mid_k); f_hi = (float)cnt - ((float)TOPK - 0.5f); if (side < 0) f_lo *= 0.5f; side = -1; }
                if (!done && hi_k - lo_k <= 1u) { T = lo_k; done = true; }
            }
            if (__all(done)) break;
        }
    }
    LAS unsigned long long* tb = (LAS unsigned long long*)(lds + IK_SB + 16384) + wv;
    if (__all(exact)) {
        unsigned vlo = 0u, vhi = 0u;
#define IDX_OUT(J0) _Pragma("unroll") for (int j = (J0); j < (J0) + 16; j += 4) { \
            asm volatile("v_cmp_ge_u32_e64 s[20:21], %2, %6\n\tv_cmp_ge_u32_e64 s[22:23], %3, %6\n\tv_cmp_ge_u32_e64 s[24:25], %4, %6\n\tv_cmp_ge_u32_e64 s[26:27], %5, %6\n\t" \
                         "v_writelane_b32 %0, s20, %7\n\tv_writelane_b32 %1, s21, %7\n\tv_writelane_b32 %0, s22, %8\n\tv_writelane_b32 %1, s23, %8\n\t" \
                         "v_writelane_b32 %0, s24, %9\n\tv_writelane_b32 %1, s25, %9\n\tv_writelane_b32 %0, s26, %10\n\tv_writelane_b32 %1, s27, %10" \
                         : "+v"(vlo), "+v"(vhi) : "v"(u[j]), "v"(u[j + 1]), "v"(u[j + 2]), "v"(u[j + 3]), "v"(T), "n"(j), "n"(j + 1), "n"(j + 2), "n"(j + 3) \
                         : "s20", "s21", "s22", "s23", "s24", "s25", "s26", "s27"); }
        IDX_OUT(0)
        if (ntile > 16) { IDX_OUT(16) if (ntile > 32) { IDX_OUT(32) if (ntile > 48) { IDX_OUT(48) } } }
#undef IDX_OUT
        tb[lane * 8] = ((unsigned long long)vhi << 32) | vlo;
    } else {
        int ngt = 0;
#pragma unroll
        for (int j = 0; j < 64; ++j) ngt += (u[j] > T) ? 1 : 0;
        ngt = half_sum(ngt);
        const int need = exact ? (1 << 30) : TOPK - ngt;
        int base = 0;
#pragma unroll
        for (int j = 0; j < 64; ++j) {
            const bool eq = (u[j] == T);
            const unsigned long long be = __ballot(eq);
            const unsigned mh = hi ? (unsigned)(be >> 32) : (unsigned)be;
            const int rank = base + __popc(mh & ((1u << c) - 1u));
            const bool sel = (u[j] > T) || (eq && rank < need);
            base += __popc(mh);
            const unsigned long long bal = __ballot(sel);
            if (lane == 0) tb[j * 8] = bal;
        }
    }
    __syncthreads();
    __hip_atomic_store((unsigned long long*)(Mg + (size_t)(tid >> 3) * SEQ + qt * 16 + 2 * (tid & 7)), ((LAS const unsigned long long*)(lds + IK_SB + 16384))[tid], __ATOMIC_RELAXED, __HIP_MEMORY_SCOPE_AGENT);
}
__device__ __forceinline__ void idx_deal(int u, int& b, int& qt) {
    b = u & 7; const int kk = (u >> 3) & 31, r = u >> 8; qt = r == 0 ? 127 - kk : (r == 1 ? 64 + kk : (r == 2 ? 63 - kk : kk));
}
__device__ __forceinline__ void phase_idx(const Params& p, LAS unsigned char* lds, int bid, int nblk) {
    IdxPre pa, pb;
    int u = bid; if (u >= 1024) return;
    int b, qt; idx_deal(u, b, qt);
    idx_prefetch(pa, p, b, qt);
    for (;;) {
        int un = u + nblk, nb = 0, nqt = 0; bool hn = un < 1024; if (hn) idx_deal(un, nb, nqt);
        idx_unit(p, lds, b, qt, pa, hn, nb, nqt, pb);
        if (!hn) break;
        u = un; b = nb; qt = nqt; un = u + nblk; hn = un < 1024; if (hn) idx_deal(un, nb, nqt);
        idx_unit(p, lds, b, qt, pb, hn, nb, nqt, pa);
        if (!hn) break;
        u = un; b = nb; qt = nqt;
    }
}
#include <cstdio>
__global__ void __launch_bounds__(NTHR, 2) k_fused(Params p) {
    extern __shared__ __attribute__((aligned(16))) unsigned char lds_raw[];
    LAS unsigned char* lds = (LAS unsigned char*)lds_raw;
    const int bid = blockIdx.x, nblk = gridDim.x;
    volatile LAS unsigned* st = (volatile LAS unsigned*)(lds + MISC_OFF);
    if (threadIdx.x < 64) st[threadIdx.x] = 0u;
    __syncthreads();
    Half H = half_init(lds);
    const XcdBarrier bar = xcd_barrier_post((unsigned*)(p.ws + WS_CTL), st);
    phase_prologue(p, lds, bid, nblk);
    xcd_barrier(bar);
    phase_gemm1(p, lds, bid, nblk);
    phase_kiwi(p, lds, bid, nblk);
    xcd_barrier(bar);
    phase_idx(p, lds, bid, nblk);
    flat_arrive(bar, 0);
    phase_sb2(p, H, bid, nblk);
    flat_wait(bar, 0);
    phase_sa(p, lds, bid, nblk);
    xcd_barrier(bar);
    phase_gemm2(p, lds, bid, nblk);
}

extern "C" void kernel_launch(void* const* d_in, const int* in_sizes, int n_in, void* d_out, int out_size, void* d_ws, size_t ws_size, hipStream_t stream) {
    static int grid_blocks = 0;
    if (!grid_blocks) {
        int dev = 0, cus = 0, per_cu = 0;
        (void)hipGetDevice(&dev);
        (void)hipDeviceGetAttribute(&cus, hipDeviceAttributeMultiprocessorCount, dev);
        (void)hipFuncSetAttribute((const void*)k_fused, hipFuncAttributeMaxDynamicSharedMemorySize, LDS_BYTES);
        (void)hipOccupancyMaxActiveBlocksPerMultiprocessor(&per_cu, (const void*)k_fused, NTHR, LDS_BYTES);
        if (per_cu < 1) per_cu = 1;
        if (per_cu > 1) per_cu = 1;
        grid_blocks = cus * per_cu;
    }
    (void)hipMemsetAsync((char*)d_ws + WS_CTL, 0, 16384, stream);
    Params p{};
    p.x = (const float*)d_in[0]; p.norm_gain = (const float*)d_in[1]; p.w_in = (const float*)d_in[2]; p.qg = (const float*)d_in[3]; p.kg = (const float*)d_in[4];
    p.rel_bias = (const float*)d_in[5]; p.w_out = (const float*)d_in[6]; p.out = (float*)d_out; p.ws = (unsigned char*)d_ws; p.use_cg = 0; p.pad = 0;
    void* args[] = {&p};
    hipError_t e = hipLaunchCooperativeKernel((const void*)k_fused, dim3(grid_blocks), dim3(NTHR), args, LDS_BYTES, stream);
    if (e != hipSuccess) fprintf(stderr, "cooperative launch failed: %s (grid %d)\n", hipGetErrorString(e), grid_blocks);
}
```

```cpp
#include <hip/hip_runtime.h>
#include <stdint.h>

typedef _Float16 h16;

constexpr int NB = 8, SEQ = 2048, DM = 1024, MTOK = NB * SEQ;
constexpr int NPROJ = 5200;
constexpr float LOG2E = 1.4426950408889634f;
constexpr float QSCALE = 0.125f * LOG2E;
constexpr float IDXS = 0.03125f;
constexpr float RMS_EPS = 1e-6f;
constexpr int TOPK = 256;
constexpr int C_QA = 0, C_KA = 512, C_VA = 1024, C_GA = 1536, C_QI = 2048, C_KI = 3072, C_WI = 3136, C_QB = 3152, C_KB = 3664, C_VB = 4176, C_GB = 4688;

constexpr size_t MiB = 1u << 20;
constexpr size_t WS_CTL = 0, WS_HN = 1 * MiB, WS_W1T = 33 * MiB, WS_W2T = 44 * MiB;
constexpr size_t WS_QA = 46 * MiB, WS_KA = 62 * MiB, WS_VA = 78 * MiB, WS_GA = 94 * MiB, WS_QI = 110 * MiB, WS_KI = 142 * MiB, WS_WI = 144 * MiB;
constexpr size_t WS_QB = 145 * MiB, WS_KB = 161 * MiB, WS_VB = 177 * MiB, WS_GB = 193 * MiB, WS_MASK = 209 * MiB, WS_MIX = WS_HN, WS_FREE = 213 * MiB;

__device__ const unsigned char T5_BUCKET[128] = {0, 1, 2, 3, 4, 5, 6, 7, 8, 9, 10, 11, 12, 13, 14, 15, 16, 16, 16, 17, 17, 18, 18, 18, 19, 19, 19, 20, 20, 20, 20, 21, 21, 21, 21, 22, 22, 22, 22, 22, 23, 23, 23, 23, 23, 23, 24, 24, 24, 24, 24, 24, 25, 25, 25, 25, 25, 25, 25, 26, 26, 26, 26, 26, 26, 26, 26, 27, 27, 27, 27, 27, 27, 27, 27, 27, 27, 28, 28, 28, 28, 28, 28, 28, 28, 28, 28, 29, 29, 29, 29, 29, 29, 29, 29, 29, 29, 29, 29, 30, 30, 30, 30, 30, 30, 30, 30, 30, 30, 30, 30, 30, 30, 31, 31, 31, 31, 31, 31, 31, 31, 31, 31, 31, 31, 31, 31, 31};

__device__ __forceinline__ float wave_sum(float v) {
#pragma unroll
    for (int o = 1; o < 64; o <<= 1) v += __shfl_xor(v, o);
    return v;
}
__device__ __forceinline__ unsigned fkey(float f) { const unsigned u = __float_as_uint(f); return (u & 0x80000000u) ? ~u : (u | 0x80000000u); }
#define LAS __attribute__((address_space(3)))
typedef _Float16 h16x8 __attribute__((ext_vector_type(8)));
typedef _Float16 h16x4 __attribute__((ext_vector_type(4)));
typedef _Float16 h16x2 __attribute__((ext_vector_type(2)));
typedef float f32x2 __attribute__((ext_vector_type(2)));
typedef float f32x4 __attribute__((ext_vector_type(4)));
typedef float f32x16 __attribute__((ext_vector_type(16)));
typedef unsigned u32x4 __attribute__((ext_vector_type(4)));
typedef unsigned u32x2 __attribute__((ext_vector_type(2)));
typedef short s16x4 __attribute__((ext_vector_type(4)));

constexpr int NTHR = 512, NWAVE = 8;
constexpr int N1PAD = 5120;
constexpr int W3ROW = 5120;
constexpr int LDS_BYTES = 147456;

struct Params {
    const float *x, *norm_gain, *w_in, *qg, *kg, *rel_bias, *w_out;
    float* out; unsigned char* ws; int use_cg, pad;
};

__device__ __forceinline__ int opaque_tid() { int t = threadIdx.x; asm volatile("" : "+v"(t)); return t; }
typedef __bf16 bf16x2_t __attribute__((ext_vector_type(2)));
__device__ __forceinline__ unsigned pk2b(float lo, float hi) { f32x2 v = {lo, hi}; bf16x2_t b = __builtin_convertvector(v, bf16x2_t); return __builtin_bit_cast(unsigned, b); }
__device__ __forceinline__ unsigned pk2h(float lo, float hi) { f32x2 v = {lo, hi}; h16x2 h = __builtin_convertvector(v, h16x2); return __builtin_bit_cast(unsigned, h); }

__host__ __device__ __forceinline__ int phys_of_logical(int lt) { const int wc = lt >> 6, bj = (lt >> 5) & 1, fq = (lt >> 3) & 3, n = (lt >> 2) & 1, reg = lt & 3; return 128 * bj + 32 * wc + 16 * n + 4 * fq + reg; }
__host__ __device__ __forceinline__ int phys_of_logical2(int lt) { const int wc = lt >> 6, bj = (lt >> 5) & 1, n = (lt >> 4) & 1, fq = (lt >> 2) & 3, reg = lt & 3; return 128 * bj + 32 * wc + 16 * n + 4 * fq + reg; }
__host__ __device__ __forceinline__ int w1_row_of_col(int c) {
    int pn, lt;
    if (c < 3072) { pn = c >> 8; lt = c & 255; } else if (c < 3152) { return W3ROW + (c - 3072); } else { const int cc = c - 3152; pn = 12 + (cc >> 8); lt = cc & 255; }
    return 256 * pn + phys_of_logical(lt);
}

namespace pg8 {
constexpr int BM = 256, BK = 64, HALF = 128, HTB = HALF * BK * 2, STAGE_BYTES = 8 * HTB, NXCD = 8, WGM = 8;
__host__ __device__ __forceinline__ int lds_byte(int r, int c) { const int st = (r >> 4) * 2 + (c >> 5), rr = r & 15, cc = c & 31, ob = rr * 64 + cc * 2; return st * 1024 + (ob ^ (((ob >> 9) & 1) << 5)); }
__host__ __device__ __forceinline__ void stage_rc(int b, int& R, int& C) { const int st = b / 1024, sb = b % 1024, swz = sb ^ (((sb >> 9) & 1) << 5); R = (st >> 1) * 16 + swz / 64; C = (st & 1) * 32 + (swz % 64) / 2; }
struct Unit { int pm, pn; };
struct Gemm { const h16* A; const h16* Bt; int M, N, K; };
struct StaticOrder {
    int nM, nN, nwg, G, c;
    __host__ __device__ __forceinline__ void init(int M, int N, int G_, int c_) { nM = M / BM; nN = N / BM; nwg = nM * nN; G = G_; c = c_; }
    __host__ __device__ __forceinline__ bool next(int i, Unit& u) const {
        const long L = (long)i * G + c; if (L >= nwg) return false;
        int wgid = (int)L; { const int q = nwg / NXCD, r = nwg % NXCD, xcd = wgid % NXCD, off = wgid / NXCD; wgid = (xcd < r ? xcd * (q + 1) : r * (q + 1) + (xcd - r) * q) + off; }
        const int nig = WGM * nN, gid = wgid / nig, fm = gid * WGM, gsz = (nM - fm) < WGM ? (nM - fm) : WGM;
        u.pm = fm + ((wgid % nig) % gsz); u.pn = (wgid % nig) / gsz; return true;
    }
};
template <class Epi, class Sched, bool ALIGN_EPI = false, bool SP2 = false>
__device__ __forceinline__ void gemm_phase(LAS unsigned char* lds, const Gemm g, const Sched& S, const Epi& E) {
    const int tid = opaque_tid(), wid = __builtin_amdgcn_readfirstlane(tid >> 6), lane = tid & 63, wr = wid >> 2, wc = wid & 3, fr = lane & 15, fq = lane >> 4;
    const int K = g.K, nt = K / BK;
    unsigned voffA[2], voffB[2];
#pragma unroll
    for (int i = 0; i < 2; ++i) { int R, C; stage_rc(tid * 16 + i * 8192, R, C); voffA[i] = (unsigned)(R * K + C) * 2u; voffB[i] = (unsigned)(R * K + C) * 2u; }
    const size_t kstep = (size_t)(BK * 2);
    const size_t hstep = (size_t)HALF * K * 2;
    const size_t tstep = 2 * hstep;
    const unsigned ldsw = (unsigned)wid * 1024u;
    const int aoff = lds_byte(wr * 64 + fr, fq * 8), boff = lds_byte(wc * 32 + fr, fq * 8);
#define PG8_SA(b, h) (((b) * 2 + (h)) * HTB)
#define PG8_SB(b, h) ((4 + (b) * 2 + (h)) * HTB)
#define PG8_STAGE(bufoff, gbase, voff) do { _Pragma("unroll") for (int _i = 0; _i < 2; ++_i) \
        __builtin_amdgcn_global_load_lds((const unsigned*)((const char*)(gbase) + (voff)[_i]), (LAS unsigned*)(lds + (bufoff) + ldsw + _i * 8192), 16, 0, 0); } while (0)
#define PG8_LDA(dst, b, h) do { _Pragma("unroll") for (int m = 0; m < 4; ++m) _Pragma("unroll") for (int k = 0; k < 2; ++k) dst[m][k] = *(const LAS h16x8*)(lds + PG8_SA(b, h) + aoff + m * 2048 + k * 1024); } while (0)
#define PG8_LDB(dst, b, h) do { _Pragma("unroll") for (int n = 0; n < 2; ++n) _Pragma("unroll") for (int k = 0; k < 2; ++k) dst[n][k] = *(const LAS h16x8*)(lds + PG8_SB(b, h) + boff + n * 2048 + k * 1024); } while (0)
#define PG8_MMA(ai, bj, At, Bt) do { __builtin_amdgcn_s_setprio(1); _Pragma("unroll") for (int m = 0; m < 4; ++m) _Pragma("unroll") for (int n = 0; n < 2; ++n) _Pragma("unroll") for (int k = 0; k < 2; ++k) \
        acc[ai][bj][m][n] = __builtin_amdgcn_mfma_f32_16x16x32_f16(Bt[n][k], At[m][k], acc[ai][bj][m][n], 0, 0, 0); __builtin_amdgcn_s_setprio(0); } while (0)
#define PG8_WAIT_V(n) asm volatile("s_waitcnt vmcnt(" #n ")" ::: "memory")
#define PG8_WAIT_L(n) asm volatile("s_waitcnt lgkmcnt(" #n ")" ::: "memory")
#define PG8_BAR __builtin_amdgcn_s_barrier()
#define PG8_SCHED __builtin_amdgcn_sched_barrier(0)
    Unit cur, nxt; int ui = 0;
    if (!S.next(0, cur)) return;
    f32x4 acc[2][2][4][2];
#pragma unroll
    for (int a = 0; a < 2; ++a)
#pragma unroll
        for (int b = 0; b < 2; ++b)
#pragma unroll
            for (int m = 0; m < 4; ++m)
#pragma unroll
                for (int n = 0; n < 2; ++n) acc[a][b][m][n] = (f32x4){0.f, 0.f, 0.f, 0.f};
    h16x8 At[4][2], B0[2][2], B1[2][2];
    const char* cA = (const char*)g.A + (size_t)cur.pm * tstep; const char* cB = (const char*)g.Bt + (size_t)cur.pn * tstep;
    if constexpr (SP2) {
        PG8_STAGE(PG8_SB(0, 0), cB, voffB); PG8_STAGE(PG8_SB(0, 1), cB + hstep, voffB); PG8_STAGE(PG8_SA(0, 0), cA, voffA); PG8_STAGE(PG8_SA(0, 1), cA + hstep, voffA);
        if (wr == 1) PG8_BAR;
        PG8_WAIT_V(2); PG8_BAR;
        PG8_STAGE(PG8_SB(1, 0), cB + kstep, voffB); PG8_STAGE(PG8_SA(1, 0), cA + kstep, voffA); PG8_STAGE(PG8_SB(1, 1), cB + hstep + kstep, voffB);
        PG8_WAIT_V(6); PG8_BAR;
    } else {
        PG8_STAGE(PG8_SB(0, 0), cB, voffB); PG8_STAGE(PG8_SA(0, 0), cA, voffA); PG8_STAGE(PG8_SB(0, 1), cB + hstep, voffB); PG8_STAGE(PG8_SA(0, 1), cA + hstep, voffA);
        if (wr == 1) PG8_BAR;
        PG8_WAIT_V(4); PG8_BAR;
        PG8_STAGE(PG8_SB(1, 0), cB + kstep, voffB); PG8_STAGE(PG8_SA(1, 0), cA + kstep, voffA); PG8_STAGE(PG8_SB(1, 1), cB + hstep + kstep, voffB);
        PG8_WAIT_V(6); PG8_BAR;
    }
    for (;;) {
        const bool has_next = S.next(ui + 1, nxt);
        const char* nA = has_next ? (const char*)g.A + (size_t)nxt.pm * tstep : cA; const char* nB = has_next ? (const char*)g.Bt + (size_t)nxt.pn * tstep : cB;
        for (int t = 0; t < nt; t += 2) {
            const bool last = (t == nt - 2);
            const char* a1 = cA + (size_t)(t + 1) * kstep;
            const char* a2 = last ? nA : cA + (size_t)(t + 2) * kstep; const char* b2 = last ? nB : cB + (size_t)(t + 2) * kstep;
            const char* a3 = a2 + kstep; const char* b3 = b2 + kstep;
            if constexpr (SP2) {
            PG8_LDB(B0, 0, 0); PG8_LDB(B1, 0, 1); PG8_SCHED; PG8_LDA(At, 0, 0); PG8_STAGE(PG8_SA(1, 1), a1 + hstep, voffA);
            PG8_WAIT_V(8); PG8_WAIT_L(0); PG8_BAR; PG8_MMA(0, 0, At, B0); PG8_MMA(0, 1, At, B1); PG8_BAR; PG8_SCHED;
            PG8_LDA(At, 0, 1); PG8_STAGE(PG8_SB(0, 0), b2, voffB); PG8_STAGE(PG8_SB(0, 1), b2 + hstep, voffB); PG8_STAGE(PG8_SA(0, 0), a2, voffA);
            PG8_WAIT_V(8); PG8_WAIT_L(0); PG8_BAR; PG8_MMA(1, 0, At, B0); PG8_MMA(1, 1, At, B1); PG8_BAR; PG8_SCHED;
            PG8_LDB(B0, 1, 0); PG8_LDB(B1, 1, 1); PG8_SCHED; PG8_LDA(At, 1, 0); PG8_STAGE(PG8_SA(0, 1), a2 + hstep, voffA);
            PG8_WAIT_V(8); PG8_WAIT_L(0); PG8_BAR; PG8_MMA(0, 0, At, B0); PG8_MMA(0, 1, At, B1); PG8_BAR; PG8_SCHED;
            PG8_LDA(At, 1, 1); PG8_STAGE(PG8_SB(1, 0), b3, voffB); PG8_STAGE(PG8_SB(1, 1), b3 + hstep, voffB); PG8_STAGE(PG8_SA(1, 0), a3, voffA);
            PG8_WAIT_V(8); PG8_WAIT_L(0); PG8_BAR; PG8_MMA(1, 0, At, B0); PG8_MMA(1, 1, At, B1); PG8_BAR; PG8_SCHED;
            } else {
            PG8_LDB(B0, 0, 0); PG8_SCHED; PG8_LDA(At, 0, 0); PG8_STAGE(PG8_SA(1, 1), a1 + hstep, voffA);
            PG8_WAIT_L(8); PG8_BAR; PG8_WAIT_L(0); PG8_MMA(0, 0, At, B0); PG8_BAR; PG8_SCHED;
            PG8_LDB(B1, 0, 1); PG8_STAGE(PG8_SB(0, 0), b2, voffB);
            PG8_BAR; PG8_WAIT_L(0); PG8_MMA(0, 1, At, B1); PG8_BAR;
            PG8_LDA(At, 0, 1); PG8_STAGE(PG8_SA(0, 0), a2, voffA);
            PG8_BAR; PG8_WAIT_L(0); PG8_MMA(1, 0, At, B0); PG8_BAR; PG8_SCHED;
            PG8_STAGE(PG8_SB(0, 1), b2 + hstep, voffB);
            PG8_WAIT_V(6); PG8_BAR; PG8_MMA(1, 1, At, B1); PG8_BAR;
            PG8_LDB(B0, 1, 0); PG8_SCHED; PG8_LDA(At, 1, 0); PG8_STAGE(PG8_SA(0, 1), a2 + hstep, voffA);
            PG8_WAIT_L(8); PG8_BAR; PG8_WAIT_L(0); PG8_MMA(0, 0, At, B0); PG8_BAR; PG8_SCHED;
            PG8_LDB(B1, 1, 1); PG8_STAGE(PG8_SB(1, 0), b3, voffB);
            PG8_BAR; PG8_WAIT_L(0); PG8_MMA(0, 1, At, B1); PG8_BAR;
            PG8_LDA(At, 1, 1); PG8_STAGE(PG8_SA(1, 0), a3, voffA);
            PG8_BAR; PG8_WAIT_L(0); PG8_MMA(1, 0, At, B0); PG8_BAR; PG8_SCHED;
            PG8_STAGE(PG8_SB(1, 1), b3 + hstep, voffB);
            PG8_WAIT_V(6); PG8_BAR; PG8_MMA(1, 1, At, B1); PG8_BAR;
            }
        }
        if constexpr (ALIGN_EPI) { if (wr == 0) PG8_BAR; }
        E(acc, cur, wr, wc, fr, fq);
        if (!has_next) break;
#pragma unroll
        for (int a = 0; a < 2; ++a)
#pragma unroll
            for (int b = 0; b < 2; ++b)
#pragma unroll
                for (int m = 0; m < 4; ++m)
#pragma unroll
                    for (int n = 0; n < 2; ++n) acc[a][b][m][n] = (f32x4){0.f, 0.f, 0.f, 0.f};
        cur = nxt; cA = nA; cB = nB; ++ui;
        if constexpr (ALIGN_EPI) { if (wr == 1) PG8_BAR; }
    }
    PG8_WAIT_V(0);
    if constexpr (!ALIGN_EPI) { if (wr == 0) PG8_BAR; }
    PG8_BAR;
#undef PG8_SA
#undef PG8_SB
#undef PG8_STAGE
#undef PG8_LDA
#undef PG8_LDB
#undef PG8_MMA
#undef PG8_WAIT_V
#undef PG8_WAIT_L
#undef PG8_BAR
#undef PG8_SCHED
}
}

struct EpiProj {
    unsigned char* ws; const float* qg; const float* kg;
    __device__ __forceinline__ void operator()(const f32x4 (&acc)[2][2][4][2], const pg8::Unit& u, int wr, int wc, int fr, int fq) const {
        const int pn = u.pn;
        int kind = 0; float scale = 1.f; const float* gain = nullptr; h16* dst; int ld = 512, tcol = 0;
        if (pn < 8) { const int t = pn >> 1; tcol = (pn & 1) * 256; dst = (h16*)(ws + WS_QA + (size_t)t * (16 * MiB));
            if (t == 0) { kind = 1; gain = qg; scale = QSCALE; } else if (t == 1) { kind = 1; gain = kg; } else if (t == 2) kind = 3; else kind = 2; }
        else if (pn < 12) { dst = (h16*)(ws + WS_QI); ld = 1024; tcol = (pn - 8) * 256; }
        else { const int t = (pn - 12) >> 1; tcol = (pn & 1) * 256; dst = (h16*)(ws + WS_QB + (size_t)t * (16 * MiB)); if (t == 0) scale = QSCALE; else if (t == 3) kind = 2; }
        const int col = tcol + 64 * wc + 8 * fq;
        float gv[16];
        if (kind == 1) {
#pragma unroll
            for (int i = 0; i < 16; ++i) gv[i] = gain[32 * (i >> 3) + 8 * fq + (i & 7)] * scale;
        }
#pragma unroll
        for (int ai = 0; ai < 2; ++ai)
#pragma unroll
            for (int m = 0; m < 4; ++m) {
                const int row = u.pm * 256 + ai * 128 + wr * 64 + m * 16 + fr;
                float v[16];
#pragma unroll
                for (int bj = 0; bj < 2; ++bj)
#pragma unroll
                    for (int n = 0; n < 2; ++n)
#pragma unroll
                        for (int r = 0; r < 4; ++r) v[8 * bj + 4 * n + r] = acc[ai][bj][m][n][r];
                if (kind == 1) {
                    float s = 0.f;
#pragma unroll
                    for (int i = 0; i < 16; ++i) s += v[i] * v[i];
                    s += __shfl_xor(s, 16); s += __shfl_xor(s, 32);
                    const float rs = rsqrtf(s * (1.f / 64.f) + RMS_EPS);
#pragma unroll
                    for (int i = 0; i < 16; ++i) v[i] = v[i] * rs * gv[i];
                } else if (kind == 2) {
#pragma unroll
                    for (int i = 0; i < 16; ++i) v[i] = v[i] * __builtin_amdgcn_rcpf(1.f + __builtin_amdgcn_exp2f(-v[i] * LOG2E));
                } else {
#pragma unroll
                    for (int i = 0; i < 16; ++i) v[i] *= scale;
                }
                h16* o = dst + (size_t)row * ld + col;
                u32x4 w0, w1;
                if (kind == 3) { w0.x = pk2b(v[0], v[1]); w0.y = pk2b(v[2], v[3]); w0.z = pk2b(v[4], v[5]); w0.w = pk2b(v[6], v[7]);
                                 w1.x = pk2b(v[8], v[9]); w1.y = pk2b(v[10], v[11]); w1.z = pk2b(v[12], v[13]); w1.w = pk2b(v[14], v[15]); }
                else { w0.x = pk2h(v[0], v[1]); w0.y = pk2h(v[2], v[3]); w0.z = pk2h(v[4], v[5]); w0.w = pk2h(v[6], v[7]);
                       w1.x = pk2h(v[8], v[9]); w1.y = pk2h(v[10], v[11]); w1.z = pk2h(v[12], v[13]); w1.w = pk2h(v[14], v[15]); }
                *(u32x4*)o = w0; *(u32x4*)(o + 32) = w1;
            }
    }
};
struct EpiOut {
    const float* x; float* out;
    __device__ __forceinline__ void operator()(const f32x4 (&acc)[2][2][4][2], const pg8::Unit& u, int wr, int wc, int fr, int fq) const {
        const int col = u.pn * 256 + 64 * wc + 4 * fq;
#pragma unroll
        for (int ai = 0; ai < 2; ++ai) {
            f32x4 xv[4][2][2];
#pragma unroll
            for (int m = 0; m < 4; ++m) { const size_t off = (size_t)(u.pm * 256 + ai * 128 + wr * 64 + m * 16 + fr) * DM + col;
#pragma unroll
                for (int bj = 0; bj < 2; ++bj)
#pragma unroll
                    for (int n = 0; n < 2; ++n) xv[m][bj][n] = *(const f32x4*)(x + off + 32 * bj + 16 * n); }
#pragma unroll
            for (int m = 0; m < 4; ++m) { const size_t off = (size_t)(u.pm * 256 + ai * 128 + wr * 64 + m * 16 + fr) * DM + col;
#pragma unroll
                for (int bj = 0; bj < 2; ++bj)
#pragma unroll
                    for (int n = 0; n < 2; ++n) *(f32x4*)(out + off + 32 * bj + 16 * n) = xv[m][bj][n] + acc[ai][bj][m][n]; }
        }
    }
};

template <class RowOf>
__device__ __forceinline__ void transpose_item(const float* W, int K, int N, h16* WT, LAS float* scr, int item, int lane, RowOf row_of) {
    const int nblk = (N + 31) / 32, kb = item / nblk, nb = item % nblk, k0 = 64 * kb, n0 = 32 * nb;
    const int nc = n0 + (lane & 31);
    float wv_[32];
#pragma unroll
    for (int i = 0; i < 32; ++i) { const int kk = 2 * i + (lane >> 5); wv_[i] = nc < N ? W[(size_t)(k0 + kk) * N + nc] : 0.f; }
#pragma unroll
    for (int i = 0; i < 32; ++i) { const int kk = 2 * i + (lane >> 5); scr[kk * 33 + (lane & 31)] = wv_[i]; }
    asm volatile("s_waitcnt lgkmcnt(0)" ::: "memory");
    const int c = lane & 7;
#pragma unroll
    for (int j = 0; j < 4; ++j) { const int n = (lane >> 3) + 8 * j; const LAS float* s = scr + (8 * c) * 33 + n;
        u32x4 o; o.x = pk2h(s[0 * 33], s[1 * 33]); o.y = pk2h(s[2 * 33], s[3 * 33]); o.z = pk2h(s[4 * 33], s[5 * 33]); o.w = pk2h(s[6 * 33], s[7 * 33]);
        if (n0 + n < N) *(u32x4*)(WT + (size_t)row_of(n0 + n) * K + k0 + 8 * c) = o; }
    asm volatile("s_waitcnt lgkmcnt(0)" ::: "memory");
}
__device__ __forceinline__ void rms_row(const float* __restrict__ xrow, const float* __restrict__ gain, h16* __restrict__ orow, int lane) {
    const f32x4* xr = (const f32x4*)xrow + lane;
    f32x4 v[4]; float s = 0.f;
#pragma unroll
    for (int j = 0; j < 4; ++j) { v[j] = xr[64 * j]; s += (v[j].x * v[j].x + v[j].y * v[j].y) + (v[j].z * v[j].z + v[j].w * v[j].w); }
    const float r = rsqrtf(wave_sum(s) * (1.f / DM) + RMS_EPS);
    u32x2* o8 = (u32x2*)orow + lane;
#pragma unroll
    for (int j = 0; j < 4; ++j) { const f32x4 g = ((const f32x4*)gain)[lane + 64 * j]; u32x2 w; w.x = pk2h(v[j].x * r * g.x, v[j].y * r * g.y); w.y = pk2h(v[j].z * r * g.z, v[j].w * r * g.w); o8[64 * j] = w; }
}
__device__ __forceinline__ void phase_prologue(const Params& p, LAS unsigned char* lds, int bid, int nblk) {
    const int tid = opaque_tid(), lane = tid & 63, wave = tid >> 6;
    LAS float* scr = (LAS float*)(lds + wave * 16384);
    const int gw = bid * NWAVE + wave, NGW = nblk * NWAVE;
    h16* W1T = (h16*)(p.ws + WS_W1T); h16* W2T = (h16*)(p.ws + WS_W2T); h16* HN = (h16*)(p.ws + WS_HN);
    constexpr int I1 = (DM / 64) * ((NPROJ + 31) / 32), I2 = (DM / 64) * (DM / 32);
    for (int it = gw; it < I1 + I2; it += NGW) {
        if (it < I1) transpose_item(p.w_in, DM, NPROJ, W1T, scr, it, lane, [](int c) { return w1_row_of_col(c); });
        else transpose_item(p.w_out, DM, DM, W2T, scr, it - I1, lane, [](int c) { return (c & ~255) + phys_of_logical2(c & 255); });
    }
    for (int m = gw; m < MTOK; m += 4 * NGW) {
        f32x4 v[4][4];
#pragma unroll
        for (int r = 0; r < 4; ++r)
#pragma unroll
            for (int j = 0; j < 4; ++j) v[r][j] = ((const f32x4*)(p.x + (size_t)(m + r * NGW) * DM))[lane + 64 * j];
#pragma unroll
        for (int r = 0; r < 4; ++r) {
            float ss = 0.f;
#pragma unroll
            for (int j = 0; j < 4; ++j) ss += (v[r][j].x * v[r][j].x + v[r][j].y * v[r][j].y) + (v[r][j].z * v[r][j].z + v[r][j].w * v[r][j].w);
            const float rs = rsqrtf(wave_sum(ss) * (1.f / DM) + RMS_EPS);
            u32x2* o8 = (u32x2*)(HN + (size_t)(m + r * NGW) * DM) + lane;
#pragma unroll
            for (int j = 0; j < 4; ++j) { const f32x4 g = ((const f32x4*)p.norm_gain)[lane + 64 * j]; u32x2 w; w.x = pk2h(v[r][j].x * rs * g.x, v[r][j].y * rs * g.y); w.y = pk2h(v[r][j].z * rs * g.z, v[r][j].w * rs * g.w); o8[64 * j] = w; }
        }
    }
}
__device__ __forceinline__ void phase_gemm1(const Params& p, LAS unsigned char* lds, int bid, int nblk) {
    pg8::Gemm g{(const h16*)(p.ws + WS_HN), (const h16*)(p.ws + WS_W1T), MTOK, N1PAD, DM};
    pg8::StaticOrder S; S.init(MTOK, N1PAD, nblk, bid);
    EpiProj E{p.ws, p.qg, p.kg};
    pg8::gemm_phase<EpiProj, pg8::StaticOrder, true, true>(lds, g, S, E);
}

constexpr int KW_STR = 528;
__device__ __forceinline__ void phase_kiwi(const Params& p, LAS unsigned char* lds, int bid, int nblk) {
    const int tid = opaque_tid(), lane = tid & 63, wv = __builtin_amdgcn_readfirstlane(tid >> 6), r32 = lane & 31, hh = lane >> 5;
    const h16* HN = (const h16*)(p.ws + WS_HN); const h16* W3 = (const h16*)(p.ws + WS_W1T) + (size_t)W3ROW * DM;
    const int rt = wv & 1, ct = wv >> 1;
    for (int blk = bid; blk < MTOK / 64; blk += nblk) {
        const int tok0 = blk * 64;
        f32x16 acc = f32x16{};
        u32x4 stg[10];
#define KW_LOAD(KC) _Pragma("unroll") for (int i = 0; i < 10; ++i) { const int idx = tid + 512 * i; const int row = idx >> 5, ch = idx & 31; \
                const h16* src = row < 64 ? HN + (size_t)(tok0 + row) * DM + (KC) * 256 + ch * 8 : W3 + (size_t)(row - 64) * DM + (KC) * 256 + ch * 8; stg[i] = *(const u32x4*)src; }
        KW_LOAD(0)
        for (int kc = 0; kc < 4; ++kc) {
            __syncthreads();
#pragma unroll
            for (int i = 0; i < 10; ++i) { const int idx = tid + 512 * i; *(LAS u32x4*)(lds + (idx >> 5) * KW_STR + (idx & 31) * 16) = stg[i]; }
            if (kc < 3) { KW_LOAD(kc + 1) }
            asm volatile("s_waitcnt lgkmcnt(0)\n\ts_barrier" ::: "memory");
            if (ct < 3) {
                LAS const unsigned char* ap = lds + (64 + ct * 32 + r32) * KW_STR + hh * 16;
                LAS const unsigned char* bp = lds + (rt * 32 + r32) * KW_STR + hh * 16;
#pragma unroll
                for (int ks = 0; ks < 16; ++ks) acc = __builtin_amdgcn_mfma_f32_32x32x16_f16(*(LAS const h16x8*)(ap + ks * 32), *(LAS const h16x8*)(bp + ks * 32), acc, 0, 0, 0);
            }
        }
#undef KW_LOAD
        const size_t tok = (size_t)(tok0 + rt * 32 + r32);
        if (ct < 2) {
            h16* o = (h16*)(p.ws + WS_KI) + tok * 64 + ct * 32 + 4 * hh;
#pragma unroll
            for (int g = 0; g < 4; ++g) { u32x2 w; w.x = pk2h(acc[4 * g], acc[4 * g + 1]); w.y = pk2h(acc[4 * g + 2], acc[4 * g + 3]); *(u32x2*)(o + 8 * g) = w; }
        } else if (ct == 2) {
            float* o = (float*)(p.ws + WS_WI) + tok * 16 + 4 * hh;
#pragma unroll
            for (int g = 0; g < 2; ++g) *(f32x4*)(o + 8 * g) = (f32x4){acc[4 * g] * IDXS, acc[4 * g + 1] * IDXS, acc[4 * g + 2] * IDXS, acc[4 * g + 3] * IDXS};
        }
    }
}
__device__ __forceinline__ void phase_gemm2(const Params& p, LAS unsigned char* lds, int bid, int nblk) {
    pg8::Gemm g{(const h16*)(p.ws + WS_MIX), (const h16*)(p.ws + WS_W2T), MTOK, DM, DM};
    pg8::StaticOrder S; S.init(MTOK, DM, nblk, bid);
    EpiOut E{p.x, p.out};
    pg8::gemm_phase<EpiOut, pg8::StaticOrder, true, true>(lds, g, S, E);
}
#define XB_TMO      128
#define XB_XCNT(j)  (256  + 64 * (j))
#define XB_XSUB(j)  (1280 + 64 * (j))
#define XB_XGEN(j)  (2304 + 64 * (j))
#define XB_TOP      3328
#define XB_TOPGEN   3392
#define XCD_BAR_WORDS 3456
#define XB_SPIN_CAP (1u << 22)
__device__ __forceinline__ unsigned xb_ld(unsigned* p)              { return __hip_atomic_load(p, __ATOMIC_RELAXED, __HIP_MEMORY_SCOPE_AGENT); }
__device__ __forceinline__ unsigned xb_add(unsigned* p, unsigned v) { return __hip_atomic_fetch_add(p, v, __ATOMIC_RELAXED, __HIP_MEMORY_SCOPE_AGENT); }
__device__ __forceinline__ unsigned xb_xcc_id() { return (unsigned)__builtin_amdgcn_s_getreg((3 << 11) | 20) & 0xFu; }
#define XB_SPIN(cond, bar) do { unsigned _sp = 0; while (cond) { __builtin_amdgcn_s_sleep(1); \
    if ((++_sp & 255u) == 0u) { if (xb_ld(&(bar)[XB_TMO])) break; if (_sp > XB_SPIN_CAP) { atomicAdd(&(bar)[XB_TMO], 1u); break; } } } } while (0)
struct XcdBarrier { unsigned* bar; unsigned x; volatile LAS unsigned* st; };
__device__ __forceinline__ XcdBarrier xcd_barrier_post(unsigned* bar, volatile LAS unsigned* st) {
    XcdBarrier b; b.bar = bar; b.x = xb_xcc_id(); b.st = st;
    if (threadIdx.x == 0) (void)xb_add(&bar[XB_XCNT(b.x)], 1u);
    return b;
}
__device__ __forceinline__ void xcd_barrier_complete(unsigned* bar, unsigned x, unsigned& nloc, unsigned& nx) {
    const unsigned G = gridDim.x * gridDim.y * gridDim.z;
    unsigned sum, cnt, mine, sp = 0u;
    for (;;) {
        sum = 0u; cnt = 0u; mine = 0u;
#pragma unroll
        for (unsigned j = 0; j < 16; ++j) { const unsigned c = xb_ld(&bar[XB_XCNT(j)]); sum += c; cnt += (c > 0u) ? 1u : 0u; mine = (j == x) ? c : mine; }
        if (sum == G) break;
        __builtin_amdgcn_s_sleep(1);
        if ((++sp & 255u) == 0u) { if (xb_ld(&bar[XB_TMO])) break; if (sp > XB_SPIN_CAP) { atomicAdd(&bar[XB_TMO], 1u); break; } }
    }
    nloc = mine > 0u ? mine : 1u; nx = cnt > 0u ? cnt : 1u;
}
__device__ __forceinline__ void xcd_barrier(const XcdBarrier& b) {
    asm volatile("s_waitcnt vmcnt(0)" ::: "memory");
    __syncthreads();
    if (threadIdx.x == 0) {
        unsigned* bar = b.bar;
        __builtin_amdgcn_s_waitcnt(0);
        unsigned nloc = b.st[0], nx = b.st[1];
        if (nloc == 0u) { xcd_barrier_complete(bar, b.x, nloc, nx); b.st[0] = nloc; b.st[1] = nx; }
        const unsigned old = xb_add(&bar[XB_XSUB(b.x)], 1u);
        const unsigned gen = old / nloc;
        if (old + 1u == (gen + 1u) * nloc) {
            __builtin_amdgcn_fence(__ATOMIC_RELEASE, "agent");
            asm volatile("s_waitcnt vmcnt(0)" ::: "memory");
            const unsigned og = xb_add(&bar[XB_TOP], 1u);
            const unsigned tg = og / nx;
            if (og + 1u == (tg + 1u) * nx) xb_add(&bar[XB_TOPGEN], 1u);
            else XB_SPIN(xb_ld(&bar[XB_TOPGEN]) == tg, bar);
            xb_add(&bar[XB_XGEN(b.x)], 1u);
            __builtin_amdgcn_fence(__ATOMIC_ACQUIRE, "agent");
            asm volatile("s_waitcnt vmcnt(0)" ::: "memory");
        } else {
            XB_SPIN(xb_ld(&bar[XB_XGEN(b.x)]) == gen, bar);
            __builtin_amdgcn_fence(__ATOMIC_ACQUIRE, "agent");
            asm volatile("s_waitcnt vmcnt(0)" ::: "memory");
        }
    }
    __syncthreads();
}
#define XB_FLAT(k)  (3520 + 64 * (k))
__device__ __forceinline__ void flat_arrive(const XcdBarrier& b, int k) {
    asm volatile("s_waitcnt vmcnt(0)" ::: "memory");
    __syncthreads();
    if (threadIdx.x == 0) (void)xb_add(&b.bar[XB_FLAT(k)], 1u);
}
__device__ __forceinline__ void flat_wait(const XcdBarrier& b, int k) {
    if (threadIdx.x == 0) { const unsigned G = gridDim.x * gridDim.y * gridDim.z; XB_SPIN(xb_ld(&b.bar[XB_FLAT(k)]) < G, b.bar); }
    __syncthreads();
}
__device__ __forceinline__ int crow(int r, int hi) { return (r & 3) + 8 * (r >> 2) + 4 * hi; }
constexpr int KSTR = 144, VSTR = 192;
constexpr int KT_BYTES = 64 * KSTR, VT_BYTES = 64 * VSTR;
constexpr int MT_BYTES = 2048;
constexpr int ATT_BUF = KT_BYTES + VT_BYTES + MT_BYTES;
constexpr int ATT_TAB = 2 * ATT_BUF;
constexpr int OSTR = 144, ATT_OST = ATT_TAB + 2304;
constexpr float SB_EXIT = 64.f;
__device__ __forceinline__ s16x4 vtr(LAS const unsigned char* p) { return __builtin_amdgcn_ds_read_tr16_b64_v4i16((LAS s16x4*)p); }
__device__ __forceinline__ h16x8 mk8(s16x4 a, s16x4 b) { typedef short s16x8 __attribute__((ext_vector_type(8))); s16x8 r = {a[0], a[1], a[2], a[3], b[0], b[1], b[2], b[3]}; return __builtin_bit_cast(h16x8, r); }
__device__ __forceinline__ h16x8 pack8(float a0, float a1, float a2, float a3, float a4, float a5, float a6, float a7) {
    u32x4 w; w.x = pk2h(a0, a1); w.y = pk2h(a2, a3); w.z = pk2h(a4, a5); w.w = pk2h(a6, a7); return __builtin_bit_cast(h16x8, w); }
__device__ __forceinline__ float bcast_lo(float v) { const unsigned u = __float_as_uint(v); auto rr = __builtin_amdgcn_permlane32_swap(u, u, false, false); return __uint_as_float(rr[0]); }
__device__ __forceinline__ f32x16 splat16(float v) { f32x16 r;
#pragma unroll
    for (int i = 0; i < 16; ++i) r[i] = v;
    return r; }

struct KVStage { u32x4 k, v; unsigned m; };
template <bool MASK>
__device__ __forceinline__ void kv_load(KVStage& st, const h16* Kg, const h16* Vg, const unsigned* Mg, int tile, int tid) {
    const size_t off = (size_t)(tile * 64 + (tid >> 3)) * 512 + (tid & 7) * 8;
    const h16* kp = Kg + off; const h16* vp = Vg + off;
    asm volatile("global_load_dwordx4 %0, %1, off" : "=v"(st.k) : "v"(kp) : "memory");
    asm volatile("global_load_dwordx4 %0, %1, off" : "=v"(st.v) : "v"(vp) : "memory");
    if (MASK) { const unsigned* mp = Mg + (size_t)(2 * tile + (tid >> 8)) * SEQ + (tid & 255); asm volatile("global_load_dword %0, %1, off" : "=v"(st.m) : "v"(mp) : "memory"); }
}
template <int N>
__device__ __forceinline__ void kv_wait(KVStage& st) {
    asm volatile("s_waitcnt vmcnt(%0)" :: "n"(N) : "memory");
    asm volatile("" : "+v"(st.k), "+v"(st.v), "+v"(st.m));
}
template <bool MASK>
__device__ __forceinline__ void kv_store(const KVStage& st, LAS unsigned char* buf, int tid) {
    *(LAS u32x4*)(buf + (tid >> 3) * KSTR + (tid & 7) * 16) = st.k;
    *(LAS u32x4*)(buf + KT_BYTES + (tid >> 3) * VSTR + (tid & 7) * 16) = st.v;
    if (MASK) *(LAS unsigned*)(buf + KT_BYTES + VT_BYTES + tid * 4) = st.m;
}
__device__ __forceinline__ f32x16 qk_tile(LAS const unsigned char* kb, int sub, const h16x8 (&qf)[4], int r32, int hh, f32x16 cinit = f32x16{}) {
    LAS const unsigned char* kp = kb + (sub * 32 + r32) * KSTR + hh * 16;
    f32x16 acc = cinit;
#pragma unroll
    for (int ks = 0; ks < 4; ++ks) { const h16x8 kf = *(LAS const h16x8*)(kp + ks * 32); acc = __builtin_amdgcn_mfma_f32_32x32x16_f16(kf, qf[ks], acc, 0, 0, 0); }
    return acc;
}
__device__ __forceinline__ void pv_tile(f32x16 (&o)[2], LAS const unsigned char* vb, int sub, const h16x8 (&pa)[2], int lane) {
    const int g = lane >> 4, i = lane & 15, q = i >> 2, pp = i & 3;
    LAS const unsigned char* vp = vb + (sub * 32 + 4 * (g >> 1) + q) * VSTR + (16 * (g & 1) + 4 * pp) * 2;
#pragma unroll
    for (int db = 0; db < 2; ++db)
#pragma unroll
        for (int s2 = 0; s2 < 2; ++s2) {
            const s16x4 lo = vtr(vp + (16 * s2) * VSTR + db * 64), hi = vtr(vp + (16 * s2 + 8) * VSTR + db * 64);
            o[db] = __builtin_amdgcn_mfma_f32_32x32x16_f16(pa[s2], mk8(lo, hi), o[db], 0, 0, 0);
        }
}
__device__ __forceinline__ void att_store(const f32x16 (&o)[2], LAS unsigned char* ost, const LAS float* rs, const h16* Gg, h16* Og, int qw, int lane) {
    const int r32 = lane & 31, hh = lane >> 5;
#pragma unroll
    for (int db = 0; db < 2; ++db)
#pragma unroll
        for (int r = 0; r < 16; ++r) *(LAS h16*)(ost + crow(r, hh) * OSTR + (32 * db + r32) * 2) = (h16)o[db][r];
    asm volatile("s_waitcnt lgkmcnt(0)" ::: "memory");
    const int ch = lane & 7;
#pragma unroll
    for (int i = 0; i < 4; ++i) {
        const int row = 8 * i + (lane >> 3);
        const float sc = rs ? 1.f / rs[row] : 1.f;
        const size_t tok = (size_t)(qw + row);
        const h16x8 ov = *(const LAS h16x8*)(ost + row * OSTR + ch * 16);
        const h16x8 gv = *(const h16x8*)(Gg + tok * 512 + ch * 8);
        u32x4 w;
        w.x = pk2h((float)ov[0] * sc * (float)gv[0], (float)ov[1] * sc * (float)gv[1]); w.y = pk2h((float)ov[2] * sc * (float)gv[2], (float)ov[3] * sc * (float)gv[3]);
        w.z = pk2h((float)ov[4] * sc * (float)gv[4], (float)ov[5] * sc * (float)gv[5]); w.w = pk2h((float)ov[6] * sc * (float)gv[6], (float)ov[7] * sc * (float)gv[7]);
        *(u32x4*)(Og + tok * 1024 + ch * 8) = w;
    }
}
__device__ __forceinline__ void k_frags(h16x8 (&kf)[4], LAS const unsigned char* kb, int sub, int r32, int hh) {
    LAS const unsigned char* kp = kb + (sub * 32 + r32) * KSTR + hh * 16;
#pragma unroll
    for (int ks = 0; ks < 4; ++ks) kf[ks] = *(LAS const h16x8*)(kp + ks * 32);
}
__device__ __forceinline__ void v_frags(h16x8 (&vf)[2][2], LAS const unsigned char* vb, int sub, int lane) {
    const int g = lane >> 4, i = lane & 15, q = i >> 2, pp = i & 3;
    LAS const unsigned char* vp = vb + (sub * 32 + 4 * (g >> 1) + q) * VSTR + (16 * (g & 1) + 4 * pp) * 2;
#pragma unroll
    for (int db = 0; db < 2; ++db)
#pragma unroll
        for (int s2 = 0; s2 < 2; ++s2) vf[db][s2] = mk8(vtr(vp + (16 * s2) * VSTR + db * 64), vtr(vp + (16 * s2 + 8) * VSTR + db * 64));
}
__device__ __forceinline__ f32x16 qk_mma(const h16x8 (&kf)[4], const h16x8 (&qf)[4], f32x16 acc) {
#pragma unroll
    for (int ks = 0; ks < 4; ++ks) acc = __builtin_amdgcn_mfma_f32_32x32x16_f16(kf[ks], qf[ks], acc, 0, 0, 0);
    return acc;
}
__device__ __forceinline__ void pv_mma(f32x16 (&o)[2], const h16x8 (&vf)[2][2], const h16x8 (&pa)[2]) {
#pragma unroll
    for (int db = 0; db < 2; ++db)
#pragma unroll
        for (int s2 = 0; s2 < 2; ++s2) o[db] = __builtin_amdgcn_mfma_f32_32x32x16_f16(pa[s2], vf[db][s2], o[db], 0, 0, 0);
}

typedef short b16x8 __attribute__((ext_vector_type(8)));
__device__ __forceinline__ b16x8 pack8b(float a0, float a1, float a2, float a3, float a4, float a5, float a6, float a7) {
    u32x4 w; w.x = pk2b(a0, a1); w.y = pk2b(a2, a3); w.z = pk2b(a4, a5); w.w = pk2b(a6, a7); return __builtin_bit_cast(b16x8, w); }
__device__ __forceinline__ void pv_mma_b(f32x16 (&o)[2], const h16x8 (&vf)[2][2], const b16x8 (&pa)[2]) {
#pragma unroll
    for (int db = 0; db < 2; ++db)
#pragma unroll
        for (int s2 = 0; s2 < 2; ++s2) o[db] = __builtin_amdgcn_mfma_f32_32x32x16_bf16(pa[s2], __builtin_bit_cast(b16x8, vf[db][s2]), o[db], 0, 0, 0);
}
#define SCHED_FENCE() __builtin_amdgcn_sched_barrier(0)
#define LDS_BARRIER() asm volatile("s_waitcnt lgkmcnt(0)\n\ts_barrier" ::: "memory")
__device__ __forceinline__ void att_unit(int u, int& b, int& h, int& qb) { const int pass = u >> 8, x = u & 7, m = (u >> 3) & 31; h = x; b = 4 * pass + (m & 3); qb = pass ? (m >> 2) : 7 - (m >> 2); }


constexpr int HALF_LDS = 65536;
constexpr int MISC_OFF = 131072;
struct Half { int hf, ht, hw, lane; LAS unsigned char* lds; LAS unsigned* bar; unsigned tgt; };
__device__ __forceinline__ Half half_init(LAS unsigned char* lds_all) {
    const int tid = opaque_tid(); Half H;
    H.hf = __builtin_amdgcn_readfirstlane(tid >> 8); H.ht = tid & 255; H.hw = __builtin_amdgcn_readfirstlane((tid >> 6) & 3); H.lane = tid & 63;
    H.lds = lds_all + H.hf * HALF_LDS; H.bar = (LAS unsigned*)(lds_all + MISC_OFF + 64 + 64 * H.hf); H.tgt = 0u;
    return H;
}
__device__ __forceinline__ void half_barrier(Half& H) {
    asm volatile("s_waitcnt lgkmcnt(0)" ::: "memory");
    H.tgt += 4u;
    if (H.lane == 0) (void)__hip_atomic_fetch_add(H.bar, 1u, __ATOMIC_RELAXED, __HIP_MEMORY_SCOPE_WORKGROUP);
    while (__hip_atomic_load(H.bar, __ATOMIC_RELAXED, __HIP_MEMORY_SCOPE_WORKGROUP) < H.tgt) __builtin_amdgcn_s_sleep(1);
    asm volatile("" ::: "memory");
}
constexpr int H_MT = 1024;
constexpr int H_BUF = KT_BYTES + VT_BYTES + H_MT;
constexpr int H_MISC = 2 * H_BUF;
constexpr int H_OST = H_MISC + 2048;
struct KV2 { u32x4 k[2], v[2]; unsigned m; };
template <bool MASK>
__device__ __forceinline__ void kv2_load(KV2& st, const h16* Kg, const h16* Vg, const unsigned* Mq, int tile, int ht) {
#pragma unroll
    for (int i = 0; i < 2; ++i) { const int idx = ht + 256 * i; const size_t off = (size_t)(tile * 64 + (idx >> 3)) * 512 + (idx & 7) * 8; st.k[i] = *(const u32x4*)(Kg + off); st.v[i] = *(const u32x4*)(Vg + off); }
    if (MASK) st.m = Mq[(size_t)(2 * tile + (ht >> 7)) * SEQ + (ht & 127)];
}
template <bool MASK>
__device__ __forceinline__ void kv2_store(const KV2& st, LAS unsigned char* buf, int ht) {
#pragma unroll
    for (int i = 0; i < 2; ++i) { const int idx = ht + 256 * i; *(LAS u32x4*)(buf + (idx >> 3) * KSTR + (idx & 7) * 16) = st.k[i]; *(LAS u32x4*)(buf + KT_BYTES + (idx >> 3) * VSTR + (idx & 7) * 16) = st.v[i]; }
    if (MASK) *(LAS unsigned*)(buf + KT_BYTES + VT_BYTES + ht * 4) = st.m;
}
__device__ __forceinline__ void att2_unit(int u, int& b, int& h, int& q16) {
    const int pass = u >> 9, v = u & 511, hf = v & 1, blk = v >> 1, x = blk & 7, e = 2 * (blk >> 3) + hf;
    h = x; b = 4 * pass + (e & 3); q16 = pass ? (e >> 2) : 15 - (e >> 2);
}
__device__ __forceinline__ void sb_softplus(const f32x16& z, h16x8 (&lf)[2], bool dg, int r32, int hh) {
    float L[16];
#pragma unroll
    for (int r = 0; r < 16; ++r) { float l = __builtin_amdgcn_logf(1.f + __builtin_amdgcn_exp2f(z[r])); if (dg && crow(r, hh) >= r32) l = 0.f; L[r] = l; }
    lf[0] = pack8(L[0], L[1], L[2], L[3], L[4], L[5], L[6], L[7]); lf[1] = pack8(L[8], L[9], L[10], L[11], L[12], L[13], L[14], L[15]);
}
__device__ __forceinline__ void sb_weights(const f32x16& z, const f32x16& y, h16x8 (&pa)[2], bool dg, int r32, int hh) {
    float A[16];
#pragma unroll
    for (int r = 0; r < 16; ++r) { float a = __builtin_amdgcn_exp2f(z[r] - y[r]); if (dg && crow(r, hh) >= r32) a = 0.f; A[r] = a; }
    pa[0] = pack8(A[0], A[1], A[2], A[3], A[4], A[5], A[6], A[7]); pa[1] = pack8(A[8], A[9], A[10], A[11], A[12], A[13], A[14], A[15]);
}
__device__ __forceinline__ f32x16 sb_cum(const h16x8 (&tri)[2], const h16x8 (&lf)[2], float carry) {
    f32x16 y = splat16(carry);
    y = __builtin_amdgcn_mfma_f32_32x32x16_f16(tri[0], lf[0], y, 0, 0, 0);
    y = __builtin_amdgcn_mfma_f32_32x32x16_f16(tri[1], lf[1], y, 0, 0, 0);
    return y;
}

__device__ __forceinline__ void sb2_unit(const Params& p, Half& H, int b, int h, int q16) {
    const int lane = H.lane, hw = H.hw, ht = H.ht, r32 = lane & 31, hh = lane >> 5;
    LAS unsigned char* lds = H.lds;
    const h16* Qg = (const h16*)(p.ws + WS_QB) + (size_t)b * SEQ * 512 + h * 64;
    const h16* Kg = (const h16*)(p.ws + WS_KB) + (size_t)b * SEQ * 512 + h * 64;
    const h16* Vg = (const h16*)(p.ws + WS_VB) + (size_t)b * SEQ * 512 + h * 64;
    const h16* Gg = (const h16*)(p.ws + WS_GB) + (size_t)b * SEQ * 512 + h * 64;
    h16* Og = (h16*)(p.ws + WS_MIX) + (size_t)b * SEQ * 1024 + 512 + h * 64;
    const int q0 = q16 * 128, qw = q0 + hw * 32;
    const int jmax = 2 * q16 + 1, diag = qw >> 5;
    KV2 st; kv2_load<false>(st, Kg, Vg, nullptr, jmax, ht);
    h16x8 qf[4];
#pragma unroll
    for (int ks = 0; ks < 4; ++ks) qf[ks] = *(const h16x8*)(Qg + (size_t)(qw + r32) * 512 + ks * 16 + hh * 8);
    h16x8 tri[2];
#pragma unroll
    for (int s2 = 0; s2 < 2; ++s2)
#pragma unroll
        for (int jj = 0; jj < 8; ++jj) { const int j = 16 * s2 + 8 * (jj >> 2) + 4 * hh + (jj & 3); tri[s2][jj] = (j >= r32) ? (h16)1.0f : (h16)0.0f; }
    f32x16 o[2]; o[0] = f32x16{}; o[1] = f32x16{};
    LAS unsigned* flg = (LAS unsigned*)(lds + H_MISC + 1536);
    float carry = 0.f;
    asm volatile("" : "+v"(qf[0]), "+v"(qf[1]), "+v"(qf[2]), "+v"(qf[3]));
    int cur = 0;
    kv2_store<false>(st, lds, ht);
    half_barrier(H);
    const int jd = diag >> 1;
    int j = jmax; bool fin = false;
#define SB_STAGE_IN()  if (j > 0) kv2_load<false>(st, Kg, Vg, nullptr, j - 1, ht); \
        LAS const unsigned char* kb = lds + cur * H_BUF; LAS const unsigned char* vb = kb + KT_BYTES;
#define SB_STAGE_OUT() if (j > 0) kv2_store<false>(st, lds + (cur ^ 1) * H_BUF, ht); \
        if (lane == 0) flg[(j & 1) * 4 + hw] = (2 * j <= diag && __all(carry > SB_EXIT)) ? 1u : 0u; \
        half_barrier(H); \
        cur ^= 1; \
        { const unsigned f = flg[(j & 1) * 4 + (lane & 3)]; if (__all(f != 0u)) fin = true; }
    for (; j > jd && !fin; --j) { SB_STAGE_IN() (void)kb; (void)vb; SB_STAGE_OUT() }
    if (!fin && j == jd) {
        SB_STAGE_IN()
#pragma unroll
        for (int sub = 1; sub >= 0; --sub) {
            const int si = 2 * j + sub;
            if (si <= diag) {
                const bool dg = (si == diag);
                const f32x16 z = qk_tile(kb, sub, qf, r32, hh);
                h16x8 lf[2], pa[2];
                sb_softplus(z, lf, dg, r32, hh);
                const f32x16 y = sb_cum(tri, lf, carry);
                sb_weights(z, y, pa, dg, r32, hh);
                carry = bcast_lo(y[0]);
                pv_tile(o, vb, sub, pa, lane);
            }
        }
        SB_STAGE_OUT()
        --j;
    }
    for (; j >= 0 && !fin; --j) {
        SB_STAGE_IN()
        const f32x16 z1 = qk_tile(kb, 1, qf, r32, hh);
        const f32x16 z0 = qk_tile(kb, 0, qf, r32, hh);
        h16x8 lf1[2], lf0[2], pa1[2], pa0[2];
        sb_softplus(z1, lf1, false, r32, hh);
        const f32x16 y1 = sb_cum(tri, lf1, carry);
        sb_softplus(z0, lf0, false, r32, hh);
        const float c1 = bcast_lo(y1[0]);
        const f32x16 y0 = sb_cum(tri, lf0, c1);
        sb_weights(z1, y1, pa1, false, r32, hh);
        pv_tile(o, vb, 1, pa1, lane);
        sb_weights(z0, y0, pa0, false, r32, hh);
        pv_tile(o, vb, 0, pa0, lane);
        carry = bcast_lo(y0[0]);
        SB_STAGE_OUT()
    }
#undef SB_STAGE_IN
#undef SB_STAGE_OUT
    att_store(o, lds + H_OST + hw * (32 * OSTR), nullptr, Gg, Og, qw, lane);
}
__device__ __forceinline__ void phase_sb2(const Params& p, Half& H, int bid, int nblk) {
    for (int u = 2 * bid + H.hf; u < 1024; u += 2 * nblk) { int b, h, q16; att2_unit(u, b, h, q16); sb2_unit(p, H, b, h, q16); }
}
__device__ __forceinline__ void sa_probs(const f32x16& s, unsigned mw, const LAS float* btab, bool nearby, b16x8 (&pa)[2], f32x16& osum, const b16x8& ones, int hh) {
    float P[16];
    if (nearby) {
#pragma unroll
        for (int r = 0; r < 16; ++r) P[r] = __builtin_amdgcn_exp2f(s[r] + btab[27 - ((r & 3) + 8 * (r >> 2))]);
    } else {
#pragma unroll
        for (int r = 0; r < 16; ++r) P[r] = __builtin_amdgcn_exp2f(s[r]);
    }
#pragma unroll
    for (int r = 0; r < 16; ++r) { const int bit = (r & 3) + 8 * (r >> 2); unsigned m_; asm("v_bfe_i32 %0, %1, %2, 1" : "=v"(m_) : "v"(mw), "n"(bit)); P[r] = __uint_as_float(__float_as_uint(P[r]) & m_); }
    pa[0] = pack8b(P[0], P[1], P[2], P[3], P[4], P[5], P[6], P[7]); pa[1] = pack8b(P[8], P[9], P[10], P[11], P[12], P[13], P[14], P[15]);
    osum = __builtin_amdgcn_mfma_f32_32x32x16_bf16(pa[0], ones, osum, 0, 0, 0);
    osum = __builtin_amdgcn_mfma_f32_32x32x16_bf16(pa[1], ones, osum, 0, 0, 0);
}
constexpr int A_KT = 128 * KSTR, A_VT = 128 * VSTR, A_MT = 4096;
constexpr int A_BUF = A_KT + A_VT + A_MT;
constexpr int A_TAB = 2 * A_BUF;
struct KV1 { u32x4 k[2], v[2]; unsigned m[2]; };
__device__ __forceinline__ void kv1_load(KV1& st, const h16* Kg, const h16* Vg, const unsigned* Mq, int tile, int tid) {
#pragma unroll
    for (int i = 0; i < 2; ++i) { const int idx = tid + 512 * i; const size_t off = (size_t)(tile * 128 + (idx >> 3)) * 512 + (idx & 7) * 8;
        st.k[i] = *(const u32x4*)(Kg + off); st.v[i] = *(const u32x4*)(Vg + off);
        st.m[i] = __hip_atomic_load(Mq + (size_t)(4 * tile + (idx >> 8)) * SEQ + (idx & 255), __ATOMIC_RELAXED, __HIP_MEMORY_SCOPE_AGENT); }
}
__device__ __forceinline__ void kv1_store(const KV1& st, LAS unsigned char* buf, int tid) {
#pragma unroll
    for (int i = 0; i < 2; ++i) { const int idx = tid + 512 * i;
        *(LAS u32x4*)(buf + (idx >> 3) * KSTR + (idx & 7) * 16) = st.k[i];
        *(LAS u32x4*)(buf + A_KT + (idx >> 3) * VSTR + (idx & 7) * 16) = st.v[i];
        *(LAS unsigned*)(buf + A_KT + A_VT + idx * 4) = st.m[i]; }
}
__device__ __forceinline__ void sa_unit(const Params& p, LAS unsigned char* lds, int b, int h, int qb) {
    const int tid = opaque_tid(), lane = tid & 63, wv = __builtin_amdgcn_readfirstlane(tid >> 6), r32 = lane & 31, hh = lane >> 5;
    const h16* Qg = (const h16*)(p.ws + WS_QA) + (size_t)b * SEQ * 512 + h * 64;
    const h16* Kg = (const h16*)(p.ws + WS_KA) + (size_t)b * SEQ * 512 + h * 64;
    const h16* Vg = (const h16*)(p.ws + WS_VA) + (size_t)b * SEQ * 512 + h * 64;
    const h16* Gg = (const h16*)(p.ws + WS_GA) + (size_t)b * SEQ * 512 + h * 64;
    h16* Og = (h16*)(p.ws + WS_MIX) + (size_t)b * SEQ * 1024 + h * 64;
    const int q0 = qb * 256, qw = q0 + wv * 32;
    const unsigned* Mq = (const unsigned*)(p.ws + WS_MASK) + (size_t)b * 64 * SEQ + q0;
    LAS float* btab = (LAS float*)(lds + A_TAB);
    LAS float* lx = (LAS float*)(lds + A_TAB + 1280);
    const int jmax = 2 * qb + 1, diag = qw >> 5;
    KV1 st; kv1_load(st, Kg, Vg, Mq, 0, tid);
    __syncthreads();
    if (tid < 320) { const int d = tid - 32; btab[tid] = (p.rel_bias[T5_BUCKET[d < 0 ? 0 : (d > 127 ? 127 : d)] * 8 + h] - p.rel_bias[31 * 8 + h]) * LOG2E; }
    h16x8 qf[4];
#pragma unroll
    for (int ks = 0; ks < 4; ++ks) qf[ks] = *(const h16x8*)(Qg + (size_t)(qw + r32) * 512 + ks * 16 + hh * 8);
    f32x16 o[2]; o[0] = f32x16{}; o[1] = f32x16{};
    f32x16 osum = f32x16{};
    b16x8 ones;
#pragma unroll
    for (int i = 0; i < 8; ++i) ones[i] = (short)0x3F80;
    const int tq = qw + r32;
    asm volatile("" : "+v"(qf[0]), "+v"(qf[1]), "+v"(qf[2]), "+v"(qf[3]));
    int cur = 0;
    kv1_store(st, lds, tid);
    __syncthreads();
    const int jf = (qw - 112) > 0 ? ((qw - 112) >> 7) : 0;
    const int jd = diag >> 2;
    int j = 0;
#define SA_STAGE_IN()  if (j < jmax) kv1_load(st, Kg, Vg, Mq, j + 1, tid); \
        LAS const unsigned char* kb = lds + cur * A_BUF; LAS const unsigned char* vb = kb + A_KT; \
        const LAS unsigned* mb = (const LAS unsigned*)(kb + A_KT + A_VT) + wv * 32 + r32;
#define SA_STAGE_OUT() if (j < jmax) kv1_store(st, lds + (cur ^ 1) * A_BUF, tid); \
        LDS_BARRIER(); \
        cur ^= 1;
    for (; j < jf; ++j) {
        SA_STAGE_IN()
#pragma unroll
        for (int pr = 0; pr < 2; ++pr) {
            const unsigned mw0 = mb[(2 * pr) * 256] >> (4 * hh), mw1 = mb[(2 * pr + 1) * 256] >> (4 * hh);
            h16x8 kf0[4], kf1[4], vf0[2][2], vf1[2][2]; b16x8 pa0[2], pa1[2];
            k_frags(kf0, kb, 2 * pr, r32, hh); k_frags(kf1, kb, 2 * pr + 1, r32, hh); v_frags(vf0, vb, 2 * pr, lane);
            SCHED_FENCE();
            const f32x16 s0 = qk_mma(kf0, qf, f32x16{});
            const f32x16 s1 = qk_mma(kf1, qf, f32x16{});
            v_frags(vf1, vb, 2 * pr + 1, lane);
            SCHED_FENCE();
            sa_probs(s0, mw0, btab, false, pa0, osum, ones, hh);
            pv_mma_b(o, vf0, pa0);
            sa_probs(s1, mw1, btab, false, pa1, osum, ones, hh);
            pv_mma_b(o, vf1, pa1);
        }
        SA_STAGE_OUT()
    }
    for (; j <= jd; ++j) {
        SA_STAGE_IN()
#pragma unroll
        for (int sub = 0; sub < 4; ++sub) {
            const int si = 4 * j + sub;
            if (si <= diag) {
                const unsigned mw = mb[sub * 256] >> (4 * hh);
                const f32x16 s = qk_tile(kb, sub, qf, r32, hh);
                b16x8 pa[2]; h16x8 vfn[2][2];
                v_frags(vfn, vb, sub, lane);
                sa_probs(s, mw, btab + (tq - 32 * si + 5 - 4 * hh), true, pa, osum, ones, hh);
                pv_mma_b(o, vfn, pa);
            }
        }
        SA_STAGE_OUT()
    }
    for (; j <= jmax; ++j) {
        SA_STAGE_IN()
        (void)vb; (void)mb;
        SA_STAGE_OUT()
    }
#undef SA_STAGE_IN
#undef SA_STAGE_OUT
    if (r32 == 0) {
#pragma unroll
        for (int r = 0; r < 16; ++r) lx[wv * 32 + crow(r, hh)] = osum[r];
    }
    att_store(o, lds + wv * (32 * OSTR), lx + wv * 32, Gg, Og, qw, lane);
}
__device__ __forceinline__ void phase_sa(const Params& p, LAS unsigned char* lds, int bid, int nblk) {
    for (int u = bid; u < 512; u += nblk) { int b, h, qb; att_unit(u, b, h, qb); sa_unit(p, lds, b, h, qb); }
}
constexpr int IK_STR = 144, IK_BUF = 256 * IK_STR, IK_SB = 2 * IK_BUF;
__device__ __forceinline__ int half_sum(int v) {
    v += __builtin_amdgcn_update_dpp(0, v, 0xB1, 0xF, 0xF, false);
    v += __builtin_amdgcn_update_dpp(0, v, 0x4E, 0xF, 0xF, false);
    v += __builtin_amdgcn_update_dpp(0, v, 0x141, 0xF, 0xF, false);
    v += __builtin_amdgcn_update_dpp(0, v, 0x140, 0xF, 0xF, false);
    { auto rr = __builtin_amdgcn_permlane16_swap((unsigned)v, (unsigned)v, false, false); v = (int)(rr[0] + rr[1]); }
    return v;
}
__device__ __forceinline__ unsigned half_umax(unsigned v) {
    unsigned o;
    o = (unsigned)__builtin_amdgcn_update_dpp(0, (int)v, 0xB1, 0xF, 0xF, false); v = v > o ? v : o;
    o = (unsigned)__builtin_amdgcn_update_dpp(0, (int)v, 0x4E, 0xF, 0xF, false); v = v > o ? v : o;
    o = (unsigned)__builtin_amdgcn_update_dpp(0, (int)v, 0x141, 0xF, 0xF, false); v = v > o ? v : o;
    o = (unsigned)__builtin_amdgcn_update_dpp(0, (int)v, 0x140, 0xF, 0xF, false); v = v > o ? v : o;
    { auto rr = __builtin_amdgcn_permlane16_swap(v, v, false, false); v = rr[0] > rr[1] ? rr[0] : rr[1]; }
    return v;
}
__device__ __forceinline__ float keyf(unsigned k) { return __uint_as_float((k & 0x80000000u) ? (k ^ 0x80000000u) : ~k); }
__device__ __forceinline__ void ik_load(u32x4 (&sk)[4], const h16* KI, int g, int tid) {
#pragma unroll
    for (int i = 0; i < 4; ++i) { const int idx = tid + 512 * i; sk[i] = *(const u32x4*)(KI + (size_t)(256 * g + (idx >> 3)) * 64 + (idx & 7) * 8); }
}
__device__ __forceinline__ void ik_store(const u32x4 (&sk)[4], LAS unsigned char* buf, int tid) {
#pragma unroll
    for (int i = 0; i < 4; ++i) { const int idx = tid + 512 * i; *(LAS u32x4*)(buf + (idx >> 3) * IK_STR + (idx & 7) * 16) = sk[i]; }
}
struct IdxPre { u32x4 sk[4]; h16x8 aq[4]; };
__device__ __forceinline__ void idx_prefetch(IdxPre& pre, const Params& p, int b, int qt) {
    const int tid = opaque_tid(), lane = tid & 63, wv = __builtin_amdgcn_readfirstlane(tid >> 6), c = lane & 31, hi = lane >> 5;
    const h16* QI = (const h16*)(p.ws + WS_QI) + (size_t)b * SEQ * 1024;
    const h16* KI = (const h16*)(p.ws + WS_KI) + (size_t)b * SEQ * 64;
    const int t0 = qt * 16 + wv * 2;
    ik_load(pre.sk, KI, 0, tid);
    const int rq = (c >> 2) & 1, rh = (c & 3) + 4 * (c >> 3);
#pragma unroll
    for (int ks = 0; ks < 4; ++ks) pre.aq[ks] = *(const h16x8*)(QI + (size_t)(t0 + rq) * 1024 + rh * 64 + ks * 16 + hi * 8);
}
__device__ __forceinline__ void idx_unit(const Params& p, LAS unsigned char* lds, int b, int qt, IdxPre& pre, bool has_next, int nb, int nqt, IdxPre& pre_next) {
    const int tid = opaque_tid(), lane = tid & 63, wv = __builtin_amdgcn_readfirstlane(tid >> 6), c = lane & 31, hi = lane >> 5;
    const h16* KI = (const h16*)(p.ws + WS_KI) + (size_t)b * SEQ * 64;
    unsigned* Mg = (unsigned*)(p.ws + WS_MASK) + (size_t)b * 64 * SEQ;
    const int t0 = qt * 16 + wv * 2, t = t0 + hi;
    u32x4 (&sk)[4] = pre.sk;
    h16x8 aq[4];
#pragma unroll
    for (int ks = 0; ks < 4; ++ks) aq[ks] = pre.aq[ks];
    const float* WI = (const float*)(p.ws + WS_WI) + (size_t)b * SEQ * 16;
    float wq[16];
#pragma unroll
    for (int i = 0; i < 4; ++i) { const f32x4 w4 = *(const f32x4*)(WI + (size_t)t * 16 + 4 * i); wq[4 * i] = w4.x; wq[4 * i + 1] = w4.y; wq[4 * i + 2] = w4.z; wq[4 * i + 3] = w4.w; }
    const int ntile = ((t0 + 1) >> 5) + 1;
    const int ngroup = ((qt * 16 + 15) >> 8) + 1;
    LAS unsigned* sb = (LAS unsigned*)(lds + IK_SB + wv * 2048);
    unsigned u[64];
#pragma unroll
    for (int j = 0; j < 64; ++j) u[j] = 0x7FC00000u;
    asm volatile("" : "+v"(aq[0]), "+v"(aq[1]), "+v"(aq[2]), "+v"(aq[3]));
    ik_store(sk, lds, tid);
    __syncthreads();
#pragma unroll
    for (int i = 0; i < 16; ++i) asm volatile("" : "+v"(wq[i]));
#pragma unroll
    for (int g = 0; g < 8; ++g) {
        if (g < ngroup) {
            if (g + 1 < ngroup) ik_load(sk, KI, g + 1, tid);
            LAS const unsigned char* kb = lds + (g & 1) * IK_BUF + c * IK_STR + hi * 16;
            h16x8 bk[4];
#pragma unroll
            for (int ks = 0; ks < 4; ++ks) bk[ks] = *(LAS const h16x8*)(kb + ks * 32);
#pragma unroll 2
            for (int jj = 0; jj < 8; ++jj) {
                const int j = 8 * g + jj, jn = jj < 7 ? jj + 1 : 7;
                h16x8 bn[4];
#pragma unroll
                for (int ks = 0; ks < 4; ++ks) bn[ks] = *(LAS const h16x8*)(kb + jn * (32 * IK_STR) + ks * 32);
                __builtin_amdgcn_sched_barrier(0);
                unsigned key = 0x7FC00000u;
                if (j < ntile) {
                    f32x16 acc = f32x16{};
#pragma unroll
                    for (int ks = 0; ks < 4; ++ks) acc = __builtin_amdgcn_mfma_f32_32x32x16_f16(aq[ks], bk[ks], acc, 0, 0, 0);
                    float sc = 0.f;
#pragma unroll
                    for (int r = 0; r < 16; ++r) { const int ib = __float_as_int(acc[r]); sc = __builtin_fmaf(wq[r], __int_as_float(ib > 0 ? ib : 0), sc); }
                    key = __float_as_uint(sc);
                }
                sb[jj * 64 + lane] = key;
#pragma unroll
                for (int ks = 0; ks < 4; ++ks) bk[ks] = bn[ks];
            }
            if (g == ((ntile - 1) >> 3)) { if (32 * (ntile - 1) + c > t) sb[((ntile - 1) & 7) * 64 + lane] = 0x7FC00000u; }
#pragma unroll
            for (int jj = 0; jj < 8; ++jj) u[8 * g + jj] = sb[jj * 64 + lane];
            if (g + 1 < ngroup) ik_store(sk, lds + ((g + 1) & 1) * IK_BUF, tid);
            asm volatile("s_waitcnt lgkmcnt(0)\n\ts_barrier" ::: "memory");
        }
    }
    if (has_next) idx_prefetch(pre_next, p, nb, nqt);
    unsigned T = 1u; bool exact = true;
    if (t0 >= TOPK) {
        float fmx = -__builtin_inff(), fmn = __builtin_inff();
#define IDX_MM(J0) _Pragma("unroll") for (int j = (J0); j < (J0) + 16; ++j) asm volatile("v_max_f32 %0, %0, %2\n\tv_min_f32 %1, %1, %2" : "+v"(fmx), "+v"(fmn) : "v"(u[j]));
        IDX_MM(0)
        if (ntile > 16) { IDX_MM(16) if (ntile > 32) { IDX_MM(32) if (ntile > 48) { IDX_MM(48) } } }
#undef IDX_MM
        unsigned kmax = fkey(fmx), kmin1 = fkey(fmn) - 1u;
        kmax = half_umax(kmax); kmin1 = ~half_umax(~kmin1);
        unsigned lo_k = kmin1 + 1u, hi_k = kmax + 1u;
        float lo_f = keyf(lo_k), hi_f = keyf(hi_k);
        float f_lo = (float)(t + 1) - ((float)TOPK - 0.5f), f_hi = -((float)TOPK - 0.5f);
        int side = 0; bool done = false; exact = false; T = lo_k;
        if (hi_k - lo_k <= 1u) done = true;
        for (int it = 0; it < 64; ++it) {
            unsigned mid_k;
            if (it < 24) { const float mid_f = hi_f - (hi_f - lo_f) * (f_hi / (f_hi - f_lo)); mid_k = fkey(mid_f); } else mid_k = lo_k + ((hi_k - lo_k) >> 1);
            mid_k = mid_k < lo_k + 1u ? lo_k + 1u : (mid_k > hi_k - 1u ? hi_k - 1u : mid_k);
            const float mid_c = keyf(mid_k);
            int c0 = 0, c1 = 0, c2 = 0, c3 = 0;
#define IDX_CNT(J0) _Pragma("unroll") for (int j = (J0); j < (J0) + 16; j += 4) { \
                asm volatile("v_cmp_ge_f32_e64 s[20:21], %4, %8\n\tv_cmp_ge_f32_e64 s[22:23], %5, %8\n\tv_cmp_ge_f32_e64 s[24:25], %6, %8\n\tv_cmp_ge_f32_e64 s[26:27], %7, %8\n\t" \
                             "v_addc_co_u32_e64 %0, s[28:29], 0, %0, s[20:21]\n\tv_addc_co_u32_e64 %1, s[28:29], 0, %1, s[22:23]\n\tv_addc_co_u32_e64 %2, s[28:29], 0, %2, s[24:25]\n\tv_addc_co_u32_e64 %3, s[28:29], 0, %3, s[26:27]" \
                             : "+v"(c0), "+v"(c1), "+v"(c2), "+v"(c3) : "v"(u[j]), "v"(u[j + 1]), "v"(u[j + 2]), "v"(u[j + 3]), "v"(mid_c) \
                             : "s20", "s21", "s22", "s23", "s24", "s25", "s26", "s27", "s28", "s29"); }
            IDX_CNT(0)
            if (ntile > 16) { IDX_CNT(16) if (ntile > 32) { IDX_CNT(32) if (ntile > 48) { IDX_CNT(48) } } }
#undef IDX_CNT
            const int cnt = half_sum((c0 + c1) + (c2 + c3));
            if (!done) {
                if (cnt == TOPK) { T = mid_k; exact = true; done = true; }
                else if (cnt > TOPK) { lo_k = mid_k; lo_f = keyf(mid_k); f_lo = (float)cnt - ((float)TOPK - 0.5f); if (side > 0) f_hi *= 0.5f; side = 1; }
                else { hi_k = mid_k; hi_f = keyf(mid_k); f_hi = (float)cnt - ((float)TOPK - 0.5f); if (side < 0) f_lo *= 0.5f; side = -1; }
                if (!done && hi_k - lo_k <= 1u) { T = lo_k; done = true; }
            }
            if (__all(done)) break;
        }
    }
    LAS unsigned long long* tb = (LAS unsigned long long*)(lds + IK_SB + 16384) + wv;
    const float Tf = (t0 >= TOPK) ? keyf(T) : -__builtin_inff();
    if (__all(exact)) {
        unsigned vlo = 0u, vhi = 0u;
#define IDX_OUT(J0) _Pragma("unroll") for (int j = (J0); j < (J0) + 16; j += 4) { \
            asm volatile("v_cmp_ge_f32_e64 s[20:21], %2, %6\n\tv_cmp_ge_f32_e64 s[22:23], %3, %6\n\tv_cmp_ge_f32_e64 s[24:25], %4, %6\n\tv_cmp_ge_f32_e64 s[26:27], %5, %6\n\t" \
                         "v_writelane_b32 %0, s20, %7\n\tv_writelane_b32 %1, s21, %7\n\tv_writelane_b32 %0, s22, %8\n\tv_writelane_b32 %1, s23, %8\n\t" \
                         "v_writelane_b32 %0, s24, %9\n\tv_writelane_b32 %1, s25, %9\n\tv_writelane_b32 %0, s26, %10\n\tv_writelane_b32 %1, s27, %10" \
                         : "+v"(vlo), "+v"(vhi) : "v"(u[j]), "v"(u[j + 1]), "v"(u[j + 2]), "v"(u[j + 3]), "v"(Tf), "n"(j), "n"(j + 1), "n"(j + 2), "n"(j + 3) \
                         : "s20", "s21", "s22", "s23", "s24", "s25", "s26", "s27"); }
        IDX_OUT(0)
        if (ntile > 16) { IDX_OUT(16) if (ntile > 32) { IDX_OUT(32) if (ntile > 48) { IDX_OUT(48) } } }
#undef IDX_OUT
        tb[lane * 8] = ((unsigned long long)vhi << 32) | vlo;
    } else {
        int ngt = 0;
#pragma unroll
        for (int j = 0; j < 64; ++j) ngt += (__uint_as_float(u[j]) > Tf) ? 1 : 0;
        ngt = half_sum(ngt);
        const int need = exact ? (1 << 30) : TOPK - ngt;
        int base = 0;
#pragma unroll
        for (int j = 0; j < 64; ++j) {
            const bool eq = (__uint_as_float(u[j]) == Tf);
            const unsigned long long be = __ballot(eq);
            const unsigned mh = hi ? (unsigned)(be >> 32) : (unsigned)be;
            const int rank = base + __popc(mh & ((1u << c) - 1u));
            const bool sel = (__uint_as_float(u[j]) > Tf) || (eq && rank < need);
            base += __popc(mh);
            const unsigned long long bal = __ballot(sel);
            if (lane == 0) tb[j * 8] = bal;
        }
    }
    __syncthreads();
    __hip_atomic_store((unsigned long long*)(Mg + (size_t)(tid >> 3) * SEQ + qt * 16 + 2 * (tid & 7)), ((LAS const unsigned long long*)(lds + IK_SB + 16384))[tid], __ATOMIC_RELAXED, __HIP_MEMORY_SCOPE_AGENT);
}
__device__ __forceinline__ void idx_deal(int u, int& b, int& qt) {
    b = u & 7; const int kk = (u >> 3) & 31, r = u >> 8; qt = r == 0 ? 127 - kk : (r == 1 ? 64 + kk : (r == 2 ? 63 - kk : kk));
}
__device__ __forceinline__ void phase_idx(const Params& p, LAS unsigned char* lds, int bid, int nblk) {
    IdxPre pa, pb;
    int u = bid; if (u >= 1024) return;
    int b, qt; idx_deal(u, b, qt);
    idx_prefetch(pa, p, b, qt);
    for (;;) {
        int un = u + nblk, nb = 0, nqt = 0; bool hn = un < 1024; if (hn) idx_deal(un, nb, nqt);
        idx_unit(p, lds, b, qt, pa, hn, nb, nqt, pb);
        if (!hn) break;
        u = un; b = nb; qt = nqt; un = u + nblk; hn = un < 1024; if (hn) idx_deal(un, nb, nqt);
        idx_unit(p, lds, b, qt, pb, hn, nb, nqt, pa);
        if (!hn) break;
        u = un; b = nb; qt = nqt;
    }
}
#include <cstdio>
__global__ void __launch_bounds__(NTHR, 2) k_fused(Params p) {
    extern __shared__ __attribute__((aligned(16))) unsigned char lds_raw[];
    LAS unsigned char* lds = (LAS unsigned char*)lds_raw;
    const int bid = blockIdx.x, nblk = gridDim.x;
    volatile LAS unsigned* st = (volatile LAS unsigned*)(lds + MISC_OFF);
    if (threadIdx.x < 64) st[threadIdx.x] = 0u;
    __syncthreads();
    Half H = half_init(lds);
    const XcdBarrier bar = xcd_barrier_post((unsigned*)(p.ws + WS_CTL), st);
    phase_prologue(p, lds, bid, nblk);
    xcd_barrier(bar);
    phase_gemm1(p, lds, bid, nblk);
    phase_kiwi(p, lds, bid, nblk);
    xcd_barrier(bar);
    phase_idx(p, lds, bid, nblk);
    flat_arrive(bar, 0);
    phase_sb2(p, H, bid, nblk);
    flat_wait(bar, 0);
    phase_sa(p, lds, bid, nblk);
    xcd_barrier(bar);
    phase_gemm2(p, lds, bid, nblk);
}

extern "C" void kernel_launch(void* const* d_in, const int* in_sizes, int n_in, void* d_out, int out_size, void* d_ws, size_t ws_size, hipStream_t stream) {
    static int grid_blocks = 0;
    if (!grid_blocks) {
        int dev = 0, cus = 0, per_cu = 0;
        (void)hipGetDevice(&dev);
        (void)hipDeviceGetAttribute(&cus, hipDeviceAttributeMultiprocessorCount, dev);
        (void)hipFuncSetAttribute((const void*)k_fused, hipFuncAttributeMaxDynamicSharedMemorySize, LDS_BYTES);
        (void)hipOccupancyMaxActiveBlocksPerMultiprocessor(&per_cu, (const void*)k_fused, NTHR, LDS_BYTES);
        if (per_cu < 1) per_cu = 1;
        if (per_cu > 1) per_cu = 1;
        grid_blocks = cus * per_cu;
    }
    (void)hipMemsetAsync((char*)d_ws + WS_CTL, 0, 16384, stream);
    Params p{};
    p.x = (const float*)d_in[0]; p.norm_gain = (const float*)d_in[1]; p.w_in = (const float*)d_in[2]; p.qg = (const float*)d_in[3]; p.kg = (const float*)d_in[4];
    p.rel_bias = (const float*)d_in[5]; p.w_out = (const float*)d_in[6]; p.out = (float*)d_out; p.ws = (unsigned char*)d_ws; p.use_cg = 0; p.pad = 0;
    void* args[] = {&p};
    hipError_t e = hipLaunchCooperativeKernel((const void*)k_fused, dim3(grid_blocks), dim3(NTHR), args, LDS_BYTES, stream);
    if (e != hipSuccess) fprintf(stderr, "cooperative launch failed: %s (grid %d)\n", hipGetErrorString(e), grid_blocks);
}
```

```cpp
#include <hip/hip_runtime.h>
#include <stdint.h>

typedef _Float16 h16;

constexpr int NB = 8, SEQ = 2048, DM = 1024, MTOK = NB * SEQ;
constexpr int NPROJ = 5200;
constexpr float LOG2E = 1.4426950408889634f;
constexpr float QSCALE = 0.125f * LOG2E;
constexpr float IDXS = 0.03125f;
constexpr float RMS_EPS = 1e-6f;
constexpr int TOPK = 256;
constexpr int C_QA = 0, C_KA = 512, C_VA = 1024, C_GA = 1536, C_QI = 2048, C_KI = 3072, C_WI = 3136, C_QB = 3152, C_KB = 3664, C_VB = 4176, C_GB = 4688;

constexpr size_t MiB = 1u << 20;
constexpr size_t WS_CTL = 0, WS_HN = 1 * MiB, WS_W1T = 33 * MiB, WS_W2T = 44 * MiB;
constexpr size_t WS_QA = 46 * MiB, WS_KA = 62 * MiB, WS_VA = 78 * MiB, WS_GA = 94 * MiB, WS_QI = 110 * MiB, WS_KI = 142 * MiB, WS_WI = 144 * MiB;
constexpr size_t WS_QB = 145 * MiB, WS_KB = 161 * MiB, WS_VB = 177 * MiB, WS_GB = 193 * MiB, WS_MASK = 209 * MiB, WS_MIX = WS_HN, WS_FREE = 213 * MiB;

__device__ const unsigned char T5_BUCKET[128] = {0, 1, 2, 3, 4, 5, 6, 7, 8, 9, 10, 11, 12, 13, 14, 15, 16, 16, 16, 17, 17, 18, 18, 18, 19, 19, 19, 20, 20, 20, 20, 21, 21, 21, 21, 22, 22, 22, 22, 22, 23, 23, 23, 23, 23, 23, 24, 24, 24, 24, 24, 24, 25, 25, 25, 25, 25, 25, 25, 26, 26, 26, 26, 26, 26, 26, 26, 27, 27, 27, 27, 27, 27, 27, 27, 27, 27, 28, 28, 28, 28, 28, 28, 28, 28, 28, 28, 29, 29, 29, 29, 29, 29, 29, 29, 29, 29, 29, 29, 30, 30, 30, 30, 30, 30, 30, 30, 30, 30, 30, 30, 30, 30, 31, 31, 31, 31, 31, 31, 31, 31, 31, 31, 31, 31, 31, 31, 31};

__device__ __forceinline__ float wave_sum(float v) {
#pragma unroll
    for (int o = 1; o < 64; o <<= 1) v += __shfl_xor(v, o);
    return v;
}
__device__ __forceinline__ unsigned fkey(float f) { const unsigned u = __float_as_uint(f); return (u & 0x80000000u) ? ~u : (u | 0x80000000u); }
#define LAS __attribute__((address_space(3)))
typedef _Float16 h16x8 __attribute__((ext_vector_type(8)));
typedef _Float16 h16x4 __attribute__((ext_vector_type(4)));
typedef _Float16 h16x2 __attribute__((ext_vector_type(2)));
typedef float f32x2 __attribute__((ext_vector_type(2)));
typedef float f32x4 __attribute__((ext_vector_type(4)));
typedef float f32x16 __attribute__((ext_vector_type(16)));
typedef unsigned u32x4 __attribute__((ext_vector_type(4)));
typedef unsigned u32x2 __attribute__((ext_vector_type(2)));
typedef short s16x4 __attribute__((ext_vector_type(4)));

constexpr int NTHR = 512, NWAVE = 8;
constexpr int N1PAD = 5120;
constexpr int W3ROW = 5120;
constexpr int LDS_BYTES = 147456;

struct Params {
    const float *x, *norm_gain, *w_in, *qg, *kg, *rel_bias, *w_out;
    float* out; unsigned char* ws; int use_cg, pad;
};

__device__ __forceinline__ int opaque_tid() { int t = threadIdx.x; asm volatile("" : "+v"(t)); return t; }
typedef __bf16 bf16x2_t __attribute__((ext_vector_type(2)));
__device__ __forceinline__ unsigned pk2b(float lo, float hi) { f32x2 v = {lo, hi}; bf16x2_t b = __builtin_convertvector(v, bf16x2_t); return __builtin_bit_cast(unsigned, b); }
__device__ __forceinline__ unsigned pk2h(float lo, float hi) { f32x2 v = {lo, hi}; h16x2 h = __builtin_convertvector(v, h16x2); return __builtin_bit_cast(unsigned, h); }

__host__ __device__ __forceinline__ int phys_of_logical(int lt) { const int wc = lt >> 6, bj = (lt >> 5) & 1, fq = (lt >> 3) & 3, n = (lt >> 2) & 1, reg = lt & 3; return 128 * bj + 32 * wc + 16 * n + 4 * fq + reg; }
__host__ __device__ __forceinline__ int phys_of_logical2(int lt) { const int wc = lt >> 6, bj = (lt >> 5) & 1, n = (lt >> 4) & 1, fq = (lt >> 2) & 3, reg = lt & 3; return 128 * bj + 32 * wc + 16 * n + 4 * fq + reg; }
__host__ __device__ __forceinline__ int w1_row_of_col(int c) {
    int pn, lt;
    if (c < 3072) { pn = c >> 8; lt = c & 255; } else if (c < 3152) { return W3ROW + (c - 3072); } else { const int cc = c - 3152; pn = 12 + (cc >> 8); lt = cc & 255; }
    return 256 * pn + phys_of_logical(lt);
}

namespace pg8 {
constexpr int BM = 256, BK = 64, HALF = 128, HTB = HALF * BK * 2, STAGE_BYTES = 8 * HTB, NXCD = 8, WGM = 8;
__host__ __device__ __forceinline__ int lds_byte(int r, int c) { const int st = (r >> 4) * 2 + (c >> 5), rr = r & 15, cc = c & 31, ob = rr * 64 + cc * 2; return st * 1024 + (ob ^ (((ob >> 9) & 1) << 5)); }
__host__ __device__ __forceinline__ void stage_rc(int b, int& R, int& C) { const int st = b / 1024, sb = b % 1024, swz = sb ^ (((sb >> 9) & 1) << 5); R = (st >> 1) * 16 + swz / 64; C = (st & 1) * 32 + (swz % 64) / 2; }
struct Unit { int pm, pn; };
struct Gemm { const h16* A; const h16* Bt; int M, N, K; };
struct StaticOrder {
    int nM, nN, nwg, G, c;
    __host__ __device__ __forceinline__ void init(int M, int N, int G_, int c_) { nM = M / BM; nN = N / BM; nwg = nM * nN; G = G_; c = c_; }
    __host__ __device__ __forceinline__ bool next(int i, Unit& u) const {
        const long L = (long)i * G + c; if (L >= nwg) return false;
        int wgid = (int)L; { const int q = nwg / NXCD, r = nwg % NXCD, xcd = wgid % NXCD, off = wgid / NXCD; wgid = (xcd < r ? xcd * (q + 1) : r * (q + 1) + (xcd - r) * q) + off; }
        const int nig = WGM * nN, gid = wgid / nig, fm = gid * WGM, gsz = (nM - fm) < WGM ? (nM - fm) : WGM;
        u.pm = fm + ((wgid % nig) % gsz); u.pn = (wgid % nig) / gsz; return true;
    }
};
template <class Epi, class Sched, bool ALIGN_EPI = false, bool SP2 = false>
__device__ __forceinline__ void gemm_phase(LAS unsigned char* lds, const Gemm g, const Sched& S, const Epi& E) {
    const int tid = opaque_tid(), wid = __builtin_amdgcn_readfirstlane(tid >> 6), lane = tid & 63, wr = wid >> 2, wc = wid & 3, fr = lane & 15, fq = lane >> 4;
    const int K = g.K, nt = K / BK;
    unsigned voffA[2], voffB[2];
#pragma unroll
    for (int i = 0; i < 2; ++i) { int R, C; stage_rc(tid * 16 + i * 8192, R, C); voffA[i] = (unsigned)(R * K + C) * 2u; voffB[i] = (unsigned)(R * K + C) * 2u; }
    const size_t kstep = (size_t)(BK * 2);
    const size_t hstep = (size_t)HALF * K * 2;
    const size_t tstep = 2 * hstep;
    const unsigned ldsw = (unsigned)wid * 1024u;
    const int aoff = lds_byte(wr * 64 + fr, fq * 8), boff = lds_byte(wc * 32 + fr, fq * 8);
#define PG8_SA(b, h) (((b) * 2 + (h)) * HTB)
#define PG8_SB(b, h) ((4 + (b) * 2 + (h)) * HTB)
#define PG8_STAGE(bufoff, gbase, voff) do { _Pragma("unroll") for (int _i = 0; _i < 2; ++_i) \
        __builtin_amdgcn_global_load_lds((const unsigned*)((const char*)(gbase) + (voff)[_i]), (LAS unsigned*)(lds + (bufoff) + ldsw + _i * 8192), 16, 0, 0); } while (0)
#define PG8_LDA(dst, b, h) do { _Pragma("unroll") for (int m = 0; m < 4; ++m) _Pragma("unroll") for (int k = 0; k < 2; ++k) dst[m][k] = *(const LAS h16x8*)(lds + PG8_SA(b, h) + aoff + m * 2048 + k * 1024); } while (0)
#define PG8_LDB(dst, b, h) do { _Pragma("unroll") for (int n = 0; n < 2; ++n) _Pragma("unroll") for (int k = 0; k < 2; ++k) dst[n][k] = *(const LAS h16x8*)(lds + PG8_SB(b, h) + boff + n * 2048 + k * 1024); } while (0)
#define PG8_MMA(ai, bj, At, Bt) do { __builtin_amdgcn_s_setprio(1); _Pragma("unroll") for (int m = 0; m < 4; ++m) _Pragma("unroll") for (int n = 0; n < 2; ++n) _Pragma("unroll") for (int k = 0; k < 2; ++k) \
        acc[ai][bj][m][n] = __builtin_amdgcn_mfma_f32_16x16x32_f16(Bt[n][k], At[m][k], acc[ai][bj][m][n], 0, 0, 0); __builtin_amdgcn_s_setprio(0); } while (0)
#define PG8_WAIT_V(n) asm volatile("s_waitcnt vmcnt(" #n ")" ::: "memory")
#define PG8_WAIT_L(n) asm volatile("s_waitcnt lgkmcnt(" #n ")" ::: "memory")
#define PG8_BAR __builtin_amdgcn_s_barrier()
#define PG8_SCHED __builtin_amdgcn_sched_barrier(0)
    Unit cur, nxt; int ui = 0;
    if (!S.next(0, cur)) return;
    f32x4 acc[2][2][4][2];
#pragma unroll
    for (int a = 0; a < 2; ++a)
#pragma unroll
        for (int b = 0; b < 2; ++b)
#pragma unroll
            for (int m = 0; m < 4; ++m)
#pragma unroll
                for (int n = 0; n < 2; ++n) acc[a][b][m][n] = (f32x4){0.f, 0.f, 0.f, 0.f};
    h16x8 At[4][2], B0[2][2], B1[2][2];
    const char* cA = (const char*)g.A + (size_t)cur.pm * tstep; const char* cB = (const char*)g.Bt + (size_t)cur.pn * tstep;
    if constexpr (SP2) {
        PG8_STAGE(PG8_SB(0, 0), cB, voffB); PG8_STAGE(PG8_SB(0, 1), cB + hstep, voffB); PG8_STAGE(PG8_SA(0, 0), cA, voffA); PG8_STAGE(PG8_SA(0, 1), cA + hstep, voffA);
        if (wr == 1) PG8_BAR;
        PG8_WAIT_V(2); PG8_BAR;
        PG8_STAGE(PG8_SB(1, 0), cB + kstep, voffB); PG8_STAGE(PG8_SA(1, 0), cA + kstep, voffA); PG8_STAGE(PG8_SB(1, 1), cB + hstep + kstep, voffB);
        PG8_WAIT_V(6); PG8_BAR;
    } else {
        PG8_STAGE(PG8_SB(0, 0), cB, voffB); PG8_STAGE(PG8_SA(0, 0), cA, voffA); PG8_STAGE(PG8_SB(0, 1), cB + hstep, voffB); PG8_STAGE(PG8_SA(0, 1), cA + hstep, voffA);
        if (wr == 1) PG8_BAR;
        PG8_WAIT_V(4); PG8_BAR;
        PG8_STAGE(PG8_SB(1, 0), cB + kstep, voffB); PG8_STAGE(PG8_SA(1, 0), cA + kstep, voffA); PG8_STAGE(PG8_SB(1, 1), cB + hstep + kstep, voffB);
        PG8_WAIT_V(6); PG8_BAR;
    }
    for (;;) {
        const bool has_next = S.next(ui + 1, nxt);
        const char* nA = has_next ? (const char*)g.A + (size_t)nxt.pm * tstep : cA; const char* nB = has_next ? (const char*)g.Bt + (size_t)nxt.pn * tstep : cB;
        for (int t = 0; t < nt; t += 2) {
            const bool last = (t == nt - 2);
            const char* a1 = cA + (size_t)(t + 1) * kstep;
            const char* a2 = last ? nA : cA + (size_t)(t + 2) * kstep; const char* b2 = last ? nB : cB + (size_t)(t + 2) * kstep;
            const char* a3 = a2 + kstep; const char* b3 = b2 + kstep;
            if constexpr (SP2) {
            PG8_LDB(B0, 0, 0); PG8_LDB(B1, 0, 1); PG8_SCHED; PG8_LDA(At, 0, 0); PG8_STAGE(PG8_SA(1, 1), a1 + hstep, voffA);
            PG8_WAIT_V(8); PG8_WAIT_L(0); PG8_BAR; PG8_MMA(0, 0, At, B0); PG8_MMA(0, 1, At, B1); PG8_BAR; PG8_SCHED;
            PG8_LDA(At, 0, 1); PG8_STAGE(PG8_SB(0, 0), b2, voffB); PG8_STAGE(PG8_SB(0, 1), b2 + hstep, voffB); PG8_STAGE(PG8_SA(0, 0), a2, voffA);
            PG8_WAIT_V(8); PG8_WAIT_L(0); PG8_BAR; PG8_MMA(1, 0, At, B0); PG8_MMA(1, 1, At, B1); PG8_BAR; PG8_SCHED;
            PG8_LDB(B0, 1, 0); PG8_LDB(B1, 1, 1); PG8_SCHED; PG8_LDA(At, 1, 0); PG8_STAGE(PG8_SA(0, 1), a2 + hstep, voffA);
            PG8_WAIT_V(8); PG8_WAIT_L(0); PG8_BAR; PG8_MMA(0, 0, At, B0); PG8_MMA(0, 1, At, B1); PG8_BAR; PG8_SCHED;
            PG8_LDA(At, 1, 1); PG8_STAGE(PG8_SB(1, 0), b3, voffB); PG8_STAGE(PG8_SB(1, 1), b3 + hstep, voffB); PG8_STAGE(PG8_SA(1, 0), a3, voffA);
            PG8_WAIT_V(8); PG8_WAIT_L(0); PG8_BAR; PG8_MMA(1, 0, At, B0); PG8_MMA(1, 1, At, B1); PG8_BAR; PG8_SCHED;
            } else {
            PG8_LDB(B0, 0, 0); PG8_SCHED; PG8_LDA(At, 0, 0); PG8_STAGE(PG8_SA(1, 1), a1 + hstep, voffA);
            PG8_WAIT_L(8); PG8_BAR; PG8_WAIT_L(0); PG8_MMA(0, 0, At, B0); PG8_BAR; PG8_SCHED;
            PG8_LDB(B1, 0, 1); PG8_STAGE(PG8_SB(0, 0), b2, voffB);
            PG8_BAR; PG8_WAIT_L(0); PG8_MMA(0, 1, At, B1); PG8_BAR;
            PG8_LDA(At, 0, 1); PG8_STAGE(PG8_SA(0, 0), a2, voffA);
            PG8_BAR; PG8_WAIT_L(0); PG8_MMA(1, 0, At, B0); PG8_BAR; PG8_SCHED;
            PG8_STAGE(PG8_SB(0, 1), b2 + hstep, voffB);
            PG8_WAIT_V(6); PG8_BAR; PG8_MMA(1, 1, At, B1); PG8_BAR;
            PG8_LDB(B0, 1, 0); PG8_SCHED; PG8_LDA(At, 1, 0); PG8_STAGE(PG8_SA(0, 1), a2 + hstep, voffA);
            PG8_WAIT_L(8); PG8_BAR; PG8_WAIT_L(0); PG8_MMA(0, 0, At, B0); PG8_BAR; PG8_SCHED;
            PG8_LDB(B1, 1, 1); PG8_STAGE(PG8_SB(1, 0), b3, voffB);
            PG8_BAR; PG8_WAIT_L(0); PG8_MMA(0, 1, At, B1); PG8_BAR;
            PG8_LDA(At, 1, 1); PG8_STAGE(PG8_SA(1, 0), a3, voffA);
            PG8_BAR; PG8_WAIT_L(0); PG8_MMA(1, 0, At, B0); PG8_BAR; PG8_SCHED;
            PG8_STAGE(PG8_SB(1, 1), b3 + hstep, voffB);
            PG8_WAIT_V(6); PG8_BAR; PG8_MMA(1, 1, At, B1); PG8_BAR;
            }
        }
        if constexpr (ALIGN_EPI) { if (wr == 0) PG8_BAR; }
        E(acc, cur, wr, wc, fr, fq);
        if (!has_next) break;
#pragma unroll
        for (int a = 0; a < 2; ++a)
#pragma unroll
            for (int b = 0; b < 2; ++b)
#pragma unroll
                for (int m = 0; m < 4; ++m)
#pragma unroll
                    for (int n = 0; n < 2; ++n) acc[a][b][m][n] = (f32x4){0.f, 0.f, 0.f, 0.f};
        cur = nxt; cA = nA; cB = nB; ++ui;
        if constexpr (ALIGN_EPI) { if (wr == 1) PG8_BAR; }
    }
    PG8_WAIT_V(0);
    if constexpr (!ALIGN_EPI) { if (wr == 0) PG8_BAR; }
    PG8_BAR;
#undef PG8_SA
#undef PG8_SB
#undef PG8_STAGE
#undef PG8_LDA
#undef PG8_LDB
#undef PG8_MMA
#undef PG8_WAIT_V
#undef PG8_WAIT_L
#undef PG8_BAR
#undef PG8_SCHED
}
}

struct EpiProj {
    unsigned char* ws; const float* qg; const float* kg;
    __device__ __forceinline__ void operator()(const f32x4 (&acc)[2][2][4][2], const pg8::Unit& u, int wr, int wc, int fr, int fq) const {
        const int pn = u.pn;
        int kind = 0; float scale = 1.f; const float* gain = nullptr; h16* dst; int ld = 512, tcol = 0;
        if (pn < 8) { const int t = pn >> 1; tcol = (pn & 1) * 256; dst = (h16*)(ws + WS_QA + (size_t)t * (16 * MiB));
            if (t == 0) { kind = 1; gain = qg; scale = QSCALE; } else if (t == 1) { kind = 1; gain = kg; } else if (t == 2) kind = 3; else kind = 2; }
        else if (pn < 12) { dst = (h16*)(ws + WS_QI); ld = 1024; tcol = (pn - 8) * 256; }
        else { const int t = (pn - 12) >> 1; tcol = (pn & 1) * 256; dst = (h16*)(ws + WS_QB + (size_t)t * (16 * MiB)); if (t == 0) scale = QSCALE; else if (t == 3) kind = 2; }
        const int col = tcol + 64 * wc + 8 * fq;
        float gv[16];
        if (kind == 1) {
#pragma unroll
            for (int i = 0; i < 16; ++i) gv[i] = gain[32 * (i >> 3) + 8 * fq + (i & 7)] * scale;
        }
#pragma unroll
        for (int ai = 0; ai < 2; ++ai)
#pragma unroll
            for (int m = 0; m < 4; ++m) {
                const int row = u.pm * 256 + ai * 128 + wr * 64 + m * 16 + fr;
                float v[16];
#pragma unroll
                for (int bj = 0; bj < 2; ++bj)
#pragma unroll
                    for (int n = 0; n < 2; ++n)
#pragma unroll
                        for (int r = 0; r < 4; ++r) v[8 * bj + 4 * n + r] = acc[ai][bj][m][n][r];
                if (kind == 1) {
                    float s = 0.f;
#pragma unroll
                    for (int i = 0; i < 16; ++i) s += v[i] * v[i];
                    s += __shfl_xor(s, 16); s += __shfl_xor(s, 32);
                    const float rs = rsqrtf(s * (1.f / 64.f) + RMS_EPS);
#pragma unroll
                    for (int i = 0; i < 16; ++i) v[i] = v[i] * rs * gv[i];
                } else if (kind == 2) {
#pragma unroll
                    for (int i = 0; i < 16; ++i) v[i] = v[i] * __builtin_amdgcn_rcpf(1.f + __builtin_amdgcn_exp2f(-v[i] * LOG2E));
                } else {
#pragma unroll
                    for (int i = 0; i < 16; ++i) v[i] *= scale;
                }
                h16* o = dst + (size_t)row * ld + col;
                u32x4 w0, w1;
                if (kind == 3) { w0.x = pk2b(v[0], v[1]); w0.y = pk2b(v[2], v[3]); w0.z = pk2b(v[4], v[5]); w0.w = pk2b(v[6], v[7]);
                                 w1.x = pk2b(v[8], v[9]); w1.y = pk2b(v[10], v[11]); w1.z = pk2b(v[12], v[13]); w1.w = pk2b(v[14], v[15]); }
                else { w0.x = pk2h(v[0], v[1]); w0.y = pk2h(v[2], v[3]); w0.z = pk2h(v[4], v[5]); w0.w = pk2h(v[6], v[7]);
                       w1.x = pk2h(v[8], v[9]); w1.y = pk2h(v[10], v[11]); w1.z = pk2h(v[12], v[13]); w1.w = pk2h(v[14], v[15]); }
                *(u32x4*)o = w0; *(u32x4*)(o + 32) = w1;
            }
    }
};
struct EpiOut {
    const float* x; float* out;
    __device__ __forceinline__ void operator()(const f32x4 (&acc)[2][2][4][2], const pg8::Unit& u, int wr, int wc, int fr, int fq) const {
        const int col = u.pn * 256 + 64 * wc + 4 * fq;
#pragma unroll
        for (int ai = 0; ai < 2; ++ai) {
            f32x4 xv[4][2][2];
#pragma unroll
            for (int m = 0; m < 4; ++m) { const size_t off = (size_t)(u.pm * 256 + ai * 128 + wr * 64 + m * 16 + fr) * DM + col;
#pragma unroll
                for (int bj = 0; bj < 2; ++bj)
#pragma unroll
                    for (int n = 0; n < 2; ++n) xv[m][bj][n] = *(const f32x4*)(x + off + 32 * bj + 16 * n); }
#pragma unroll
            for (int m = 0; m < 4; ++m) { const size_t off = (size_t)(u.pm * 256 + ai * 128 + wr * 64 + m * 16 + fr) * DM + col;
#pragma unroll
                for (int bj = 0; bj < 2; ++bj)
#pragma unroll
                    for (int n = 0; n < 2; ++n) *(f32x4*)(out + off + 32 * bj + 16 * n) = xv[m][bj][n] + acc[ai][bj][m][n]; }
        }
    }
};

template <class RowOf>
__device__ __forceinline__ void transpose_item(const float* W, int K, int N, h16* WT, LAS float* scr, int item, int lane, RowOf row_of) {
    const int nblk = (N + 31) / 32, kb = item / nblk, nb = item % nblk, k0 = 64 * kb, n0 = 32 * nb;
    const int nc = n0 + (lane & 31);
    float wv_[32];
#pragma unroll
    for (int i = 0; i < 32; ++i) { const int kk = 2 * i + (lane >> 5); wv_[i] = nc < N ? W[(size_t)(k0 + kk) * N + nc] : 0.f; }
#pragma unroll
    for (int i = 0; i < 32; ++i) { const int kk = 2 * i + (lane >> 5); scr[kk * 33 + (lane & 31)] = wv_[i]; }
    asm volatile("s_waitcnt lgkmcnt(0)" ::: "memory");
    const int c = lane & 7;
#pragma unroll
    for (int j = 0; j < 4; ++j) { const int n = (lane >> 3) + 8 * j; const LAS float* s = scr + (8 * c) * 33 + n;
        u32x4 o; o.x = pk2h(s[0 * 33], s[1 * 33]); o.y = pk2h(s[2 * 33], s[3 * 33]); o.z = pk2h(s[4 * 33], s[5 * 33]); o.w = pk2h(s[6 * 33], s[7 * 33]);
        if (n0 + n < N) *(u32x4*)(WT + (size_t)row_of(n0 + n) * K + k0 + 8 * c) = o; }
    asm volatile("s_waitcnt lgkmcnt(0)" ::: "memory");
}
__device__ __forceinline__ void rms_row(const float* __restrict__ xrow, const float* __restrict__ gain, h16* __restrict__ orow, int lane) {
    const f32x4* xr = (const f32x4*)xrow + lane;
    f32x4 v[4]; float s = 0.f;
#pragma unroll
    for (int j = 0; j < 4; ++j) { v[j] = xr[64 * j]; s += (v[j].x * v[j].x + v[j].y * v[j].y) + (v[j].z * v[j].z + v[j].w * v[j].w); }
    const float r = rsqrtf(wave_sum(s) * (1.f / DM) + RMS_EPS);
    u32x2* o8 = (u32x2*)orow + lane;
#pragma unroll
    for (int j = 0; j < 4; ++j) { const f32x4 g = ((const f32x4*)gain)[lane + 64 * j]; u32x2 w; w.x = pk2h(v[j].x * r * g.x, v[j].y * r * g.y); w.y = pk2h(v[j].z * r * g.z, v[j].w * r * g.w); o8[64 * j] = w; }
}
__device__ __forceinline__ void phase_prologue(const Params& p, LAS unsigned char* lds, int bid, int nblk) {
    const int tid = opaque_tid(), lane = tid & 63, wave = tid >> 6;
    LAS float* scr = (LAS float*)(lds + wave * 16384);
    const int gw = bid * NWAVE + wave, NGW = nblk * NWAVE;
    h16* W1T = (h16*)(p.ws + WS_W1T); h16* W2T = (h16*)(p.ws + WS_W2T); h16* HN = (h16*)(p.ws + WS_HN);
    constexpr int I1 = (DM / 64) * ((NPROJ + 31) / 32), I2 = (DM / 64) * (DM / 32);
    for (int it = gw; it < I1 + I2; it += NGW) {
        if (it < I1) transpose_item(p.w_in, DM, NPROJ, W1T, scr, it, lane, [](int c) { return w1_row_of_col(c); });
        else transpose_item(p.w_out, DM, DM, W2T, scr, it - I1, lane, [](int c) { return (c & ~255) + phys_of_logical2(c & 255); });
    }
    for (int m = gw; m < MTOK; m += 4 * NGW) {
        f32x4 v[4][4];
#pragma unroll
        for (int r = 0; r < 4; ++r)
#pragma unroll
            for (int j = 0; j < 4; ++j) v[r][j] = ((const f32x4*)(p.x + (size_t)(m + r * NGW) * DM))[lane + 64 * j];
#pragma unroll
        for (int r = 0; r < 4; ++r) {
            float ss = 0.f;
#pragma unroll
            for (int j = 0; j < 4; ++j) ss += (v[r][j].x * v[r][j].x + v[r][j].y * v[r][j].y) + (v[r][j].z * v[r][j].z + v[r][j].w * v[r][j].w);
            const float rs = rsqrtf(wave_sum(ss) * (1.f / DM) + RMS_EPS);
            u32x2* o8 = (u32x2*)(HN + (size_t)(m + r * NGW) * DM) + lane;
#pragma unroll
            for (int j = 0; j < 4; ++j) { const f32x4 g = ((const f32x4*)p.norm_gain)[lane + 64 * j]; u32x2 w; w.x = pk2h(v[r][j].x * rs * g.x, v[r][j].y * rs * g.y); w.y = pk2h(v[r][j].z * rs * g.z, v[r][j].w * rs * g.w); o8[64 * j] = w; }
        }
    }
}
__device__ __forceinline__ void phase_gemm1(const Params& p, LAS unsigned char* lds, int bid, int nblk) {
    pg8::Gemm g{(const h16*)(p.ws + WS_HN), (const h16*)(p.ws + WS_W1T), MTOK, N1PAD, DM};
    pg8::StaticOrder S; S.init(MTOK, N1PAD, nblk, bid);
    EpiProj E{p.ws, p.qg, p.kg};
    pg8::gemm_phase<EpiProj, pg8::StaticOrder, true, true>(lds, g, S, E);
}

constexpr int KW_STR = 528;
__device__ __forceinline__ void phase_kiwi(const Params& p, LAS unsigned char* lds, int bid, int nblk) {
    const int tid = opaque_tid(), lane = tid & 63, wv = __builtin_amdgcn_readfirstlane(tid >> 6), r32 = lane & 31, hh = lane >> 5;
    const h16* HN = (const h16*)(p.ws + WS_HN); const h16* W3 = (const h16*)(p.ws + WS_W1T) + (size_t)W3ROW * DM;
    const int rt = wv & 1, ct = wv >> 1;
    for (int blk = bid; blk < MTOK / 64; blk += nblk) {
        const int tok0 = blk * 64;
        f32x16 acc = f32x16{};
        u32x4 stg[10];
#define KW_LOAD(KC) _Pragma("unroll") for (int i = 0; i < 10; ++i) { const int idx = tid + 512 * i; const int row = idx >> 5, ch = idx & 31; \
                const h16* src = row < 64 ? HN + (size_t)(tok0 + row) * DM + (KC) * 256 + ch * 8 : W3 + (size_t)(row - 64) * DM + (KC) * 256 + ch * 8; stg[i] = *(const u32x4*)src; }
        KW_LOAD(0)
        for (int kc = 0; kc < 4; ++kc) {
            __syncthreads();
#pragma unroll
            for (int i = 0; i < 10; ++i) { const int idx = tid + 512 * i; *(LAS u32x4*)(lds + (idx >> 5) * KW_STR + (idx & 31) * 16) = stg[i]; }
            if (kc < 3) { KW_LOAD(kc + 1) }
            asm volatile("s_waitcnt lgkmcnt(0)\n\ts_barrier" ::: "memory");
            if (ct < 3) {
                LAS const unsigned char* ap = lds + (64 + ct * 32 + r32) * KW_STR + hh * 16;
                LAS const unsigned char* bp = lds + (rt * 32 + r32) * KW_STR + hh * 16;
#pragma unroll
                for (int ks = 0; ks < 16; ++ks) acc = __builtin_amdgcn_mfma_f32_32x32x16_f16(*(LAS const h16x8*)(ap + ks * 32), *(LAS const h16x8*)(bp + ks * 32), acc, 0, 0, 0);
            }
        }
#undef KW_LOAD
        const size_t tok = (size_t)(tok0 + rt * 32 + r32);
        if (ct < 2) {
            h16* o = (h16*)(p.ws + WS_KI) + tok * 64 + ct * 32 + 4 * hh;
#pragma unroll
            for (int g = 0; g < 4; ++g) { u32x2 w; w.x = pk2h(acc[4 * g], acc[4 * g + 1]); w.y = pk2h(acc[4 * g + 2], acc[4 * g + 3]); *(u32x2*)(o + 8 * g) = w; }
        } else if (ct == 2) {
            float* o = (float*)(p.ws + WS_WI) + tok * 16 + 4 * hh;
#pragma unroll
            for (int g = 0; g < 2; ++g) *(f32x4*)(o + 8 * g) = (f32x4){acc[4 * g] * IDXS, acc[4 * g + 1] * IDXS, acc[4 * g + 2] * IDXS, acc[4 * g + 3] * IDXS};
        }
    }
}
__device__ __forceinline__ void phase_gemm2(const Params& p, LAS unsigned char* lds, int bid, int nblk) {
    pg8::Gemm g{(const h16*)(p.ws + WS_MIX), (const h16*)(p.ws + WS_W2T), MTOK, DM, DM};
    pg8::StaticOrder S; S.init(MTOK, DM, nblk, bid);
    EpiOut E{p.x, p.out};
    pg8::gemm_phase<EpiOut, pg8::StaticOrder, true, true>(lds, g, S, E);
}
#define XB_TMO      128
#define XB_XCNT(j)  (256  + 64 * (j))
#define XB_XSUB(j)  (1280 + 64 * (j))
#define XB_XGEN(j)  (2304 + 64 * (j))
#define XB_TOP      3328
#define XB_TOPGEN   3392
#define XCD_BAR_WORDS 3456
#define XB_SPIN_CAP (1u << 22)
__device__ __forceinline__ unsigned xb_ld(unsigned* p)              { return __hip_atomic_load(p, __ATOMIC_RELAXED, __HIP_MEMORY_SCOPE_AGENT); }
__device__ __forceinline__ unsigned xb_add(unsigned* p, unsigned v) { return __hip_atomic_fetch_add(p, v, __ATOMIC_RELAXED, __HIP_MEMORY_SCOPE_AGENT); }
__device__ __forceinline__ unsigned xb_xcc_id() { return (unsigned)__builtin_amdgcn_s_getreg((3 << 11) | 20) & 0xFu; }
#define XB_SPIN(cond, bar) do { unsigned _sp = 0; while (cond) { __builtin_amdgcn_s_sleep(1); \
    if ((++_sp & 255u) == 0u) { if (xb_ld(&(bar)[XB_TMO])) break; if (_sp > XB_SPIN_CAP) { atomicAdd(&(bar)[XB_TMO], 1u); break; } } } } while (0)
struct XcdBarrier { unsigned* bar; unsigned x; volatile LAS unsigned* st; };
__device__ __forceinline__ XcdBarrier xcd_barrier_post(unsigned* bar, volatile LAS unsigned* st) {
    XcdBarrier b; b.bar = bar; b.x = xb_xcc_id(); b.st = st;
    if (threadIdx.x == 0) (void)xb_add(&bar[XB_XCNT(b.x)], 1u);
    return b;
}
__device__ __forceinline__ void xcd_barrier_complete(unsigned* bar, unsigned x, unsigned& nloc, unsigned& nx) {
    const unsigned G = gridDim.x * gridDim.y * gridDim.z;
    unsigned sum, cnt, mine, sp = 0u;
    for (;;) {
        sum = 0u; cnt = 0u; mine = 0u;
#pragma unroll
        for (unsigned j = 0; j < 16; ++j) { const unsigned c = xb_ld(&bar[XB_XCNT(j)]); sum += c; cnt += (c > 0u) ? 1u : 0u; mine = (j == x) ? c : mine; }
        if (sum == G) break;
        __builtin_amdgcn_s_sleep(1);
        if ((++sp & 255u) == 0u) { if (xb_ld(&bar[XB_TMO])) break; if (sp > XB_SPIN_CAP) { atomicAdd(&bar[XB_TMO], 1u); break; } }
    }
    nloc = mine > 0u ? mine : 1u; nx = cnt > 0u ? cnt : 1u;
}
__device__ __forceinline__ void xcd_barrier(const XcdBarrier& b) {
    asm volatile("s_waitcnt vmcnt(0)" ::: "memory");
    __syncthreads();
    if (threadIdx.x == 0) {
        unsigned* bar = b.bar;
        __builtin_amdgcn_s_waitcnt(0);
        unsigned nloc = b.st[0], nx = b.st[1];
        if (nloc == 0u) { xcd_barrier_complete(bar, b.x, nloc, nx); b.st[0] = nloc; b.st[1] = nx; }
        const unsigned old = xb_add(&bar[XB_XSUB(b.x)], 1u);
        const unsigned gen = old / nloc;
        if (old + 1u == (gen + 1u) * nloc) {
            __builtin_amdgcn_fence(__ATOMIC_RELEASE, "agent");
            asm volatile("s_waitcnt vmcnt(0)" ::: "memory");
            const unsigned og = xb_add(&bar[XB_TOP], 1u);
            const unsigned tg = og / nx;
            if (og + 1u == (tg + 1u) * nx) xb_add(&bar[XB_TOPGEN], 1u);
            else XB_SPIN(xb_ld(&bar[XB_TOPGEN]) == tg, bar);
            xb_add(&bar[XB_XGEN(b.x)], 1u);
            __builtin_amdgcn_fence(__ATOMIC_ACQUIRE, "agent");
            asm volatile("s_waitcnt vmcnt(0)" ::: "memory");
        } else {
            XB_SPIN(xb_ld(&bar[XB_XGEN(b.x)]) == gen, bar);
            __builtin_amdgcn_fence(__ATOMIC_ACQUIRE, "agent");
            asm volatile("s_waitcnt vmcnt(0)" ::: "memory");
        }
    }
    __syncthreads();
}
#define XB_FLAT(k)  (3520 + 64 * (k))
__device__ __forceinline__ void flat_arrive(const XcdBarrier& b, int k) {
    asm volatile("s_waitcnt vmcnt(0)" ::: "memory");
    __syncthreads();
    if (threadIdx.x == 0) (void)xb_add(&b.bar[XB_FLAT(k)], 1u);
}
__device__ __forceinline__ void flat_wait(const XcdBarrier& b, int k) {
    if (threadIdx.x == 0) { const unsigned G = gridDim.x * gridDim.y * gridDim.z; XB_SPIN(xb_ld(&b.bar[XB_FLAT(k)]) < G, b.bar); }
    __syncthreads();
}
__device__ __forceinline__ int crow(int r, int hi) { return (r & 3) + 8 * (r >> 2) + 4 * hi; }
constexpr int KSTR = 144, VSTR = 192;
constexpr int KT_BYTES = 64 * KSTR, VT_BYTES = 64 * VSTR;
constexpr int MT_BYTES = 2048;
constexpr int ATT_BUF = KT_BYTES + VT_BYTES + MT_BYTES;
constexpr int ATT_TAB = 2 * ATT_BUF;
constexpr int OSTR = 144, ATT_OST = ATT_TAB + 2304;
constexpr float SB_EXIT = 64.f;
__device__ __forceinline__ s16x4 vtr(LAS const unsigned char* p) { return __builtin_amdgcn_ds_read_tr16_b64_v4i16((LAS s16x4*)p); }
__device__ __forceinline__ h16x8 mk8(s16x4 a, s16x4 b) { typedef short s16x8 __attribute__((ext_vector_type(8))); s16x8 r = {a[0], a[1], a[2], a[3], b[0], b[1], b[2], b[3]}; return __builtin_bit_cast(h16x8, r); }
__device__ __forceinline__ h16x8 pack8(float a0, float a1, float a2, float a3, float a4, float a5, float a6, float a7) {
    u32x4 w; w.x = pk2h(a0, a1); w.y = pk2h(a2, a3); w.z = pk2h(a4, a5); w.w = pk2h(a6, a7); return __builtin_bit_cast(h16x8, w); }
__device__ __forceinline__ float bcast_lo(float v) { const unsigned u = __float_as_uint(v); auto rr = __builtin_amdgcn_permlane32_swap(u, u, false, false); return __uint_as_float(rr[0]); }
__device__ __forceinline__ f32x16 splat16(float v) { f32x16 r;
#pragma unroll
    for (int i = 0; i < 16; ++i) r[i] = v;
    return r; }

struct KVStage { u32x4 k, v; unsigned m; };
template <bool MASK>
__device__ __forceinline__ void kv_load(KVStage& st, const h16* Kg, const h16* Vg, const unsigned* Mg, int tile, int tid) {
    const size_t off = (size_t)(tile * 64 + (tid >> 3)) * 512 + (tid & 7) * 8;
    const h16* kp = Kg + off; const h16* vp = Vg + off;
    asm volatile("global_load_dwordx4 %0, %1, off" : "=v"(st.k) : "v"(kp) : "memory");
    asm volatile("global_load_dwordx4 %0, %1, off" : "=v"(st.v) : "v"(vp) : "memory");
    if (MASK) { const unsigned* mp = Mg + (size_t)(2 * tile + (tid >> 8)) * SEQ + (tid & 255); asm volatile("global_load_dword %0, %1, off" : "=v"(st.m) : "v"(mp) : "memory"); }
}
template <int N>
__device__ __forceinline__ void kv_wait(KVStage& st) {
    asm volatile("s_waitcnt vmcnt(%0)" :: "n"(N) : "memory");
    asm volatile("" : "+v"(st.k), "+v"(st.v), "+v"(st.m));
}
template <bool MASK>
__device__ __forceinline__ void kv_store(const KVStage& st, LAS unsigned char* buf, int tid) {
    *(LAS u32x4*)(buf + (tid >> 3) * KSTR + (tid & 7) * 16) = st.k;
    *(LAS u32x4*)(buf + KT_BYTES + (tid >> 3) * VSTR + (tid & 7) * 16) = st.v;
    if (MASK) *(LAS unsigned*)(buf + KT_BYTES + VT_BYTES + tid * 4) = st.m;
}
__device__ __forceinline__ f32x16 qk_tile(LAS const unsigned char* kb, int sub, const h16x8 (&qf)[4], int r32, int hh, f32x16 cinit = f32x16{}) {
    LAS const unsigned char* kp = kb + (sub * 32 + r32) * KSTR + hh * 16;
    f32x16 acc = cinit;
#pragma unroll
    for (int ks = 0; ks < 4; ++ks) { const h16x8 kf = *(LAS const h16x8*)(kp + ks * 32); acc = __builtin_amdgcn_mfma_f32_32x32x16_f16(kf, qf[ks], acc, 0, 0, 0); }
    return acc;
}
__device__ __forceinline__ void pv_tile(f32x16 (&o)[2], LAS const unsigned char* vb, int sub, const h16x8 (&pa)[2], int lane) {
    const int g = lane >> 4, i = lane & 15, q = i >> 2, pp = i & 3;
    LAS const unsigned char* vp = vb + (sub * 32 + 4 * (g >> 1) + q) * VSTR + (16 * (g & 1) + 4 * pp) * 2;
#pragma unroll
    for (int db = 0; db < 2; ++db)
#pragma unroll
        for (int s2 = 0; s2 < 2; ++s2) {
            const s16x4 lo = vtr(vp + (16 * s2) * VSTR + db * 64), hi = vtr(vp + (16 * s2 + 8) * VSTR + db * 64);
            o[db] = __builtin_amdgcn_mfma_f32_32x32x16_f16(pa[s2], mk8(lo, hi), o[db], 0, 0, 0);
        }
}
__device__ __forceinline__ void att_store(const f32x16 (&o)[2], LAS unsigned char* ost, const LAS float* rs, const h16* Gg, h16* Og, int qw, int lane) {
    const int r32 = lane & 31, hh = lane >> 5;
#pragma unroll
    for (int db = 0; db < 2; ++db)
#pragma unroll
        for (int r = 0; r < 16; ++r) *(LAS h16*)(ost + crow(r, hh) * OSTR + (32 * db + r32) * 2) = (h16)o[db][r];
    asm volatile("s_waitcnt lgkmcnt(0)" ::: "memory");
    const int ch = lane & 7;
#pragma unroll
    for (int i = 0; i < 4; ++i) {
        const int row = 8 * i + (lane >> 3);
        const float sc = rs ? 1.f / rs[row] : 1.f;
        const size_t tok = (size_t)(qw + row);
        const h16x8 ov = *(const LAS h16x8*)(ost + row * OSTR + ch * 16);
        const h16x8 gv = *(const h16x8*)(Gg + tok * 512 + ch * 8);
        u32x4 w;
        w.x = pk2h((float)ov[0] * sc * (float)gv[0], (float)ov[1] * sc * (float)gv[1]); w.y = pk2h((float)ov[2] * sc * (float)gv[2], (float)ov[3] * sc * (float)gv[3]);
        w.z = pk2h((float)ov[4] * sc * (float)gv[4], (float)ov[5] * sc * (float)gv[5]); w.w = pk2h((float)ov[6] * sc * (float)gv[6], (float)ov[7] * sc * (float)gv[7]);
        *(u32x4*)(Og + tok * 1024 + ch * 8) = w;
    }
}
__device__ __forceinline__ void k_frags(h16x8 (&kf)[4], LAS const unsigned char* kb, int sub, int r32, int hh) {
    LAS const unsigned char* kp = kb + (sub * 32 + r32) * KSTR + hh * 16;
#pragma unroll
    for (int ks = 0; ks < 4; ++ks) kf[ks] = *(LAS const h16x8*)(kp + ks * 32);
}
__device__ __forceinline__ void v_frags(h16x8 (&vf)[2][2], LAS const unsigned char* vb, int sub, int lane) {
    const int g = lane >> 4, i = lane & 15, q = i >> 2, pp = i & 3;
    LAS const unsigned char* vp = vb + (sub * 32 + 4 * (g >> 1) + q) * VSTR + (16 * (g & 1) + 4 * pp) * 2;
#pragma unroll
    for (int db = 0; db < 2; ++db)
#pragma unroll
        for (int s2 = 0; s2 < 2; ++s2) vf[db][s2] = mk8(vtr(vp + (16 * s2) * VSTR + db * 64), vtr(vp + (16 * s2 + 8) * VSTR + db * 64));
}
__device__ __forceinline__ f32x16 qk_mma(const h16x8 (&kf)[4], const h16x8 (&qf)[4], f32x16 acc) {
#pragma unroll
    for (int ks = 0; ks < 4; ++ks) acc = __builtin_amdgcn_mfma_f32_32x32x16_f16(kf[ks], qf[ks], acc, 0, 0, 0);
    return acc;
}
__device__ __forceinline__ void pv_mma(f32x16 (&o)[2], const h16x8 (&vf)[2][2], const h16x8 (&pa)[2]) {
#pragma unroll
    for (int db = 0; db < 2; ++db)
#pragma unroll
        for (int s2 = 0; s2 < 2; ++s2) o[db] = __builtin_amdgcn_mfma_f32_32x32x16_f16(pa[s2], vf[db][s2], o[db], 0, 0, 0);
}

typedef short b16x8 __attribute__((ext_vector_type(8)));
__device__ __forceinline__ b16x8 pack8b(float a0, float a1, float a2, float a3, float a4, float a5, float a6, float a7) {
    u32x4 w; w.x = pk2b(a0, a1); w.y = pk2b(a2, a3); w.z = pk2b(a4, a5); w.w = pk2b(a6, a7); return __builtin_bit_cast(b16x8, w); }
__device__ __forceinline__ void pv_mma_b(f32x16 (&o)[2], const h16x8 (&vf)[2][2], const b16x8 (&pa)[2]) {
#pragma unroll
    for (int db = 0; db < 2; ++db)
#pragma unroll
        for (int s2 = 0; s2 < 2; ++s2) o[db] = __builtin_amdgcn_mfma_f32_32x32x16_bf16(pa[s2], __builtin_bit_cast(b16x8, vf[db][s2]), o[db], 0, 0, 0);
}
#define SCHED_FENCE() __builtin_amdgcn_sched_barrier(0)
#define LDS_BARRIER() asm volatile("s_waitcnt lgkmcnt(0)\n\ts_barrier" ::: "memory")
__device__ __forceinline__ void att_unit(int u, int& b, int& h, int& qb) { const int pass = u >> 8, x = u & 7, m = (u >> 3) & 31; h = x; b = 4 * pass + (m & 3); qb = pass ? (m >> 2) : 7 - (m >> 2); }


constexpr int HALF_LDS = 65536;
constexpr int MISC_OFF = 131072;
struct Half { int hf, ht, hw, lane; LAS unsigned char* lds; LAS unsigned* bar; unsigned tgt; };
__device__ __forceinline__ Half half_init(LAS unsigned char* lds_all) {
    const int tid = opaque_tid(); Half H;
    H.hf = __builtin_amdgcn_readfirstlane(tid >> 8); H.ht = tid & 255; H.hw = __builtin_amdgcn_readfirstlane((tid >> 6) & 3); H.lane = tid & 63;
    H.lds = lds_all + H.hf * HALF_LDS; H.bar = (LAS unsigned*)(lds_all + MISC_OFF + 64 + 64 * H.hf); H.tgt = 0u;
    return H;
}
__device__ __forceinline__ void half_barrier(Half& H) {
    asm volatile("s_waitcnt lgkmcnt(0)" ::: "memory");
    H.tgt += 4u;
    if (H.lane == 0) (void)__hip_atomic_fetch_add(H.bar, 1u, __ATOMIC_RELAXED, __HIP_MEMORY_SCOPE_WORKGROUP);
    while (__hip_atomic_load(H.bar, __ATOMIC_RELAXED, __HIP_MEMORY_SCOPE_WORKGROUP) < H.tgt) __builtin_amdgcn_s_sleep(1);
    asm volatile("" ::: "memory");
}
constexpr int H_MT = 1024;
constexpr int H_BUF = KT_BYTES + VT_BYTES + H_MT;
constexpr int H_MISC = 2 * H_BUF;
constexpr int H_OST = H_MISC + 2048;
struct KV2 { u32x4 k[2], v[2]; unsigned m; };
template <bool MASK>
__device__ __forceinline__ void kv2_load(KV2& st, const h16* Kg, const h16* Vg, const unsigned* Mq, int tile, int ht) {
#pragma unroll
    for (int i = 0; i < 2; ++i) { const int idx = ht + 256 * i; const size_t off = (size_t)(tile * 64 + (idx >> 3)) * 512 + (idx & 7) * 8; st.k[i] = *(const u32x4*)(Kg + off); st.v[i] = *(const u32x4*)(Vg + off); }
    if (MASK) st.m = Mq[(size_t)(2 * tile + (ht >> 7)) * SEQ + (ht & 127)];
}
template <bool MASK>
__device__ __forceinline__ void kv2_store(const KV2& st, LAS unsigned char* buf, int ht) {
#pragma unroll
    for (int i = 0; i < 2; ++i) { const int idx = ht + 256 * i; *(LAS u32x4*)(buf + (idx >> 3) * KSTR + (idx & 7) * 16) = st.k[i]; *(LAS u32x4*)(buf + KT_BYTES + (idx >> 3) * VSTR + (idx & 7) * 16) = st.v[i]; }
    if (MASK) *(LAS unsigned*)(buf + KT_BYTES + VT_BYTES + ht * 4) = st.m;
}
__device__ __forceinline__ void att2_unit(int u, int& b, int& h, int& q16) {
    const int pass = u >> 9, v = u & 511, hf = v & 1, blk = v >> 1, x = blk & 7, e = 2 * (blk >> 3) + hf;
    h = x; b = 4 * pass + (e & 3); q16 = pass ? (e >> 2) : 15 - (e >> 2);
}
__device__ __forceinline__ void sb_softplus(const f32x16& z, h16x8 (&lf)[2], bool dg, int r32, int hh) {
    float L[16];
#pragma unroll
    for (int r = 0; r < 16; ++r) { float l = __builtin_amdgcn_logf(1.f + __builtin_amdgcn_exp2f(z[r])); if (dg && crow(r, hh) >= r32) l = 0.f; L[r] = l; }
    lf[0] = pack8(L[0], L[1], L[2], L[3], L[4], L[5], L[6], L[7]); lf[1] = pack8(L[8], L[9], L[10], L[11], L[12], L[13], L[14], L[15]);
}
__device__ __forceinline__ void sb_weights(const f32x16& z, const f32x16& y, h16x8 (&pa)[2], bool dg, int r32, int hh) {
    float A[16];
#pragma unroll
    for (int r = 0; r < 16; ++r) { float a = __builtin_amdgcn_exp2f(z[r] - y[r]); if (dg && crow(r, hh) >= r32) a = 0.f; A[r] = a; }
    pa[0] = pack8(A[0], A[1], A[2], A[3], A[4], A[5], A[6], A[7]); pa[1] = pack8(A[8], A[9], A[10], A[11], A[12], A[13], A[14], A[15]);
}
__device__ __forceinline__ f32x16 sb_cum(const h16x8 (&tri)[2], const h16x8 (&lf)[2], float carry) {
    f32x16 y = splat16(carry);
    y = __builtin_amdgcn_mfma_f32_32x32x16_f16(tri[0], lf[0], y, 0, 0, 0);
    y = __builtin_amdgcn_mfma_f32_32x32x16_f16(tri[1], lf[1], y, 0, 0, 0);
    return y;
}

__device__ __forceinline__ void sb2_unit(const Params& p, Half& H, int b, int h, int q16) {
    const int lane = H.lane, hw = H.hw, ht = H.ht, r32 = lane & 31, hh = lane >> 5;
    LAS unsigned char* lds = H.lds;
    const h16* Qg = (const h16*)(p.ws + WS_QB) + (size_t)b * SEQ * 512 + h * 64;
    const h16* Kg = (const h16*)(p.ws + WS_KB) + (size_t)b * SEQ * 512 + h * 64;
    const h16* Vg = (const h16*)(p.ws + WS_VB) + (size_t)b * SEQ * 512 + h * 64;
    const h16* Gg = (const h16*)(p.ws + WS_GB) + (size_t)b * SEQ * 512 + h * 64;
    h16* Og = (h16*)(p.ws + WS_MIX) + (size_t)b * SEQ * 1024 + 512 + h * 64;
    const int q0 = q16 * 128, qw = q0 + hw * 32;
    const int jmax = 2 * q16 + 1, diag = qw >> 5;
    KV2 st; kv2_load<false>(st, Kg, Vg, nullptr, jmax, ht);
    h16x8 qf[4];
#pragma unroll
    for (int ks = 0; ks < 4; ++ks) qf[ks] = *(const h16x8*)(Qg + (size_t)(qw + r32) * 512 + ks * 16 + hh * 8);
    h16x8 tri[2];
#pragma unroll
    for (int s2 = 0; s2 < 2; ++s2)
#pragma unroll
        for (int jj = 0; jj < 8; ++jj) { const int j = 16 * s2 + 8 * (jj >> 2) + 4 * hh + (jj & 3); tri[s2][jj] = (j >= r32) ? (h16)1.0f : (h16)0.0f; }
    f32x16 o[2]; o[0] = f32x16{}; o[1] = f32x16{};
    LAS unsigned* flg = (LAS unsigned*)(lds + H_MISC + 1536);
    float carry = 0.f;
    asm volatile("" : "+v"(qf[0]), "+v"(qf[1]), "+v"(qf[2]), "+v"(qf[3]));
    int cur = 0;
    kv2_store<false>(st, lds, ht);
    half_barrier(H);
    const int jd = diag >> 1;
    int j = jmax; bool fin = false;
#define SB_STAGE_IN()  if (j > 0) kv2_load<false>(st, Kg, Vg, nullptr, j - 1, ht); \
        LAS const unsigned char* kb = lds + cur * H_BUF; LAS const unsigned char* vb = kb + KT_BYTES;
#define SB_STAGE_OUT() if (j > 0) kv2_store<false>(st, lds + (cur ^ 1) * H_BUF, ht); \
        if (lane == 0) flg[(j & 1) * 4 + hw] = (2 * j <= diag && __all(carry > SB_EXIT)) ? 1u : 0u; \
        half_barrier(H); \
        cur ^= 1; \
        { const unsigned f = flg[(j & 1) * 4 + (lane & 3)]; if (__all(f != 0u)) fin = true; }
    for (; j > jd && !fin; --j) { SB_STAGE_IN() (void)kb; (void)vb; SB_STAGE_OUT() }
    if (!fin && j == jd) {
        SB_STAGE_IN()
#pragma unroll
        for (int sub = 1; sub >= 0; --sub) {
            const int si = 2 * j + sub;
            if (si <= diag) {
                const bool dg = (si == diag);
                const f32x16 z = qk_tile(kb, sub, qf, r32, hh);
                h16x8 lf[2], pa[2];
                sb_softplus(z, lf, dg, r32, hh);
                const f32x16 y = sb_cum(tri, lf, carry);
                sb_weights(z, y, pa, dg, r32, hh);
                carry = bcast_lo(y[0]);
                pv_tile(o, vb, sub, pa, lane);
            }
        }
        SB_STAGE_OUT()
        --j;
    }
    for (; j >= 0 && !fin; --j) {
        SB_STAGE_IN()
        const f32x16 z1 = qk_tile(kb, 1, qf, r32, hh);
        const f32x16 z0 = qk_tile(kb, 0, qf, r32, hh);
        h16x8 lf1[2], lf0[2], pa1[2], pa0[2];
        sb_softplus(z1, lf1, false, r32, hh);
        const f32x16 y1 = sb_cum(tri, lf1, carry);
        sb_softplus(z0, lf0, false, r32, hh);
        const float c1 = bcast_lo(y1[0]);
        const f32x16 y0 = sb_cum(tri, lf0, c1);
        sb_weights(z1, y1, pa1, false, r32, hh);
        pv_tile(o, vb, 1, pa1, lane);
        sb_weights(z0, y0, pa0, false, r32, hh);
        pv_tile(o, vb, 0, pa0, lane);
        carry = bcast_lo(y0[0]);
        SB_STAGE_OUT()
    }
#undef SB_STAGE_IN
#undef SB_STAGE_OUT
    att_store(o, lds + H_OST + hw * (32 * OSTR), nullptr, Gg, Og, qw, lane);
}
__device__ __forceinline__ void phase_sb2(const Params& p, Half& H, int bid, int nblk) {
    for (int u = 2 * bid + H.hf; u < 1024; u += 2 * nblk) { int b, h, q16; att2_unit(u, b, h, q16); sb2_unit(p, H, b, h, q16); }
}
__device__ __forceinline__ void sa_probs(const f32x16& s, unsigned mw, const LAS float* btab, bool nearby, b16x8 (&pa)[2], f32x16& osum, const b16x8& ones, int hh) {
    float P[16];
    if (nearby) {
#pragma unroll
        for (int r = 0; r < 16; ++r) P[r] = __builtin_amdgcn_exp2f(s[r] + btab[27 - ((r & 3) + 8 * (r >> 2))]);
    } else {
#pragma unroll
        for (int r = 0; r < 16; ++r) P[r] = __builtin_amdgcn_exp2f(s[r]);
    }
#pragma unroll
    for (int r = 0; r < 16; ++r) { const int bit = (r & 3) + 8 * (r >> 2); unsigned m_; asm("v_bfe_i32 %0, %1, %2, 1" : "=v"(m_) : "v"(mw), "n"(bit)); P[r] = __uint_as_float(__float_as_uint(P[r]) & m_); }
    pa[0] = pack8b(P[0], P[1], P[2], P[3], P[4], P[5], P[6], P[7]); pa[1] = pack8b(P[8], P[9], P[10], P[11], P[12], P[13], P[14], P[15]);
    osum = __builtin_amdgcn_mfma_f32_32x32x16_bf16(pa[0], ones, osum, 0, 0, 0);
    osum = __builtin_amdgcn_mfma_f32_32x32x16_bf16(pa[1], ones, osum, 0, 0, 0);
}
constexpr int A_KT = 128 * KSTR, A_VT = 128 * VSTR, A_MT = 4096;
constexpr int A_BUF = A_KT + A_VT + A_MT;
constexpr int A_TAB = 2 * A_BUF;
struct KV1 { u32x4 k[2], v[2]; unsigned m[2]; };
__device__ __forceinline__ void kv1_load_kv(KV1& st, const h16* Kg, const h16* Vg, int tile, int tid) {
#pragma unroll
    for (int i = 0; i < 2; ++i) { const int idx = tid + 512 * i; const size_t off = (size_t)(tile * 128 + (idx >> 3)) * 512 + (idx & 7) * 8;
        st.k[i] = *(const u32x4*)(Kg + off); st.v[i] = *(const u32x4*)(Vg + off); }
}
__device__ __forceinline__ void kv1_load_m(KV1& st, const unsigned* Mq, int tile, int tid) {
#pragma unroll
    for (int i = 0; i < 2; ++i) { const int idx = tid + 512 * i;
        st.m[i] = __hip_atomic_load(Mq + (size_t)(4 * tile + (idx >> 8)) * SEQ + (idx & 255), __ATOMIC_RELAXED, __HIP_MEMORY_SCOPE_AGENT); }
}
__device__ __forceinline__ void kv1_load(KV1& st, const h16* Kg, const h16* Vg, const unsigned* Mq, int tile, int tid) { kv1_load_kv(st, Kg, Vg, tile, tid); kv1_load_m(st, Mq, tile, tid); }
struct SaPre { KV1 st; h16x8 qf[4]; };
__device__ __forceinline__ void sa_prefetch_kvq(SaPre& pre, const Params& p, int b, int h, int qb) {
    const int tid = opaque_tid(), lane = tid & 63, wv = __builtin_amdgcn_readfirstlane(tid >> 6), r32 = lane & 31, hh = lane >> 5;
    const h16* Qg = (const h16*)(p.ws + WS_QA) + (size_t)b * SEQ * 512 + h * 64;
    const h16* Kg = (const h16*)(p.ws + WS_KA) + (size_t)b * SEQ * 512 + h * 64;
    const h16* Vg = (const h16*)(p.ws + WS_VA) + (size_t)b * SEQ * 512 + h * 64;
    kv1_load_kv(pre.st, Kg, Vg, 0, tid);
    const int qw = qb * 256 + wv * 32;
#pragma unroll
    for (int ks = 0; ks < 4; ++ks) pre.qf[ks] = *(const h16x8*)(Qg + (size_t)(qw + r32) * 512 + ks * 16 + hh * 8);
}
__device__ __forceinline__ void sa_prefetch_m(SaPre& pre, const Params& p, int b, int qb) {
    const int tid = opaque_tid();
    kv1_load_m(pre.st, (const unsigned*)(p.ws + WS_MASK) + (size_t)b * 64 * SEQ + qb * 256, 0, tid);
}
__device__ __forceinline__ void kv1_store(const KV1& st, LAS unsigned char* buf, int tid) {
#pragma unroll
    for (int i = 0; i < 2; ++i) { const int idx = tid + 512 * i;
        *(LAS u32x4*)(buf + (idx >> 3) * KSTR + (idx & 7) * 16) = st.k[i];
        *(LAS u32x4*)(buf + A_KT + (idx >> 3) * VSTR + (idx & 7) * 16) = st.v[i];
        *(LAS unsigned*)(buf + A_KT + A_VT + idx * 4) = st.m[i]; }
}
__device__ __forceinline__ void sa_unit(const Params& p, LAS unsigned char* lds, int b, int h, int qb, bool new_head, SaPre& pre, bool has_next, int nb, int nh, int nqb, SaPre& pre_next) {
    const int tid = opaque_tid(), lane = tid & 63, wv = __builtin_amdgcn_readfirstlane(tid >> 6), r32 = lane & 31, hh = lane >> 5;
    const h16* Qg = (const h16*)(p.ws + WS_QA) + (size_t)b * SEQ * 512 + h * 64;
    const h16* Kg = (const h16*)(p.ws + WS_KA) + (size_t)b * SEQ * 512 + h * 64;
    const h16* Vg = (const h16*)(p.ws + WS_VA) + (size_t)b * SEQ * 512 + h * 64;
    const h16* Gg = (const h16*)(p.ws + WS_GA) + (size_t)b * SEQ * 512 + h * 64;
    h16* Og = (h16*)(p.ws + WS_MIX) + (size_t)b * SEQ * 1024 + h * 64;
    const int q0 = qb * 256, qw = q0 + wv * 32;
    const unsigned* Mq = (const unsigned*)(p.ws + WS_MASK) + (size_t)b * 64 * SEQ + q0;
    LAS float* btab = (LAS float*)(lds + A_TAB);
    LAS float* lx = (LAS float*)(lds + A_TAB + 1280);
    const int jmax = 2 * qb + 1, diag = qw >> 5;
    KV1 st = pre.st;
    __syncthreads();
    if (new_head && tid < 320) { const int d = tid - 32; btab[tid] = (p.rel_bias[T5_BUCKET[d < 0 ? 0 : (d > 127 ? 127 : d)] * 8 + h] - p.rel_bias[31 * 8 + h]) * LOG2E; }
    h16x8 qf[4];
#pragma unroll
    for (int ks = 0; ks < 4; ++ks) qf[ks] = pre.qf[ks];
    (void)Qg;
    f32x16 o[2]; o[0] = f32x16{}; o[1] = f32x16{};
    f32x16 osum = f32x16{};
    b16x8 ones;
#pragma unroll
    for (int i = 0; i < 8; ++i) ones[i] = (short)0x3F80;
    const int tq = qw + r32;
    asm volatile("" : "+v"(qf[0]), "+v"(qf[1]), "+v"(qf[2]), "+v"(qf[3]));
    int cur = 0;
    kv1_store(st, lds, tid);
    __syncthreads();
    const int jf = (qw - 112) > 0 ? ((qw - 112) >> 7) : 0;
    const int jd = diag >> 2;
    int j = 0;
#define SA_STAGE_IN()  if (j < jmax) kv1_load(st, Kg, Vg, Mq, j + 1, tid); \
        LAS const unsigned char* kb = lds + cur * A_BUF; LAS const unsigned char* vb = kb + A_KT; \
        const LAS unsigned* mb = (const LAS unsigned*)(kb + A_KT + A_VT) + wv * 32 + r32;
#define SA_STAGE_OUT() if (j < jmax) kv1_store(st, lds + (cur ^ 1) * A_BUF, tid); \
        LDS_BARRIER(); \
        cur ^= 1;
    for (; j < jf; ++j) {
        SA_STAGE_IN()
#pragma unroll
        for (int pr = 0; pr < 2; ++pr) {
            const unsigned mw0 = mb[(2 * pr) * 256] >> (4 * hh), mw1 = mb[(2 * pr + 1) * 256] >> (4 * hh);
            h16x8 kf0[4], kf1[4], vf0[2][2], vf1[2][2]; b16x8 pa0[2], pa1[2];
            k_frags(kf0, kb, 2 * pr, r32, hh); k_frags(kf1, kb, 2 * pr + 1, r32, hh); v_frags(vf0, vb, 2 * pr, lane);
            SCHED_FENCE();
            const f32x16 s0 = qk_mma(kf0, qf, f32x16{});
            const f32x16 s1 = qk_mma(kf1, qf, f32x16{});
            v_frags(vf1, vb, 2 * pr + 1, lane);
            SCHED_FENCE();
            sa_probs(s0, mw0, btab, false, pa0, osum, ones, hh);
            pv_mma_b(o, vf0, pa0);
            sa_probs(s1, mw1, btab, false, pa1, osum, ones, hh);
            pv_mma_b(o, vf1, pa1);
        }
        SA_STAGE_OUT()
    }
    for (; j <= jd; ++j) {
        SA_STAGE_IN()
#pragma unroll
        for (int sub = 0; sub < 4; ++sub) {
            const int si = 4 * j + sub;
            if (si <= diag) {
                const unsigned mw = mb[sub * 256] >> (4 * hh);
                const f32x16 s = qk_tile(kb, sub, qf, r32, hh);
                b16x8 pa[2]; h16x8 vfn[2][2];
                v_frags(vfn, vb, sub, lane);
                sa_probs(s, mw, btab + (tq - 32 * si + 5 - 4 * hh), true, pa, osum, ones, hh);
                pv_mma_b(o, vfn, pa);
            }
        }
        SA_STAGE_OUT()
    }
    for (; j <= jmax; ++j) {
        SA_STAGE_IN()
        (void)vb; (void)mb;
        SA_STAGE_OUT()
    }
#undef SA_STAGE_IN
#undef SA_STAGE_OUT
    if (has_next) { sa_prefetch_kvq(pre_next, p, nb, nh, nqb); sa_prefetch_m(pre_next, p, nb, nqb); }
    if (r32 == 0) {
#pragma unroll
        for (int r = 0; r < 16; ++r) lx[wv * 32 + crow(r, hh)] = osum[r];
    }
    att_store(o, lds + wv * (32 * OSTR), lx + wv * 32, Gg, Og, qw, lane);
}
__device__ __forceinline__ void phase_sa(const Params& p, LAS unsigned char* lds, int bid, int nblk, const XcdBarrier& bar) {
    SaPre pa, pb;
    const int u = bid; const bool any = u < 512;
    int b = 0, h = 0, qb = 0;
    if (any) { att_unit(u, b, h, qb); sa_prefetch_kvq(pa, p, b, h, qb); }
    flat_wait(bar, 0);
    if (!any) return;
    sa_prefetch_m(pa, p, b, qb);
    const int u2 = u + nblk; const bool hn = u2 < 512;
    int nb = 0, nh = 0, nqb = 0; if (hn) att_unit(u2, nb, nh, nqb);
    sa_unit(p, lds, b, h, qb, true, pa, hn, nb, nh, nqb, pb);
    if (!hn) return;
    sa_unit(p, lds, nb, nh, nqb, nh != h, pb, false, 0, 0, 0, pa);
    int hprev = nh;
    for (int u3 = u2 + nblk; u3 < 512; u3 += nblk) {
        SaPre pc; att_unit(u3, b, h, qb); sa_prefetch_kvq(pc, p, b, h, qb); sa_prefetch_m(pc, p, b, qb);
        sa_unit(p, lds, b, h, qb, h != hprev, pc, false, 0, 0, 0, pc); hprev = h;
    }
}
constexpr int IK_STR = 144, IK_BUF = 256 * IK_STR, IK_SB = 2 * IK_BUF;
__device__ __forceinline__ int half_sum(int v) {
    v += __builtin_amdgcn_update_dpp(0, v, 0xB1, 0xF, 0xF, false);
    v += __builtin_amdgcn_update_dpp(0, v, 0x4E, 0xF, 0xF, false);
    v += __builtin_amdgcn_update_dpp(0, v, 0x141, 0xF, 0xF, false);
    v += __builtin_amdgcn_update_dpp(0, v, 0x140, 0xF, 0xF, false);
    { auto rr = __builtin_amdgcn_permlane16_swap((unsigned)v, (unsigned)v, false, false); v = (int)(rr[0] + rr[1]); }
    return v;
}
__device__ __forceinline__ unsigned half_umax(unsigned v) {
    unsigned o;
    o = (unsigned)__builtin_amdgcn_update_dpp(0, (int)v, 0xB1, 0xF, 0xF, false); v = v > o ? v : o;
    o = (unsigned)__builtin_amdgcn_update_dpp(0, (int)v, 0x4E, 0xF, 0xF, false); v = v > o ? v : o;
    o = (unsigned)__builtin_amdgcn_update_dpp(0, (int)v, 0x141, 0xF, 0xF, false); v = v > o ? v : o;
    o = (unsigned)__builtin_amdgcn_update_dpp(0, (int)v, 0x140, 0xF, 0xF, false); v = v > o ? v : o;
    { auto rr = __builtin_amdgcn_permlane16_swap(v, v, false, false); v = rr[0] > rr[1] ? rr[0] : rr[1]; }
    return v;
}
__device__ __forceinline__ float keyf(unsigned k) { return __uint_as_float((k & 0x80000000u) ? (k ^ 0x80000000u) : ~k); }
__device__ __forceinline__ void ik_load(u32x4 (&sk)[4], const h16* KI, int g, int tid) {
#pragma unroll
    for (int i = 0; i < 4; ++i) { const int idx = tid + 512 * i; sk[i] = *(const u32x4*)(KI + (size_t)(256 * g + (idx >> 3)) * 64 + (idx & 7) * 8); }
}
__device__ __forceinline__ void ik_store(const u32x4 (&sk)[4], LAS unsigned char* buf, int tid) {
#pragma unroll
    for (int i = 0; i < 4; ++i) { const int idx = tid + 512 * i; *(LAS u32x4*)(buf + (idx >> 3) * IK_STR + (idx & 7) * 16) = sk[i]; }
}
struct IdxPre { u32x4 sk[4]; h16x8 aq[4]; };
__device__ __forceinline__ void idx_prefetch(IdxPre& pre, const Params& p, int b, int qt) {
    const int tid = opaque_tid(), lane = tid & 63, wv = __builtin_amdgcn_readfirstlane(tid >> 6), c = lane & 31, hi = lane >> 5;
    const h16* QI = (const h16*)(p.ws + WS_QI) + (size_t)b * SEQ * 1024;
    const h16* KI = (const h16*)(p.ws + WS_KI) + (size_t)b * SEQ * 64;
    const int t0 = qt * 16 + wv * 2;
    ik_load(pre.sk, KI, 0, tid);
    const int rq = (c >> 2) & 1, rh = (c & 3) + 4 * (c >> 3);
#pragma unroll
    for (int ks = 0; ks < 4; ++ks) pre.aq[ks] = *(const h16x8*)(QI + (size_t)(t0 + rq) * 1024 + rh * 64 + ks * 16 + hi * 8);
}
__device__ __forceinline__ void idx_unit(const Params& p, LAS unsigned char* lds, int b, int qt, IdxPre& pre, bool has_next, int nb, int nqt, IdxPre& pre_next) {
    const int tid = opaque_tid(), lane = tid & 63, wv = __builtin_amdgcn_readfirstlane(tid >> 6), c = lane & 31, hi = lane >> 5;
    const h16* KI = (const h16*)(p.ws + WS_KI) + (size_t)b * SEQ * 64;
    unsigned* Mg = (unsigned*)(p.ws + WS_MASK) + (size_t)b * 64 * SEQ;
    const int t0 = qt * 16 + wv * 2, t = t0 + hi;
    u32x4 (&sk)[4] = pre.sk;
    h16x8 aq[4];
#pragma unroll
    for (int ks = 0; ks < 4; ++ks) aq[ks] = pre.aq[ks];
    const float* WI = (const float*)(p.ws + WS_WI) + (size_t)b * SEQ * 16;
    float wq[16];
#pragma unroll
    for (int i = 0; i < 4; ++i) { const f32x4 w4 = *(const f32x4*)(WI + (size_t)t * 16 + 4 * i); wq[4 * i] = w4.x; wq[4 * i + 1] = w4.y; wq[4 * i + 2] = w4.z; wq[4 * i + 3] = w4.w; }
    const int ntile = ((t0 + 1) >> 5) + 1;
    const int ngroup = ((qt * 16 + 15) >> 8) + 1;
    LAS unsigned* sb = (LAS unsigned*)(lds + IK_SB + wv * 2048);
    unsigned u[64];
#pragma unroll
    for (int j = 0; j < 64; ++j) u[j] = 0x7FC00000u;
    asm volatile("" : "+v"(aq[0]), "+v"(aq[1]), "+v"(aq[2]), "+v"(aq[3]));
    ik_store(sk, lds, tid);
    __syncthreads();
#pragma unroll
    for (int i = 0; i < 16; ++i) asm volatile("" : "+v"(wq[i]));
#pragma unroll
    for (int g = 0; g < 8; ++g) {
        if (g < ngroup) {
            if (g + 1 < ngroup) ik_load(sk, KI, g + 1, tid);
            LAS const unsigned char* kb = lds + (g & 1) * IK_BUF + c * IK_STR + hi * 16;
            h16x8 bk[4];
#pragma unroll
            for (int ks = 0; ks < 4; ++ks) bk[ks] = *(LAS const h16x8*)(kb + ks * 32);
#pragma unroll 2
            for (int jj = 0; jj < 8; ++jj) {
                const int j = 8 * g + jj, jn = jj < 7 ? jj + 1 : 7;
                h16x8 bn[4];
#pragma unroll
                for (int ks = 0; ks < 4; ++ks) bn[ks] = *(LAS const h16x8*)(kb + jn * (32 * IK_STR) + ks * 32);
                __builtin_amdgcn_sched_barrier(0);
                unsigned key = 0x7FC00000u;
                if (j < ntile) {
                    f32x16 acc = f32x16{};
#pragma unroll
                    for (int ks = 0; ks < 4; ++ks) acc = __builtin_amdgcn_mfma_f32_32x32x16_f16(aq[ks], bk[ks], acc, 0, 0, 0);
                    float sc = 0.f;
#pragma unroll
                    for (int r = 0; r < 16; ++r) { const int ib = __float_as_int(acc[r]); sc = __builtin_fmaf(wq[r], __int_as_float(ib > 0 ? ib : 0), sc); }
                    key = __float_as_uint(sc);
                }
                sb[jj * 64 + lane] = key;
#pragma unroll
                for (int ks = 0; ks < 4; ++ks) bk[ks] = bn[ks];
            }
            if (g == ((ntile - 1) >> 3)) { if (32 * (ntile - 1) + c > t) sb[((ntile - 1) & 7) * 64 + lane] = 0x7FC00000u; }
#pragma unroll
            for (int jj = 0; jj < 8; ++jj) u[8 * g + jj] = sb[jj * 64 + lane];
            if (g + 1 < ngroup) ik_store(sk, lds + ((g + 1) & 1) * IK_BUF, tid);
            asm volatile("s_waitcnt lgkmcnt(0)\n\ts_barrier" ::: "memory");
        }
    }
    if (has_next) idx_prefetch(pre_next, p, nb, nqt);
    unsigned T = 1u; bool exact = true;
    if (t0 >= TOPK) {
        float fmx = -__builtin_inff(), fmn = __builtin_inff();
#define IDX_MM(J0) _Pragma("unroll") for (int j = (J0); j < (J0) + 16; ++j) asm volatile("v_max_f32 %0, %0, %2\n\tv_min_f32 %1, %1, %2" : "+v"(fmx), "+v"(fmn) : "v"(u[j]));
        IDX_MM(0)
        if (ntile > 16) { IDX_MM(16) if (ntile > 32) { IDX_MM(32) if (ntile > 48) { IDX_MM(48) } } }
#undef IDX_MM
        unsigned kmax = fkey(fmx), kmin1 = fkey(fmn) - 1u;
        kmax = half_umax(kmax); kmin1 = ~half_umax(~kmin1);
        unsigned lo_k = kmin1 + 1u, hi_k = kmax + 1u;
        float lo_f = keyf(lo_k), hi_f = keyf(hi_k);
        float f_lo = (float)(t + 1) - ((float)TOPK - 0.5f), f_hi = -((float)TOPK - 0.5f);
        int side = 0; bool done = false; exact = false; T = lo_k;
        if (hi_k - lo_k <= 1u) done = true;
        for (int it = 0; it < 64; ++it) {
            unsigned mid_k;
            if (it < 24) { const float mid_f = hi_f - (hi_f - lo_f) * (f_hi / (f_hi - f_lo)); mid_k = fkey(mid_f); } else mid_k = lo_k + ((hi_k - lo_k) >> 1);
            mid_k = mid_k < lo_k + 1u ? lo_k + 1u : (mid_k > hi_k - 1u ? hi_k - 1u : mid_k);
            const float mid_c = keyf(mid_k);
            int c0 = 0, c1 = 0, c2 = 0, c3 = 0;
#define IDX_CNT(J0) _Pragma("unroll") for (int j = (J0); j < (J0) + 16; j += 4) { \
                asm volatile("v_cmp_ge_f32_e64 s[20:21], %4, %8\n\tv_cmp_ge_f32_e64 s[22:23], %5, %8\n\tv_cmp_ge_f32_e64 s[24:25], %6, %8\n\tv_cmp_ge_f32_e64 s[26:27], %7, %8\n\t" \
                             "v_addc_co_u32_e64 %0, s[28:29], 0, %0, s[20:21]\n\tv_addc_co_u32_e64 %1, s[28:29], 0, %1, s[22:23]\n\tv_addc_co_u32_e64 %2, s[28:29], 0, %2, s[24:25]\n\tv_addc_co_u32_e64 %3, s[28:29], 0, %3, s[26:27]" \
                             : "+v"(c0), "+v"(c1), "+v"(c2), "+v"(c3) : "v"(u[j]), "v"(u[j + 1]), "v"(u[j + 2]), "v"(u[j + 3]), "v"(mid_c) \
                             : "s20", "s21", "s22", "s23", "s24", "s25", "s26", "s27", "s28", "s29"); }
            IDX_CNT(0)
            if (ntile > 16) { IDX_CNT(16) if (ntile > 32) { IDX_CNT(32) if (ntile > 48) { IDX_CNT(48) } } }
#undef IDX_CNT
            const int cnt = half_sum((c0 + c1) + (c2 + c3));
            if (!done) {
                if (cnt == TOPK) { T = mid_k; exact = true; done = true; }
                else if (cnt > TOPK) { lo_k = mid_k; lo_f = keyf(mid_k); f_lo = (float)cnt - ((float)TOPK - 0.5f); if (side > 0) f_hi *= 0.5f; side = 1; }
                else { hi_k = mid_k; hi_f = keyf(mid_k); f_hi = (float)cnt - ((float)TOPK - 0.5f); if (side < 0) f_lo *= 0.5f; side = -1; }
                if (!done && hi_k - lo_k <= 1u) { T = lo_k; done = true; }
            }
            if (__all(done)) break;
        }
    }
    LAS unsigned long long* tb = (LAS unsigned long long*)(lds + IK_SB + 16384) + wv;
    const float Tf = (t0 >= TOPK) ? keyf(T) : -__builtin_inff();
    if (__all(exact)) {
        unsigned vlo = 0u, vhi = 0u;
#define IDX_OUT(J0) _Pragma("unroll") for (int j = (J0); j < (J0) + 16; j += 4) { \
            asm volatile("v_cmp_ge_f32_e64 s[20:21], %2, %6\n\tv_cmp_ge_f32_e64 s[22:23], %3, %6\n\tv_cmp_ge_f32_e64 s[24:25], %4, %6\n\tv_cmp_ge_f32_e64 s[26:27], %5, %6\n\t" \
                         "v_writelane_b32 %0, s20, %7\n\tv_writelane_b32 %1, s21, %7\n\tv_writelane_b32 %0, s22, %8\n\tv_writelane_b32 %1, s23, %8\n\t" \
                         "v_writelane_b32 %0, s24, %9\n\tv_writelane_b32 %1, s25, %9\n\tv_writelane_b32 %0, s26, %10\n\tv_writelane_b32 %1, s27, %10" \
                         : "+v"(vlo), "+v"(vhi) : "v"(u[j]), "v"(u[j + 1]), "v"(u[j + 2]), "v"(u[j + 3]), "v"(Tf), "n"(j), "n"(j + 1), "n"(j + 2), "n"(j + 3) \
                         : "s20", "s21", "s22", "s23", "s24", "s25", "s26", "s27"); }
        IDX_OUT(0)
        if (ntile > 16) { IDX_OUT(16) if (ntile > 32) { IDX_OUT(32) if (ntile > 48) { IDX_OUT(48) } } }
#undef IDX_OUT
        tb[lane * 8] = ((unsigned long long)vhi << 32) | vlo;
    } else {
        int ngt = 0;
#pragma unroll
        for (int j = 0; j < 64; ++j) ngt += (__uint_as_float(u[j]) > Tf) ? 1 : 0;
        ngt = half_sum(ngt);
        const int need = exact ? (1 << 30) : TOPK - ngt;
        int base = 0;
#pragma unroll
        for (int j = 0; j < 64; ++j) {
            const bool eq = (__uint_as_float(u[j]) == Tf);
            const unsigned long long be = __ballot(eq);
            const unsigned mh = hi ? (unsigned)(be >> 32) : (unsigned)be;
            const int rank = base + __popc(mh & ((1u << c) - 1u));
            const bool sel = (__uint_as_float(u[j]) > Tf) || (eq && rank < need);
            base += __popc(mh);
            const unsigned long long bal = __ballot(sel);
            if (lane == 0) tb[j * 8] = bal;
        }
    }
    __syncthreads();
    __hip_atomic_store((unsigned long long*)(Mg + (size_t)(tid >> 3) * SEQ + qt * 16 + 2 * (tid & 7)), ((LAS const unsigned long long*)(lds + IK_SB + 16384))[tid], __ATOMIC_RELAXED, __HIP_MEMORY_SCOPE_AGENT);
}
__device__ __forceinline__ void idx_deal(int u, int& b, int& qt) {
    b = u & 7; const int kk = (u >> 3) & 31, r = u >> 8; qt = r == 0 ? 127 - kk : (r == 1 ? 64 + kk : (r == 2 ? 63 - kk : kk));
}
__device__ __forceinline__ void phase_idx(const Params& p, LAS unsigned char* lds, int bid, int nblk) {
    IdxPre pa, pb;
    int u = bid; if (u >= 1024) return;
    int b, qt; idx_deal(u, b, qt);
    idx_prefetch(pa, p, b, qt);
    for (;;) {
        int un = u + nblk, nb = 0, nqt = 0; bool hn = un < 1024; if (hn) idx_deal(un, nb, nqt);
        idx_unit(p, lds, b, qt, pa, hn, nb, nqt, pb);
        if (!hn) break;
        u = un; b = nb; qt = nqt; un = u + nblk; hn = un < 1024; if (hn) idx_deal(un, nb, nqt);
        idx_unit(p, lds, b, qt, pb, hn, nb, nqt, pa);
        if (!hn) break;
        u = un; b = nb; qt = nqt;
    }
}
#include <cstdio>
__global__ void __launch_bounds__(NTHR, 2) k_fused(Params p) {
    extern __shared__ __attribute__((aligned(16))) unsigned char lds_raw[];
    LAS unsigned char* lds = (LAS unsigned char*)lds_raw;
    const int bid = blockIdx.x, nblk = gridDim.x;
    volatile LAS unsigned* st = (volatile LAS unsigned*)(lds + MISC_OFF);
    if (threadIdx.x < 64) st[threadIdx.x] = 0u;
    __syncthreads();
    Half H = half_init(lds);
    const XcdBarrier bar = xcd_barrier_post((unsigned*)(p.ws + WS_CTL), st);
    phase_prologue(p, lds, bid, nblk);
    xcd_barrier(bar);
    phase_gemm1(p, lds, bid, nblk);
    phase_kiwi(p, lds, bid, nblk);
    xcd_barrier(bar);
    phase_idx(p, lds, bid, nblk);
    flat_arrive(bar, 0);
    phase_sb2(p, H, bid, nblk);
    phase_sa(p, lds, bid, nblk, bar);
    xcd_barrier(bar);
    phase_gemm2(p, lds, bid, nblk);
}

extern "C" void kernel_launch(void* const* d_in, const int* in_sizes, int n_in, void* d_out, int out_size, void* d_ws, size_t ws_size, hipStream_t stream) {
    static int grid_blocks = 0;
    if (!grid_blocks) {
        int dev = 0, cus = 0, per_cu = 0;
        (void)hipGetDevice(&dev);
        (void)hipDeviceGetAttribute(&cus, hipDeviceAttributeMultiprocessorCount, dev);
        (void)hipFuncSetAttribute((const void*)k_fused, hipFuncAttributeMaxDynamicSharedMemorySize, LDS_BYTES);
        (void)hipOccupancyMaxActiveBlocksPerMultiprocessor(&per_cu, (const void*)k_fused, NTHR, LDS_BYTES);
        if (per_cu < 1) per_cu = 1;
        if (per_cu > 1) per_cu = 1;
        grid_blocks = cus * per_cu;
    }
    (void)hipMemsetAsync((char*)d_ws + WS_CTL, 0, 16384, stream);
    Params p{};
    p.x = (const float*)d_in[0]; p.norm_gain = (const float*)d_in[1]; p.w_in = (const float*)d_in[2]; p.qg = (const float*)d_in[3]; p.kg = (const float*)d_in[4];
    p.rel_bias = (const float*)d_in[5]; p.w_out = (const float*)d_in[6]; p.out = (float*)d_out; p.ws = (unsigned char*)d_ws; p.use_cg = 0; p.pad = 0;
    void* args[] = {&p};
    hipError_t e = hipLaunchCooperativeKernel((const void*)k_fused, dim3(grid_blocks), dim3(NTHR), args, LDS_BYTES, stream);
    if (e != hipSuccess) fprintf(stderr, "cooperative launch failed: %s (grid %d)\n", hipGetErrorString(e), grid_blocks);
}
```

```cpp
#include <hip/hip_runtime.h>
#include <stdint.h>

typedef _Float16 h16;

constexpr int NB = 8, SEQ = 2048, DM = 1024, MTOK = NB * SEQ;
constexpr int NPROJ = 5200;
constexpr float LOG2E = 1.4426950408889634f;
constexpr float QSCALE = 0.125f * LOG2E;
constexpr float IDXS = 0.03125f;
constexpr float RMS_EPS = 1e-6f;
constexpr int TOPK = 256;
constexpr int C_QA = 0, C_KA = 512, C_VA = 1024, C_GA = 1536, C_QI = 2048, C_KI = 3072, C_WI = 3136, C_QB = 3152, C_KB = 3664, C_VB = 4176, C_GB = 4688;

constexpr size_t MiB = 1u << 20;
constexpr size_t WS_CTL = 0, WS_HN = 1 * MiB, WS_W1T = 33 * MiB, WS_W2T = 44 * MiB;
constexpr size_t WS_QA = 46 * MiB, WS_KA = 62 * MiB, WS_VA = 78 * MiB, WS_GA = 94 * MiB, WS_QI = 110 * MiB, WS_KI = 142 * MiB, WS_WI = 144 * MiB;
constexpr size_t WS_QB = 145 * MiB, WS_KB = 161 * MiB, WS_VB = 177 * MiB, WS_GB = 193 * MiB, WS_MASK = 209 * MiB, WS_MIX = WS_HN, WS_FREE = 213 * MiB;

__device__ const unsigned char T5_BUCKET[128] = {0, 1, 2, 3, 4, 5, 6, 7, 8, 9, 10, 11, 12, 13, 14, 15, 16, 16, 16, 17, 17, 18, 18, 18, 19, 19, 19, 20, 20, 20, 20, 21, 21, 21, 21, 22, 22, 22, 22, 22, 23, 23, 23, 23, 23, 23, 24, 24, 24, 24, 24, 24, 25, 25, 25, 25, 25, 25, 25, 26, 26, 26, 26, 26, 26, 26, 26, 27, 27, 27, 27, 27, 27, 27, 27, 27, 27, 28, 28, 28, 28, 28, 28, 28, 28, 28, 28, 29, 29, 29, 29, 29, 29, 29, 29, 29, 29, 29, 29, 30, 30, 30, 30, 30, 30, 30, 30, 30, 30, 30, 30, 30, 30, 31, 31, 31, 31, 31, 31, 31, 31, 31, 31, 31, 31, 31, 31, 31};

__device__ __forceinline__ float wave_sum(float v) {
#pragma unroll
    for (int o = 1; o < 64; o <<= 1) v += __shfl_xor(v, o);
    return v;
}
__device__ __forceinline__ unsigned fkey(float f) { const unsigned u = __float_as_uint(f); return (u & 0x80000000u) ? ~u : (u | 0x80000000u); }
#define LAS __attribute__((address_space(3)))
typedef _Float16 h16x8 __attribute__((ext_vector_type(8)));
typedef _Float16 h16x4 __attribute__((ext_vector_type(4)));
typedef _Float16 h16x2 __attribute__((ext_vector_type(2)));
typedef float f32x2 __attribute__((ext_vector_type(2)));
typedef float f32x4 __attribute__((ext_vector_type(4)));
typedef float f32x16 __attribute__((ext_vector_type(16)));
typedef unsigned u32x4 __attribute__((ext_vector_type(4)));
typedef unsigned u32x2 __attribute__((ext_vector_type(2)));
typedef short s16x4 __attribute__((ext_vector_type(4)));

constexpr int NTHR = 512, NWAVE = 8;
constexpr int N1PAD = 5120;
constexpr int W3ROW = 5120;
constexpr int LDS_BYTES = 147456;

struct Params {
    const float *x, *norm_gain, *w_in, *qg, *kg, *rel_bias, *w_out;
    float* out; unsigned char* ws; int use_cg, pad;
};

__device__ __forceinline__ int opaque_tid() { int t = threadIdx.x; asm volatile("" : "+v"(t)); return t; }
typedef __bf16 bf16x2_t __attribute__((ext_vector_type(2)));
__device__ __forceinline__ unsigned pk2b(float lo, float hi) { f32x2 v = {lo, hi}; bf16x2_t b = __builtin_convertvector(v, bf16x2_t); return __builtin_bit_cast(unsigned, b); }
__device__ __forceinline__ unsigned pk2h(float lo, float hi) { f32x2 v = {lo, hi}; h16x2 h = __builtin_convertvector(v, h16x2); return __builtin_bit_cast(unsigned, h); }

__host__ __device__ __forceinline__ int phys_of_logical(int lt) { const int wc = lt >> 6, bj = (lt >> 5) & 1, fq = (lt >> 3) & 3, n = (lt >> 2) & 1, reg = lt & 3; return 128 * bj + 32 * wc + 16 * n + 4 * fq + reg; }
__host__ __device__ __forceinline__ int phys_of_logical2(int lt) { const int wc = lt >> 6, bj = (lt >> 5) & 1, n = (lt >> 4) & 1, fq = (lt >> 2) & 3, reg = lt & 3; return 128 * bj + 32 * wc + 16 * n + 4 * fq + reg; }
__host__ __device__ __forceinline__ int w1_row_of_col(int c) {
    int pn, lt;
    if (c < 3072) { pn = c >> 8; lt = c & 255; } else if (c < 3152) { return W3ROW + (c - 3072); } else { const int cc = c - 3152; pn = 12 + (cc >> 8); lt = cc & 255; }
    return 256 * pn + phys_of_logical(lt);
}

namespace pg8 {
constexpr int BM = 256, BK = 64, HALF = 128, HTB = HALF * BK * 2, STAGE_BYTES = 8 * HTB, NXCD = 8, WGM = 8;
__host__ __device__ __forceinline__ int lds_byte(int r, int c) { const int st = (r >> 4) * 2 + (c >> 5), rr = r & 15, cc = c & 31, ob = rr * 64 + cc * 2; return st * 1024 + (ob ^ (((ob >> 9) & 1) << 5)); }
__host__ __device__ __forceinline__ void stage_rc(int b, int& R, int& C) { const int st = b / 1024, sb = b % 1024, swz = sb ^ (((sb >> 9) & 1) << 5); R = (st >> 1) * 16 + swz / 64; C = (st & 1) * 32 + (swz % 64) / 2; }
struct Unit { int pm, pn; };
struct Gemm { const h16* A; const h16* Bt; int M, N, K; };
struct StaticOrder {
    int nM, nN, nwg, G, c;
    __host__ __device__ __forceinline__ void init(int M, int N, int G_, int c_) { nM = M / BM; nN = N / BM; nwg = nM * nN; G = G_; c = c_; }
    __host__ __device__ __forceinline__ bool next(int i, Unit& u) const {
        const long L = (long)i * G + c; if (L >= nwg) return false;
        int wgid = (int)L; { const int q = nwg / NXCD, r = nwg % NXCD, xcd = wgid % NXCD, off = wgid / NXCD; wgid = (xcd < r ? xcd * (q + 1) : r * (q + 1) + (xcd - r) * q) + off; }
        const int nig = WGM * nN, gid = wgid / nig, fm = gid * WGM, gsz = (nM - fm) < WGM ? (nM - fm) : WGM;
        u.pm = fm + ((wgid % nig) % gsz); u.pn = (wgid % nig) / gsz; return true;
    }
};
template <class Epi, class Sched, bool ALIGN_EPI = false, bool SP2 = false>
__device__ __forceinline__ void gemm_phase(LAS unsigned char* lds, const Gemm g, const Sched& S, const Epi& E) {
    const int tid = opaque_tid(), wid = __builtin_amdgcn_readfirstlane(tid >> 6), lane = tid & 63, wr = wid >> 2, wc = wid & 3, fr = lane & 15, fq = lane >> 4;
    const int K = g.K, nt = K / BK;
    unsigned voffA[2], voffB[2];
#pragma unroll
    for (int i = 0; i < 2; ++i) { int R, C; stage_rc(tid * 16 + i * 8192, R, C); voffA[i] = (unsigned)(R * K + C) * 2u; voffB[i] = (unsigned)(R * K + C) * 2u; }
    const size_t kstep = (size_t)(BK * 2);
    const size_t hstep = (size_t)HALF * K * 2;
    const size_t tstep = 2 * hstep;
    const unsigned ldsw = (unsigned)wid * 1024u;
    const int aoff = lds_byte(wr * 64 + fr, fq * 8), boff = lds_byte(wc * 32 + fr, fq * 8);
#define PG8_SA(b, h) (((b) * 2 + (h)) * HTB)
#define PG8_SB(b, h) ((4 + (b) * 2 + (h)) * HTB)
#define PG8_STAGE(bufoff, gbase, voff) do { _Pragma("unroll") for (int _i = 0; _i < 2; ++_i) \
        __builtin_amdgcn_global_load_lds((const unsigned*)((const char*)(gbase) + (voff)[_i]), (LAS unsigned*)(lds + (bufoff) + ldsw + _i * 8192), 16, 0, 0); } while (0)
#define PG8_LDA(dst, b, h) do { _Pragma("unroll") for (int m = 0; m < 4; ++m) _Pragma("unroll") for (int k = 0; k < 2; ++k) dst[m][k] = *(const LAS h16x8*)(lds + PG8_SA(b, h) + aoff + m * 2048 + k * 1024); } while (0)
#define PG8_LDB(dst, b, h) do { _Pragma("unroll") for (int n = 0; n < 2; ++n) _Pragma("unroll") for (int k = 0; k < 2; ++k) dst[n][k] = *(const LAS h16x8*)(lds + PG8_SB(b, h) + boff + n * 2048 + k * 1024); } while (0)
#define PG8_MMA(ai, bj, At, Bt) do { __builtin_amdgcn_s_setprio(1); _Pragma("unroll") for (int m = 0; m < 4; ++m) _Pragma("unroll") for (int n = 0; n < 2; ++n) _Pragma("unroll") for (int k = 0; k < 2; ++k) \
        acc[ai][bj][m][n] = __builtin_amdgcn_mfma_f32_16x16x32_f16(Bt[n][k], At[m][k], acc[ai][bj][m][n], 0, 0, 0); __builtin_amdgcn_s_setprio(0); } while (0)
#define PG8_WAIT_V(n) asm volatile("s_waitcnt vmcnt(" #n ")" ::: "memory")
#define PG8_WAIT_L(n) asm volatile("s_waitcnt lgkmcnt(" #n ")" ::: "memory")
#define PG8_BAR __builtin_amdgcn_s_barrier()
#define PG8_SCHED __builtin_amdgcn_sched_barrier(0)
    Unit cur, nxt; int ui = 0;
    if (!S.next(0, cur)) return;
    f32x4 acc[2][2][4][2];
#pragma unroll
    for (int a = 0; a < 2; ++a)
#pragma unroll
        for (int b = 0; b < 2; ++b)
#pragma unroll
            for (int m = 0; m < 4; ++m)
#pragma unroll
                for (int n = 0; n < 2; ++n) acc[a][b][m][n] = (f32x4){0.f, 0.f, 0.f, 0.f};
    h16x8 At[4][2], B0[2][2], B1[2][2];
    const char* cA = (const char*)g.A + (size_t)cur.pm * tstep; const char* cB = (const char*)g.Bt + (size_t)cur.pn * tstep;
    if constexpr (SP2) {
        PG8_STAGE(PG8_SB(0, 0), cB, voffB); PG8_STAGE(PG8_SB(0, 1), cB + hstep, voffB); PG8_STAGE(PG8_SA(0, 0), cA, voffA); PG8_STAGE(PG8_SA(0, 1), cA + hstep, voffA);
        if (wr == 1) PG8_BAR;
        PG8_WAIT_V(2); PG8_BAR;
        PG8_STAGE(PG8_SB(1, 0), cB + kstep, voffB); PG8_STAGE(PG8_SA(1, 0), cA + kstep, voffA); PG8_STAGE(PG8_SB(1, 1), cB + hstep + kstep, voffB);
        PG8_WAIT_V(6); PG8_BAR;
    } else {
        PG8_STAGE(PG8_SB(0, 0), cB, voffB); PG8_STAGE(PG8_SA(0, 0), cA, voffA); PG8_STAGE(PG8_SB(0, 1), cB + hstep, voffB); PG8_STAGE(PG8_SA(0, 1), cA + hstep, voffA);
        if (wr == 1) PG8_BAR;
        PG8_WAIT_V(4); PG8_BAR;
        PG8_STAGE(PG8_SB(1, 0), cB + kstep, voffB); PG8_STAGE(PG8_SA(1, 0), cA + kstep, voffA); PG8_STAGE(PG8_SB(1, 1), cB + hstep + kstep, voffB);
        PG8_WAIT_V(6); PG8_BAR;
    }
    for (;;) {
        const bool has_next = S.next(ui + 1, nxt);
        const char* nA = has_next ? (const char*)g.A + (size_t)nxt.pm * tstep : cA; const char* nB = has_next ? (const char*)g.Bt + (size_t)nxt.pn * tstep : cB;
        for (int t = 0; t < nt; t += 2) {
            const bool last = (t == nt - 2);
            const char* a1 = cA + (size_t)(t + 1) * kstep;
            const char* a2 = last ? nA : cA + (size_t)(t + 2) * kstep; const char* b2 = last ? nB : cB + (size_t)(t + 2) * kstep;
            const char* a3 = a2 + kstep; const char* b3 = b2 + kstep;
            if constexpr (SP2) {
            PG8_LDB(B0, 0, 0); PG8_LDB(B1, 0, 1); PG8_SCHED; PG8_LDA(At, 0, 0); PG8_STAGE(PG8_SA(1, 1), a1 + hstep, voffA);
            PG8_WAIT_V(8); PG8_WAIT_L(0); PG8_BAR; PG8_MMA(0, 0, At, B0); PG8_MMA(0, 1, At, B1); PG8_BAR; PG8_SCHED;
            PG8_LDA(At, 0, 1); PG8_STAGE(PG8_SB(0, 0), b2, voffB); PG8_STAGE(PG8_SB(0, 1), b2 + hstep, voffB); PG8_STAGE(PG8_SA(0, 0), a2, voffA);
            PG8_WAIT_V(8); PG8_WAIT_L(0); PG8_BAR; PG8_MMA(1, 0, At, B0); PG8_MMA(1, 1, At, B1); PG8_BAR; PG8_SCHED;
            PG8_LDB(B0, 1, 0); PG8_LDB(B1, 1, 1); PG8_SCHED; PG8_LDA(At, 1, 0); PG8_STAGE(PG8_SA(0, 1), a2 + hstep, voffA);
            PG8_WAIT_V(8); PG8_WAIT_L(0); PG8_BAR; PG8_MMA(0, 0, At, B0); PG8_MMA(0, 1, At, B1); PG8_BAR; PG8_SCHED;
            PG8_LDA(At, 1, 1); PG8_STAGE(PG8_SB(1, 0), b3, voffB); PG8_STAGE(PG8_SB(1, 1), b3 + hstep, voffB); PG8_STAGE(PG8_SA(1, 0), a3, voffA);
            PG8_WAIT_V(8); PG8_WAIT_L(0); PG8_BAR; PG8_MMA(1, 0, At, B0); PG8_MMA(1, 1, At, B1); PG8_BAR; PG8_SCHED;
            } else {
            PG8_LDB(B0, 0, 0); PG8_SCHED; PG8_LDA(At, 0, 0); PG8_STAGE(PG8_SA(1, 1), a1 + hstep, voffA);
            PG8_WAIT_L(8); PG8_BAR; PG8_WAIT_L(0); PG8_MMA(0, 0, At, B0); PG8_BAR; PG8_SCHED;
            PG8_LDB(B1, 0, 1); PG8_STAGE(PG8_SB(0, 0), b2, voffB);
            PG8_BAR; PG8_WAIT_L(0); PG8_MMA(0, 1, At, B1); PG8_BAR;
            PG8_LDA(At, 0, 1); PG8_STAGE(PG8_SA(0, 0), a2, voffA);
            PG8_BAR; PG8_WAIT_L(0); PG8_MMA(1, 0, At, B0); PG8_BAR; PG8_SCHED;
            PG8_STAGE(PG8_SB(0, 1), b2 + hstep, voffB);
            PG8_WAIT_V(6); PG8_BAR; PG8_MMA(1, 1, At, B1); PG8_BAR;
            PG8_LDB(B0, 1, 0); PG8_SCHED; PG8_LDA(At, 1, 0); PG8_STAGE(PG8_SA(0, 1), a2 + hstep, voffA);
            PG8_WAIT_L(8); PG8_BAR; PG8_WAIT_L(0); PG8_MMA(0, 0, At, B0); PG8_BAR; PG8_SCHED;
            PG8_LDB(B1, 1, 1); PG8_STAGE(PG8_SB(1, 0), b3, voffB);
            PG8_BAR; PG8_WAIT_L(0); PG8_MMA(0, 1, At, B1); PG8_BAR;
            PG8_LDA(At, 1, 1); PG8_STAGE(PG8_SA(1, 0), a3, voffA);
            PG8_BAR; PG8_WAIT_L(0); PG8_MMA(1, 0, At, B0); PG8_BAR; PG8_SCHED;
            PG8_STAGE(PG8_SB(1, 1), b3 + hstep, voffB);
            PG8_WAIT_V(6); PG8_BAR; PG8_MMA(1, 1, At, B1); PG8_BAR;
            }
        }
        if constexpr (ALIGN_EPI) { if (wr == 0) PG8_BAR; }
        E(acc, cur, wr, wc, fr, fq);
        if (!has_next) break;
#pragma unroll
        for (int a = 0; a < 2; ++a)
#pragma unroll
            for (int b = 0; b < 2; ++b)
#pragma unroll
                for (int m = 0; m < 4; ++m)
#pragma unroll
                    for (int n = 0; n < 2; ++n) acc[a][b][m][n] = (f32x4){0.f, 0.f, 0.f, 0.f};
        cur = nxt; cA = nA; cB = nB; ++ui;
        if constexpr (ALIGN_EPI) { if (wr == 1) PG8_BAR; }
    }
    PG8_WAIT_V(0);
    if constexpr (!ALIGN_EPI) { if (wr == 0) PG8_BAR; }
    PG8_BAR;
#undef PG8_SA
#undef PG8_SB
#undef PG8_STAGE
#undef PG8_LDA
#undef PG8_LDB
#undef PG8_MMA
#undef PG8_WAIT_V
#undef PG8_WAIT_L
#undef PG8_BAR
#undef PG8_SCHED
}
}

struct EpiProj {
    unsigned char* ws; const float* qg; const float* kg;
    __device__ __forceinline__ void operator()(const f32x4 (&acc)[2][2][4][2], const pg8::Unit& u, int wr, int wc, int fr, int fq) const {
        const int pn = u.pn;
        int kind = 0; float scale = 1.f; const float* gain = nullptr; h16* dst; int ld = 512, tcol = 0;
        if (pn < 8) { const int t = pn >> 1; tcol = (pn & 1) * 256; dst = (h16*)(ws + WS_QA + (size_t)t * (16 * MiB));
            if (t == 0) { kind = 1; gain = qg; scale = QSCALE; } else if (t == 1) { kind = 1; gain = kg; } else if (t == 2) kind = 3; else kind = 2; }
        else if (pn < 12) { dst = (h16*)(ws + WS_QI); ld = 1024; tcol = (pn - 8) * 256; }
        else { const int t = (pn - 12) >> 1; tcol = (pn & 1) * 256; dst = (h16*)(ws + WS_QB + (size_t)t * (16 * MiB)); if (t == 0) scale = QSCALE; else if (t == 3) kind = 2; }
        const int col = tcol + 64 * wc + 8 * fq;
        float gv[16];
        if (kind == 1) {
#pragma unroll
            for (int i = 0; i < 16; ++i) gv[i] = gain[32 * (i >> 3) + 8 * fq + (i & 7)] * scale;
        }
#pragma unroll
        for (int ai = 0; ai < 2; ++ai)
#pragma unroll
            for (int m = 0; m < 4; ++m) {
                const int row = u.pm * 256 + ai * 128 + wr * 64 + m * 16 + fr;
                float v[16];
#pragma unroll
                for (int bj = 0; bj < 2; ++bj)
#pragma unroll
                    for (int n = 0; n < 2; ++n)
#pragma unroll
                        for (int r = 0; r < 4; ++r) v[8 * bj + 4 * n + r] = acc[ai][bj][m][n][r];
                if (kind == 1) {
                    float s = 0.f;
#pragma unroll
                    for (int i = 0; i < 16; ++i) s += v[i] * v[i];
                    s += __shfl_xor(s, 16); s += __shfl_xor(s, 32);
                    const float rs = rsqrtf(s * (1.f / 64.f) + RMS_EPS);
#pragma unroll
                    for (int i = 0; i < 16; ++i) v[i] = v[i] * rs * gv[i];
                } else if (kind == 2) {
#pragma unroll
                    for (int i = 0; i < 16; ++i) v[i] = v[i] * __builtin_amdgcn_rcpf(1.f + __builtin_amdgcn_exp2f(-v[i] * LOG2E));
                } else {
#pragma unroll
                    for (int i = 0; i < 16; ++i) v[i] *= scale;
                }
                h16* o = dst + (size_t)row * ld + col;
                u32x4 w0, w1;
                if (kind == 3) { w0.x = pk2b(v[0], v[1]); w0.y = pk2b(v[2], v[3]); w0.z = pk2b(v[4], v[5]); w0.w = pk2b(v[6], v[7]);
                                 w1.x = pk2b(v[8], v[9]); w1.y = pk2b(v[10], v[11]); w1.z = pk2b(v[12], v[13]); w1.w = pk2b(v[14], v[15]); }
                else { w0.x = pk2h(v[0], v[1]); w0.y = pk2h(v[2], v[3]); w0.z = pk2h(v[4], v[5]); w0.w = pk2h(v[6], v[7]);
                       w1.x = pk2h(v[8], v[9]); w1.y = pk2h(v[10], v[11]); w1.z = pk2h(v[12], v[13]); w1.w = pk2h(v[14], v[15]); }
                *(u32x4*)o = w0; *(u32x4*)(o + 32) = w1;
            }
    }
};
struct EpiOut {
    const float* x; float* out;
    __device__ __forceinline__ void operator()(const f32x4 (&acc)[2][2][4][2], const pg8::Unit& u, int wr, int wc, int fr, int fq) const {
        const int col = u.pn * 256 + 64 * wc + 4 * fq;
#pragma unroll
        for (int ai = 0; ai < 2; ++ai) {
            f32x4 xv[4][2][2];
#pragma unroll
            for (int m = 0; m < 4; ++m) { const size_t off = (size_t)(u.pm * 256 + ai * 128 + wr * 64 + m * 16 + fr) * DM + col;
#pragma unroll
                for (int bj = 0; bj < 2; ++bj)
#pragma unroll
                    for (int n = 0; n < 2; ++n) xv[m][bj][n] = *(const f32x4*)(x + off + 32 * bj + 16 * n); }
#pragma unroll
            for (int m = 0; m < 4; ++m) { const size_t off = (size_t)(u.pm * 256 + ai * 128 + wr * 64 + m * 16 + fr) * DM + col;
#pragma unroll
                for (int bj = 0; bj < 2; ++bj)
#pragma unroll
                    for (int n = 0; n < 2; ++n) *(f32x4*)(out + off + 32 * bj + 16 * n) = xv[m][bj][n] + acc[ai][bj][m][n]; }
        }
    }
};

template <class RowOf>
__device__ __forceinline__ void transpose_item(const float* W, int K, int N, h16* WT, LAS float* scr, int item, int lane, RowOf row_of) {
    const int nblk = (N + 31) / 32, kb = item / nblk, nb = item % nblk, k0 = 64 * kb, n0 = 32 * nb;
    const int nc = n0 + (lane & 31);
    float wv_[32];
#pragma unroll
    for (int i = 0; i < 32; ++i) { const int kk = 2 * i + (lane >> 5); wv_[i] = nc < N ? W[(size_t)(k0 + kk) * N + nc] : 0.f; }
#pragma unroll
    for (int i = 0; i < 32; ++i) { const int kk = 2 * i + (lane >> 5); scr[kk * 33 + (lane & 31)] = wv_[i]; }
    asm volatile("s_waitcnt lgkmcnt(0)" ::: "memory");
    const int c = lane & 7;
#pragma unroll
    for (int j = 0; j < 4; ++j) { const int n = (lane >> 3) + 8 * j; const LAS float* s = scr + (8 * c) * 33 + n;
        u32x4 o; o.x = pk2h(s[0 * 33], s[1 * 33]); o.y = pk2h(s[2 * 33], s[3 * 33]); o.z = pk2h(s[4 * 33], s[5 * 33]); o.w = pk2h(s[6 * 33], s[7 * 33]);
        if (n0 + n < N) *(u32x4*)(WT + (size_t)row_of(n0 + n) * K + k0 + 8 * c) = o; }
    asm volatile("s_waitcnt lgkmcnt(0)" ::: "memory");
}
__device__ __forceinline__ void rms_row(const float* __restrict__ xrow, const float* __restrict__ gain, h16* __restrict__ orow, int lane) {
    const f32x4* xr = (const f32x4*)xrow + lane;
    f32x4 v[4]; float s = 0.f;
#pragma unroll
    for (int j = 0; j < 4; ++j) { v[j] = xr[64 * j]; s += (v[j].x * v[j].x + v[j].y * v[j].y) + (v[j].z * v[j].z + v[j].w * v[j].w); }
    const float r = rsqrtf(wave_sum(s) * (1.f / DM) + RMS_EPS);
    u32x2* o8 = (u32x2*)orow + lane;
#pragma unroll
    for (int j = 0; j < 4; ++j) { const f32x4 g = ((const f32x4*)gain)[lane + 64 * j]; u32x2 w; w.x = pk2h(v[j].x * r * g.x, v[j].y * r * g.y); w.y = pk2h(v[j].z * r * g.z, v[j].w * r * g.w); o8[64 * j] = w; }
}
__device__ __forceinline__ void phase_prologue(const Params& p, LAS unsigned char* lds, int bid, int nblk) {
    const int tid = opaque_tid(), lane = tid & 63, wave = tid >> 6;
    LAS float* scr = (LAS float*)(lds + wave * 16384);
    const int gw = bid * NWAVE + wave, NGW = nblk * NWAVE;
    h16* W1T = (h16*)(p.ws + WS_W1T); h16* W2T = (h16*)(p.ws + WS_W2T); h16* HN = (h16*)(p.ws + WS_HN);
    constexpr int I1 = (DM / 64) * ((NPROJ + 31) / 32), I2 = (DM / 64) * (DM / 32);
    for (int it = gw; it < I1 + I2; it += NGW) {
        if (it < I1) transpose_item(p.w_in, DM, NPROJ, W1T, scr, it, lane, [](int c) { return w1_row_of_col(c); });
        else transpose_item(p.w_out, DM, DM, W2T, scr, it - I1, lane, [](int c) { return (c & ~255) + phys_of_logical2(c & 255); });
    }
    for (int m = gw; m < MTOK; m += 4 * NGW) {
        f32x4 v[4][4];
#pragma unroll
        for (int r = 0; r < 4; ++r)
#pragma unroll
            for (int j = 0; j < 4; ++j) v[r][j] = ((const f32x4*)(p.x + (size_t)(m + r * NGW) * DM))[lane + 64 * j];
#pragma unroll
        for (int r = 0; r < 4; ++r) {
            float ss = 0.f;
#pragma unroll
            for (int j = 0; j < 4; ++j) ss += (v[r][j].x * v[r][j].x + v[r][j].y * v[r][j].y) + (v[r][j].z * v[r][j].z + v[r][j].w * v[r][j].w);
            const float rs = rsqrtf(wave_sum(ss) * (1.f / DM) + RMS_EPS);
            u32x2* o8 = (u32x2*)(HN + (size_t)(m + r * NGW) * DM) + lane;
#pragma unroll
            for (int j = 0; j < 4; ++j) { const f32x4 g = ((const f32x4*)p.norm_gain)[lane + 64 * j]; u32x2 w; w.x = pk2h(v[r][j].x * rs * g.x, v[r][j].y * rs * g.y); w.y = pk2h(v[r][j].z * rs * g.z, v[r][j].w * rs * g.w); o8[64 * j] = w; }
        }
    }
}
__device__ __forceinline__ void phase_gemm1(const Params& p, LAS unsigned char* lds, int bid, int nblk) {
    pg8::Gemm g{(const h16*)(p.ws + WS_HN), (const h16*)(p.ws + WS_W1T), MTOK, N1PAD, DM};
    pg8::StaticOrder S; S.init(MTOK, N1PAD, nblk, bid);
    EpiProj E{p.ws, p.qg, p.kg};
    pg8::gemm_phase<EpiProj, pg8::StaticOrder, true, true>(lds, g, S, E);
}

constexpr int KW_STR = 528;
__device__ __forceinline__ void phase_kiwi(const Params& p, LAS unsigned char* lds, int bid, int nblk) {
    const int tid = opaque_tid(), lane = tid & 63, wv = __builtin_amdgcn_readfirstlane(tid >> 6), r32 = lane & 31, hh = lane >> 5;
    const h16* HN = (const h16*)(p.ws + WS_HN); const h16* W3 = (const h16*)(p.ws + WS_W1T) + (size_t)W3ROW * DM;
    const int rt = wv & 1, ct = wv >> 1;
    for (int blk = bid; blk < MTOK / 64; blk += nblk) {
        const int tok0 = blk * 64;
        f32x16 acc = f32x16{};
        u32x4 stg[10];
#define KW_LOAD(KC) _Pragma("unroll") for (int i = 0; i < 10; ++i) { const int idx = tid + 512 * i; const int row = idx >> 5, ch = idx & 31; \
                const h16* src = row < 64 ? HN + (size_t)(tok0 + row) * DM + (KC) * 256 + ch * 8 : W3 + (size_t)(row - 64) * DM + (KC) * 256 + ch * 8; stg[i] = *(const u32x4*)src; }
        KW_LOAD(0)
        for (int kc = 0; kc < 4; ++kc) {
            __syncthreads();
#pragma unroll
            for (int i = 0; i < 10; ++i) { const int idx = tid + 512 * i; *(LAS u32x4*)(lds + (idx >> 5) * KW_STR + (idx & 31) * 16) = stg[i]; }
            if (kc < 3) { KW_LOAD(kc + 1) }
            asm volatile("s_waitcnt lgkmcnt(0)\n\ts_barrier" ::: "memory");
            if (ct < 3) {
                LAS const unsigned char* ap = lds + (64 + ct * 32 + r32) * KW_STR + hh * 16;
                LAS const unsigned char* bp = lds + (rt * 32 + r32) * KW_STR + hh * 16;
#pragma unroll
                for (int ks = 0; ks < 16; ++ks) acc = __builtin_amdgcn_mfma_f32_32x32x16_f16(*(LAS const h16x8*)(ap + ks * 32), *(LAS const h16x8*)(bp + ks * 32), acc, 0, 0, 0);
            }
        }
#undef KW_LOAD
        const size_t tok = (size_t)(tok0 + rt * 32 + r32);
        if (ct < 2) {
            h16* o = (h16*)(p.ws + WS_KI) + tok * 64 + ct * 32 + 4 * hh;
#pragma unroll
            for (int g = 0; g < 4; ++g) { u32x2 w; w.x = pk2h(acc[4 * g], acc[4 * g + 1]); w.y = pk2h(acc[4 * g + 2], acc[4 * g + 3]); *(u32x2*)(o + 8 * g) = w; }
        } else if (ct == 2) {
            float* o = (float*)(p.ws + WS_WI) + tok * 16 + 4 * hh;
#pragma unroll
            for (int g = 0; g < 2; ++g) *(f32x4*)(o + 8 * g) = (f32x4){acc[4 * g] * IDXS, acc[4 * g + 1] * IDXS, acc[4 * g + 2] * IDXS, acc[4 * g + 3] * IDXS};
        }
    }
}
__device__ __forceinline__ void phase_gemm2(const Params& p, LAS unsigned char* lds, int bid, int nblk) {
    pg8::Gemm g{(const h16*)(p.ws + WS_MIX), (const h16*)(p.ws + WS_W2T), MTOK, DM, DM};
    pg8::StaticOrder S; S.init(MTOK, DM, nblk, bid);
    EpiOut E{p.x, p.out};
    pg8::gemm_phase<EpiOut, pg8::StaticOrder, true, true>(lds, g, S, E);
}
#define XB_TMO      128
#define XB_XCNT(j)  (256  + 64 * (j))
#define XB_XSUB(j)  (1280 + 64 * (j))
#define XB_XGEN(j)  (2304 + 64 * (j))
#define XB_TOP      3328
#define XB_TOPGEN   3392
#define XCD_BAR_WORDS 3456
#define XB_SPIN_CAP (1u << 22)
__device__ __forceinline__ unsigned xb_ld(unsigned* p)              { return __hip_atomic_load(p, __ATOMIC_RELAXED, __HIP_MEMORY_SCOPE_AGENT); }
__device__ __forceinline__ unsigned xb_add(unsigned* p, unsigned v) { return __hip_atomic_fetch_add(p, v, __ATOMIC_RELAXED, __HIP_MEMORY_SCOPE_AGENT); }
__device__ __forceinline__ unsigned xb_xcc_id() { return (unsigned)__builtin_amdgcn_s_getreg((3 << 11) | 20) & 0xFu; }
#define XB_SPIN(cond, bar) do { unsigned _sp = 0; while (cond) { __builtin_amdgcn_s_sleep(1); \
    if ((++_sp & 255u) == 0u) { if (xb_ld(&(bar)[XB_TMO])) break; if (_sp > XB_SPIN_CAP) { atomicAdd(&(bar)[XB_TMO], 1u); break; } } } } while (0)
struct XcdBarrier { unsigned* bar; unsigned x; volatile LAS unsigned* st; };
__device__ __forceinline__ XcdBarrier xcd_barrier_post(unsigned* bar, volatile LAS unsigned* st) {
    XcdBarrier b; b.bar = bar; b.x = xb_xcc_id(); b.st = st;
    if (threadIdx.x == 0) (void)xb_add(&bar[XB_XCNT(b.x)], 1u);
    return b;
}
__device__ __forceinline__ void xcd_barrier_complete(unsigned* bar, unsigned x, unsigned& nloc, unsigned& nx) {
    const unsigned G = gridDim.x * gridDim.y * gridDim.z;
    unsigned sum, cnt, mine, sp = 0u;
    for (;;) {
        sum = 0u; cnt = 0u; mine = 0u;
#pragma unroll
        for (unsigned j = 0; j < 16; ++j) { const unsigned c = xb_ld(&bar[XB_XCNT(j)]); sum += c; cnt += (c > 0u) ? 1u : 0u; mine = (j == x) ? c : mine; }
        if (sum == G) break;
        __builtin_amdgcn_s_sleep(1);
        if ((++sp & 255u) == 0u) { if (xb_ld(&bar[XB_TMO])) break; if (sp > XB_SPIN_CAP) { atomicAdd(&bar[XB_TMO], 1u); break; } }
    }
    nloc = mine > 0u ? mine : 1u; nx = cnt > 0u ? cnt : 1u;
}
__device__ __forceinline__ void xcd_barrier(const XcdBarrier& b) {
    asm volatile("s_waitcnt vmcnt(0)" ::: "memory");
    __syncthreads();
    if (threadIdx.x == 0) {
        unsigned* bar = b.bar;
        __builtin_amdgcn_s_waitcnt(0);
        unsigned nloc = b.st[0], nx = b.st[1];
        if (nloc == 0u) { xcd_barrier_complete(bar, b.x, nloc, nx); b.st[0] = nloc; b.st[1] = nx; }
        const unsigned old = xb_add(&bar[XB_XSUB(b.x)], 1u);
        const unsigned gen = old / nloc;
        if (old + 1u == (gen + 1u) * nloc) {
            __builtin_amdgcn_fence(__ATOMIC_RELEASE, "agent");
            asm volatile("s_waitcnt vmcnt(0)" ::: "memory");
            const unsigned og = xb_add(&bar[XB_TOP], 1u);
            const unsigned tg = og / nx;
            if (og + 1u == (tg + 1u) * nx) xb_add(&bar[XB_TOPGEN], 1u);
            else XB_SPIN(xb_ld(&bar[XB_TOPGEN]) == tg, bar);
            xb_add(&bar[XB_XGEN(b.x)], 1u);
            __builtin_amdgcn_fence(__ATOMIC_ACQUIRE, "agent");
            asm volatile("s_waitcnt vmcnt(0)" ::: "memory");
        } else {
            XB_SPIN(xb_ld(&bar[XB_XGEN(b.x)]) == gen, bar);
            __builtin_amdgcn_fence(__ATOMIC_ACQUIRE, "agent");
            asm volatile("s_waitcnt vmcnt(0)" ::: "memory");
        }
    }
    __syncthreads();
}
#define XB_FLAT(k)  (3520 + 64 * (k))
__device__ __forceinline__ void flat_arrive(const XcdBarrier& b, int k) {
    asm volatile("s_waitcnt vmcnt(0)" ::: "memory");
    __syncthreads();
    if (threadIdx.x == 0) (void)xb_add(&b.bar[XB_FLAT(k)], 1u);
}
__device__ __forceinline__ void flat_wait(const XcdBarrier& b, int k) {
    if (threadIdx.x == 0) { const unsigned G = gridDim.x * gridDim.y * gridDim.z; XB_SPIN(xb_ld(&b.bar[XB_FLAT(k)]) < G, b.bar); }
    __syncthreads();
}
__device__ __forceinline__ int crow(int r, int hi) { return (r & 3) + 8 * (r >> 2) + 4 * hi; }
constexpr int KSTR = 144, VSTR = 192;
constexpr int KT_BYTES = 64 * KSTR, VT_BYTES = 64 * VSTR;
constexpr int MT_BYTES = 2048;
constexpr int ATT_BUF = KT_BYTES + VT_BYTES + MT_BYTES;
constexpr int ATT_TAB = 2 * ATT_BUF;
constexpr int OSTR = 144, ATT_OST = ATT_TAB + 2304;
constexpr float SB_EXIT = 64.f;
__device__ __forceinline__ s16x4 vtr(LAS const unsigned char* p) { return __builtin_amdgcn_ds_read_tr16_b64_v4i16((LAS s16x4*)p); }
__device__ __forceinline__ h16x8 mk8(s16x4 a, s16x4 b) { typedef short s16x8 __attribute__((ext_vector_type(8))); s16x8 r = {a[0], a[1], a[2], a[3], b[0], b[1], b[2], b[3]}; return __builtin_bit_cast(h16x8, r); }
__device__ __forceinline__ h16x8 pack8(float a0, float a1, float a2, float a3, float a4, float a5, float a6, float a7) {
    u32x4 w; w.x = pk2h(a0, a1); w.y = pk2h(a2, a3); w.z = pk2h(a4, a5); w.w = pk2h(a6, a7); return __builtin_bit_cast(h16x8, w); }
__device__ __forceinline__ float bcast_lo(float v) { const unsigned u = __float_as_uint(v); auto rr = __builtin_amdgcn_permlane32_swap(u, u, false, false); return __uint_as_float(rr[0]); }
__device__ __forceinline__ f32x16 splat16(float v) { f32x16 r;
#pragma unroll
    for (int i = 0; i < 16; ++i) r[i] = v;
    return r; }

struct KVStage { u32x4 k, v; unsigned m; };
template <bool MASK>
__device__ __forceinline__ void kv_load(KVStage& st, const h16* Kg, const h16* Vg, const unsigned* Mg, int tile, int tid) {
    const size_t off = (size_t)(tile * 64 + (tid >> 3)) * 512 + (tid & 7) * 8;
    const h16* kp = Kg + off; const h16* vp = Vg + off;
    asm volatile("global_load_dwordx4 %0, %1, off" : "=v"(st.k) : "v"(kp) : "memory");
    asm volatile("global_load_dwordx4 %0, %1, off" : "=v"(st.v) : "v"(vp) : "memory");
    if (MASK) { const unsigned* mp = Mg + (size_t)(2 * tile + (tid >> 8)) * SEQ + (tid & 255); asm volatile("global_load_dword %0, %1, off" : "=v"(st.m) : "v"(mp) : "memory"); }
}
template <int N>
__device__ __forceinline__ void kv_wait(KVStage& st) {
    asm volatile("s_waitcnt vmcnt(%0)" :: "n"(N) : "memory");
    asm volatile("" : "+v"(st.k), "+v"(st.v), "+v"(st.m));
}
template <bool MASK>
__device__ __forceinline__ void kv_store(const KVStage& st, LAS unsigned char* buf, int tid) {
    *(LAS u32x4*)(buf + (tid >> 3) * KSTR + (tid & 7) * 16) = st.k;
    *(LAS u32x4*)(buf + KT_BYTES + (tid >> 3) * VSTR + (tid & 7) * 16) = st.v;
    if (MASK) *(LAS unsigned*)(buf + KT_BYTES + VT_BYTES + tid * 4) = st.m;
}
__device__ __forceinline__ f32x16 qk_tile(LAS const unsigned char* kb, int sub, const h16x8 (&qf)[4], int r32, int hh, f32x16 cinit = f32x16{}) {
    LAS const unsigned char* kp = kb + (sub * 32 + r32) * KSTR + hh * 16;
    f32x16 acc = cinit;
#pragma unroll
    for (int ks = 0; ks < 4; ++ks) { const h16x8 kf = *(LAS const h16x8*)(kp + ks * 32); acc = __builtin_amdgcn_mfma_f32_32x32x16_f16(kf, qf[ks], acc, 0, 0, 0); }
    return acc;
}
__device__ __forceinline__ void pv_tile(f32x16 (&o)[2], LAS const unsigned char* vb, int sub, const h16x8 (&pa)[2], int lane) {
    const int g = lane >> 4, i = lane & 15, q = i >> 2, pp = i & 3;
    LAS const unsigned char* vp = vb + (sub * 32 + 4 * (g >> 1) + q) * VSTR + (16 * (g & 1) + 4 * pp) * 2;
#pragma unroll
    for (int db = 0; db < 2; ++db)
#pragma unroll
        for (int s2 = 0; s2 < 2; ++s2) {
            const s16x4 lo = vtr(vp + (16 * s2) * VSTR + db * 64), hi = vtr(vp + (16 * s2 + 8) * VSTR + db * 64);
            o[db] = __builtin_amdgcn_mfma_f32_32x32x16_f16(pa[s2], mk8(lo, hi), o[db], 0, 0, 0);
        }
}
__device__ __forceinline__ void att_store(const f32x16 (&o)[2], LAS unsigned char* ost, const LAS float* rs, const h16* Gg, h16* Og, int qw, int lane) {
    const int r32 = lane & 31, hh = lane >> 5;
    const int ch = lane & 7;
    h16x8 gvv[4];
#pragma unroll
    for (int i = 0; i < 4; ++i) gvv[i] = *(const h16x8*)(Gg + (size_t)(qw + 8 * i + (lane >> 3)) * 512 + ch * 8);
#pragma unroll
    for (int db = 0; db < 2; ++db)
#pragma unroll
        for (int r = 0; r < 16; ++r) *(LAS h16*)(ost + crow(r, hh) * OSTR + (32 * db + r32) * 2) = (h16)o[db][r];
    asm volatile("s_waitcnt lgkmcnt(0)" ::: "memory");
#pragma unroll
    for (int i = 0; i < 4; ++i) {
        const int row = 8 * i + (lane >> 3);
        const float sc = rs ? 1.f / rs[row] : 1.f;
        const size_t tok = (size_t)(qw + row);
        const h16x8 ov = *(const LAS h16x8*)(ost + row * OSTR + ch * 16);
        const h16x8 gv = gvv[i];
        u32x4 w;
        w.x = pk2h((float)ov[0] * sc * (float)gv[0], (float)ov[1] * sc * (float)gv[1]); w.y = pk2h((float)ov[2] * sc * (float)gv[2], (float)ov[3] * sc * (float)gv[3]);
        w.z = pk2h((float)ov[4] * sc * (float)gv[4], (float)ov[5] * sc * (float)gv[5]); w.w = pk2h((float)ov[6] * sc * (float)gv[6], (float)ov[7] * sc * (float)gv[7]);
        *(u32x4*)(Og + tok * 1024 + ch * 8) = w;
    }
}
__device__ __forceinline__ void k_frags(h16x8 (&kf)[4], LAS const unsigned char* kb, int sub, int r32, int hh) {
    LAS const unsigned char* kp = kb + (sub * 32 + r32) * KSTR + hh * 16;
#pragma unroll
    for (int ks = 0; ks < 4; ++ks) kf[ks] = *(LAS const h16x8*)(kp + ks * 32);
}
__device__ __forceinline__ void v_frags(h16x8 (&vf)[2][2], LAS const unsigned char* vb, int sub, int lane) {
    const int g = lane >> 4, i = lane & 15, q = i >> 2, pp = i & 3;
    LAS const unsigned char* vp = vb + (sub * 32 + 4 * (g >> 1) + q) * VSTR + (16 * (g & 1) + 4 * pp) * 2;
#pragma unroll
    for (int db = 0; db < 2; ++db)
#pragma unroll
        for (int s2 = 0; s2 < 2; ++s2) vf[db][s2] = mk8(vtr(vp + (16 * s2) * VSTR + db * 64), vtr(vp + (16 * s2 + 8) * VSTR + db * 64));
}
__device__ __forceinline__ f32x16 qk_mma(const h16x8 (&kf)[4], const h16x8 (&qf)[4], f32x16 acc) {
#pragma unroll
    for (int ks = 0; ks < 4; ++ks) acc = __builtin_amdgcn_mfma_f32_32x32x16_f16(kf[ks], qf[ks], acc, 0, 0, 0);
    return acc;
}
__device__ __forceinline__ void pv_mma(f32x16 (&o)[2], const h16x8 (&vf)[2][2], const h16x8 (&pa)[2]) {
#pragma unroll
    for (int db = 0; db < 2; ++db)
#pragma unroll
        for (int s2 = 0; s2 < 2; ++s2) o[db] = __builtin_amdgcn_mfma_f32_32x32x16_f16(pa[s2], vf[db][s2], o[db], 0, 0, 0);
}

typedef short b16x8 __attribute__((ext_vector_type(8)));
__device__ __forceinline__ b16x8 pack8b(float a0, float a1, float a2, float a3, float a4, float a5, float a6, float a7) {
    u32x4 w; w.x = pk2b(a0, a1); w.y = pk2b(a2, a3); w.z = pk2b(a4, a5); w.w = pk2b(a6, a7); return __builtin_bit_cast(b16x8, w); }
__device__ __forceinline__ void pv_mma_b(f32x16 (&o)[2], const h16x8 (&vf)[2][2], const b16x8 (&pa)[2]) {
#pragma unroll
    for (int db = 0; db < 2; ++db)
#pragma unroll
        for (int s2 = 0; s2 < 2; ++s2) o[db] = __builtin_amdgcn_mfma_f32_32x32x16_bf16(pa[s2], __builtin_bit_cast(b16x8, vf[db][s2]), o[db], 0, 0, 0);
}
#define SCHED_FENCE() __builtin_amdgcn_sched_barrier(0)
#define LDS_BARRIER() asm volatile("s_waitcnt lgkmcnt(0)\n\ts_barrier" ::: "memory")
__device__ __forceinline__ void att_unit(int u, int& b, int& h, int& qb) { const int pass = u >> 8, x = u & 7, m = (u >> 3) & 31; h = x; b = 4 * pass + (m & 3); qb = pass ? (m >> 2) : 7 - (m >> 2); }


constexpr int HALF_LDS = 65536;
constexpr int MISC_OFF = 131072;
struct Half { int hf, ht, hw, lane; LAS unsigned char* lds; LAS unsigned* bar; unsigned tgt; };
__device__ __forceinline__ Half half_init(LAS unsigned char* lds_all) {
    const int tid = opaque_tid(); Half H;
    H.hf = __builtin_amdgcn_readfirstlane(tid >> 8); H.ht = tid & 255; H.hw = __builtin_amdgcn_readfirstlane((tid >> 6) & 3); H.lane = tid & 63;
    H.lds = lds_all + H.hf * HALF_LDS; H.bar = (LAS unsigned*)(lds_all + MISC_OFF + 64 + 64 * H.hf); H.tgt = 0u;
    return H;
}
__device__ __forceinline__ void half_barrier(Half& H) {
    asm volatile("s_waitcnt lgkmcnt(0)" ::: "memory");
    H.tgt += 4u;
    if (H.lane == 0) (void)__hip_atomic_fetch_add(H.bar, 1u, __ATOMIC_RELAXED, __HIP_MEMORY_SCOPE_WORKGROUP);
    while (__hip_atomic_load(H.bar, __ATOMIC_RELAXED, __HIP_MEMORY_SCOPE_WORKGROUP) < H.tgt) __builtin_amdgcn_s_sleep(1);
    asm volatile("" ::: "memory");
}
constexpr int H_MT = 1024;
constexpr int H_BUF = KT_BYTES + VT_BYTES + H_MT;
constexpr int H_MISC = 2 * H_BUF;
constexpr int H_OST = H_MISC + 2048;
struct KV2 { u32x4 k[2], v[2]; unsigned m; };
template <bool MASK>
__device__ __forceinline__ void kv2_load(KV2& st, const h16* Kg, const h16* Vg, const unsigned* Mq, int tile, int ht) {
#pragma unroll
    for (int i = 0; i < 2; ++i) { const int idx = ht + 256 * i; const size_t off = (size_t)(tile * 64 + (idx >> 3)) * 512 + (idx & 7) * 8; st.k[i] = *(const u32x4*)(Kg + off); st.v[i] = *(const u32x4*)(Vg + off); }
    if (MASK) st.m = Mq[(size_t)(2 * tile + (ht >> 7)) * SEQ + (ht & 127)];
}
template <bool MASK>
__device__ __forceinline__ void kv2_store(const KV2& st, LAS unsigned char* buf, int ht) {
#pragma unroll
    for (int i = 0; i < 2; ++i) { const int idx = ht + 256 * i; *(LAS u32x4*)(buf + (idx >> 3) * KSTR + (idx & 7) * 16) = st.k[i]; *(LAS u32x4*)(buf + KT_BYTES + (idx >> 3) * VSTR + (idx & 7) * 16) = st.v[i]; }
    if (MASK) *(LAS unsigned*)(buf + KT_BYTES + VT_BYTES + ht * 4) = st.m;
}
__device__ __forceinline__ void att2_unit(int u, int& b, int& h, int& q16) {
    const int pass = u >> 9, v = u & 511, hf = v & 1, blk = v >> 1, x = blk & 7, e = 2 * (blk >> 3) + hf;
    h = x; b = 4 * pass + (e & 3); q16 = pass ? (e >> 2) : 15 - (e >> 2);
}
__device__ __forceinline__ void sb_softplus(const f32x16& z, h16x8 (&lf)[2], bool dg, int r32, int hh) {
    float L[16];
#pragma unroll
    for (int r = 0; r < 16; ++r) { float l = __builtin_amdgcn_logf(1.f + __builtin_amdgcn_exp2f(z[r])); if (dg && crow(r, hh) >= r32) l = 0.f; L[r] = l; }
    lf[0] = pack8(L[0], L[1], L[2], L[3], L[4], L[5], L[6], L[7]); lf[1] = pack8(L[8], L[9], L[10], L[11], L[12], L[13], L[14], L[15]);
}
__device__ __forceinline__ void sb_weights(const f32x16& z, const f32x16& y, h16x8 (&pa)[2], bool dg, int r32, int hh) {
    float A[16];
#pragma unroll
    for (int r = 0; r < 16; ++r) { float a = __builtin_amdgcn_exp2f(z[r] - y[r]); if (dg && crow(r, hh) >= r32) a = 0.f; A[r] = a; }
    pa[0] = pack8(A[0], A[1], A[2], A[3], A[4], A[5], A[6], A[7]); pa[1] = pack8(A[8], A[9], A[10], A[11], A[12], A[13], A[14], A[15]);
}
__device__ __forceinline__ f32x16 sb_cum(const h16x8 (&tri)[2], const h16x8 (&lf)[2], float carry) {
    f32x16 y = splat16(carry);
    y = __builtin_amdgcn_mfma_f32_32x32x16_f16(tri[0], lf[0], y, 0, 0, 0);
    y = __builtin_amdgcn_mfma_f32_32x32x16_f16(tri[1], lf[1], y, 0, 0, 0);
    return y;
}

__device__ __forceinline__ void sb2_unit(const Params& p, Half& H, int b, int h, int q16) {
    const int lane = H.lane, hw = H.hw, ht = H.ht, r32 = lane & 31, hh = lane >> 5;
    LAS unsigned char* lds = H.lds;
    const h16* Qg = (const h16*)(p.ws + WS_QB) + (size_t)b * SEQ * 512 + h * 64;
    const h16* Kg = (const h16*)(p.ws + WS_KB) + (size_t)b * SEQ * 512 + h * 64;
    const h16* Vg = (const h16*)(p.ws + WS_VB) + (size_t)b * SEQ * 512 + h * 64;
    const h16* Gg = (const h16*)(p.ws + WS_GB) + (size_t)b * SEQ * 512 + h * 64;
    h16* Og = (h16*)(p.ws + WS_MIX) + (size_t)b * SEQ * 1024 + 512 + h * 64;
    const int q0 = q16 * 128, qw = q0 + hw * 32;
    const int jmax = 2 * q16 + 1, diag = qw >> 5;
    KV2 st; kv2_load<false>(st, Kg, Vg, nullptr, jmax, ht);
    h16x8 qf[4];
#pragma unroll
    for (int ks = 0; ks < 4; ++ks) qf[ks] = *(const h16x8*)(Qg + (size_t)(qw + r32) * 512 + ks * 16 + hh * 8);
    h16x8 tri[2];
#pragma unroll
    for (int s2 = 0; s2 < 2; ++s2)
#pragma unroll
        for (int jj = 0; jj < 8; ++jj) { const int j = 16 * s2 + 8 * (jj >> 2) + 4 * hh + (jj & 3); tri[s2][jj] = (j >= r32) ? (h16)1.0f : (h16)0.0f; }
    f32x16 o[2]; o[0] = f32x16{}; o[1] = f32x16{};
    LAS unsigned* flg = (LAS unsigned*)(lds + H_MISC + 1536);
    float carry = 0.f;
    asm volatile("" : "+v"(qf[0]), "+v"(qf[1]), "+v"(qf[2]), "+v"(qf[3]));
    int cur = 0;
    kv2_store<false>(st, lds, ht);
    half_barrier(H);
    const int jd = diag >> 1;
    int j = jmax; bool fin = false;
#define SB_STAGE_IN()  if (j > 0) kv2_load<false>(st, Kg, Vg, nullptr, j - 1, ht); \
        LAS const unsigned char* kb = lds + cur * H_BUF; LAS const unsigned char* vb = kb + KT_BYTES;
#define SB_STAGE_OUT() if (j > 0) kv2_store<false>(st, lds + (cur ^ 1) * H_BUF, ht); \
        if (lane == 0) flg[(j & 1) * 4 + hw] = (2 * j <= diag && __all(carry > SB_EXIT)) ? 1u : 0u; \
        half_barrier(H); \
        cur ^= 1; \
        { const unsigned f = flg[(j & 1) * 4 + (lane & 3)]; if (__all(f != 0u)) fin = true; }
    for (; j > jd && !fin; --j) { SB_STAGE_IN() (void)kb; (void)vb; SB_STAGE_OUT() }
    if (!fin && j == jd) {
        SB_STAGE_IN()
#pragma unroll
        for (int sub = 1; sub >= 0; --sub) {
            const int si = 2 * j + sub;
            if (si <= diag) {
                const bool dg = (si == diag);
                const f32x16 z = qk_tile(kb, sub, qf, r32, hh);
                h16x8 lf[2], pa[2];
                sb_softplus(z, lf, dg, r32, hh);
                const f32x16 y = sb_cum(tri, lf, carry);
                sb_weights(z, y, pa, dg, r32, hh);
                carry = bcast_lo(y[0]);
                pv_tile(o, vb, sub, pa, lane);
            }
        }
        SB_STAGE_OUT()
        --j;
    }
    for (; j >= 0 && !fin; --j) {
        SB_STAGE_IN()
        const f32x16 z1 = qk_tile(kb, 1, qf, r32, hh);
        const f32x16 z0 = qk_tile(kb, 0, qf, r32, hh);
        h16x8 lf1[2], lf0[2], pa1[2], pa0[2];
        sb_softplus(z1, lf1, false, r32, hh);
        const f32x16 y1 = sb_cum(tri, lf1, carry);
        sb_softplus(z0, lf0, false, r32, hh);
        const float c1 = bcast_lo(y1[0]);
        const f32x16 y0 = sb_cum(tri, lf0, c1);
        sb_weights(z1, y1, pa1, false, r32, hh);
        pv_tile(o, vb, 1, pa1, lane);
        sb_weights(z0, y0, pa0, false, r32, hh);
        pv_tile(o, vb, 0, pa0, lane);
        carry = bcast_lo(y0[0]);
        SB_STAGE_OUT()
    }
#undef SB_STAGE_IN
#undef SB_STAGE_OUT
    att_store(o, lds + H_OST + hw * (32 * OSTR), nullptr, Gg, Og, qw, lane);
}
__device__ __forceinline__ void phase_sb2(const Params& p, Half& H, int bid, int nblk) {
    for (int u = 2 * bid + H.hf; u < 1024; u += 2 * nblk) { int b, h, q16; att2_unit(u, b, h, q16); sb2_unit(p, H, b, h, q16); }
}
__device__ __forceinline__ void sa_probs(const f32x16& s, unsigned mw, const LAS float* btab, bool nearby, b16x8 (&pa)[2], f32x16& osum, const b16x8& ones, int hh) {
    float P[16];
    if (nearby) {
#pragma unroll
        for (int r = 0; r < 16; ++r) P[r] = __builtin_amdgcn_exp2f(s[r] + btab[27 - ((r & 3) + 8 * (r >> 2))]);
    } else {
#pragma unroll
        for (int r = 0; r < 16; ++r) P[r] = __builtin_amdgcn_exp2f(s[r]);
    }
#pragma unroll
    for (int r = 0; r < 16; ++r) { const int bit = (r & 3) + 8 * (r >> 2); unsigned m_; asm("v_bfe_i32 %0, %1, %2, 1" : "=v"(m_) : "v"(mw), "n"(bit)); P[r] = __uint_as_float(__float_as_uint(P[r]) & m_); }
    pa[0] = pack8b(P[0], P[1], P[2], P[3], P[4], P[5], P[6], P[7]); pa[1] = pack8b(P[8], P[9], P[10], P[11], P[12], P[13], P[14], P[15]);
    osum = __builtin_amdgcn_mfma_f32_32x32x16_bf16(pa[0], ones, osum, 0, 0, 0);
    osum = __builtin_amdgcn_mfma_f32_32x32x16_bf16(pa[1], ones, osum, 0, 0, 0);
}
constexpr int A_KT = 128 * KSTR, A_VT = 128 * VSTR, A_MT = 4096;
constexpr int A_BUF = A_KT + A_VT + A_MT;
constexpr int A_TAB = 2 * A_BUF;
struct KV1 { u32x4 k[2], v[2]; unsigned m[2]; };
__device__ __forceinline__ void kv1_load_kv(KV1& st, const h16* Kg, const h16* Vg, int tile, int tid) {
#pragma unroll
    for (int i = 0; i < 2; ++i) { const int idx = tid + 512 * i; const size_t off = (size_t)(tile * 128 + (idx >> 3)) * 512 + (idx & 7) * 8;
        st.k[i] = *(const u32x4*)(Kg + off); st.v[i] = *(const u32x4*)(Vg + off); }
}
__device__ __forceinline__ void kv1_load_m(KV1& st, const unsigned* Mq, int tile, int tid) {
#pragma unroll
    for (int i = 0; i < 2; ++i) { const int idx = tid + 512 * i;
        st.m[i] = __hip_atomic_load(Mq + (size_t)(4 * tile + (idx >> 8)) * SEQ + (idx & 255), __ATOMIC_RELAXED, __HIP_MEMORY_SCOPE_AGENT); }
}
__device__ __forceinline__ void kv1_load(KV1& st, const h16* Kg, const h16* Vg, const unsigned* Mq, int tile, int tid) { kv1_load_kv(st, Kg, Vg, tile, tid); kv1_load_m(st, Mq, tile, tid); }
struct SaPre { KV1 st; h16x8 qf[4]; };
__device__ __forceinline__ void sa_prefetch_kvq(SaPre& pre, const Params& p, int b, int h, int qb) {
    const int tid = opaque_tid(), lane = tid & 63, wv = __builtin_amdgcn_readfirstlane(tid >> 6), r32 = lane & 31, hh = lane >> 5;
    const h16* Qg = (const h16*)(p.ws + WS_QA) + (size_t)b * SEQ * 512 + h * 64;
    const h16* Kg = (const h16*)(p.ws + WS_KA) + (size_t)b * SEQ * 512 + h * 64;
    const h16* Vg = (const h16*)(p.ws + WS_VA) + (size_t)b * SEQ * 512 + h * 64;
    kv1_load_kv(pre.st, Kg, Vg, 0, tid);
    const int qw = qb * 256 + wv * 32;
#pragma unroll
    for (int ks = 0; ks < 4; ++ks) pre.qf[ks] = *(const h16x8*)(Qg + (size_t)(qw + r32) * 512 + ks * 16 + hh * 8);
}
__device__ __forceinline__ void sa_prefetch_m(SaPre& pre, const Params& p, int b, int qb) {
    const int tid = opaque_tid();
    kv1_load_m(pre.st, (const unsigned*)(p.ws + WS_MASK) + (size_t)b * 64 * SEQ + qb * 256, 0, tid);
}
__device__ __forceinline__ void kv1_store(const KV1& st, LAS unsigned char* buf, int tid) {
#pragma unroll
    for (int i = 0; i < 2; ++i) { const int idx = tid + 512 * i;
        *(LAS u32x4*)(buf + (idx >> 3) * KSTR + (idx & 7) * 16) = st.k[i];
        *(LAS u32x4*)(buf + A_KT + (idx >> 3) * VSTR + (idx & 7) * 16) = st.v[i];
        *(LAS unsigned*)(buf + A_KT + A_VT + idx * 4) = st.m[i]; }
}
__device__ __forceinline__ void sa_unit(const Params& p, LAS unsigned char* lds, int b, int h, int qb, bool new_head, SaPre& pre, bool has_next, int nb, int nh, int nqb, SaPre& pre_next) {
    const int tid = opaque_tid(), lane = tid & 63, wv = __builtin_amdgcn_readfirstlane(tid >> 6), r32 = lane & 31, hh = lane >> 5;
    const h16* Qg = (const h16*)(p.ws + WS_QA) + (size_t)b * SEQ * 512 + h * 64;
    const h16* Kg = (const h16*)(p.ws + WS_KA) + (size_t)b * SEQ * 512 + h * 64;
    const h16* Vg = (const h16*)(p.ws + WS_VA) + (size_t)b * SEQ * 512 + h * 64;
    const h16* Gg = (const h16*)(p.ws + WS_GA) + (size_t)b * SEQ * 512 + h * 64;
    h16* Og = (h16*)(p.ws + WS_MIX) + (size_t)b * SEQ * 1024 + h * 64;
    const int q0 = qb * 256, qw = q0 + wv * 32;
    const unsigned* Mq = (const unsigned*)(p.ws + WS_MASK) + (size_t)b * 64 * SEQ + q0;
    LAS float* btab = (LAS float*)(lds + A_TAB);
    LAS float* lx = (LAS float*)(lds + A_TAB + 1280);
    const int jmax = 2 * qb + 1, diag = qw >> 5;
    KV1 st = pre.st;
    __syncthreads();
    if (new_head && tid < 320) { const int d = tid - 32; btab[tid] = (p.rel_bias[T5_BUCKET[d < 0 ? 0 : (d > 127 ? 127 : d)] * 8 + h] - p.rel_bias[31 * 8 + h]) * LOG2E; }
    h16x8 qf[4];
#pragma unroll
    for (int ks = 0; ks < 4; ++ks) qf[ks] = pre.qf[ks];
    (void)Qg;
    f32x16 o[2]; o[0] = f32x16{}; o[1] = f32x16{};
    f32x16 osum = f32x16{};
    b16x8 ones;
#pragma unroll
    for (int i = 0; i < 8; ++i) ones[i] = (short)0x3F80;
    const int tq = qw + r32;
    asm volatile("" : "+v"(qf[0]), "+v"(qf[1]), "+v"(qf[2]), "+v"(qf[3]));
    int cur = 0;
    kv1_store(st, lds, tid);
    __syncthreads();
    const int jf = (qw - 112) > 0 ? ((qw - 112) >> 7) : 0;
    const int jd = diag >> 2;
    int j = 0;
#define SA_STAGE_IN()  if (j < jmax) kv1_load(st, Kg, Vg, Mq, j + 1, tid); \
        LAS const unsigned char* kb = lds + cur * A_BUF; LAS const unsigned char* vb = kb + A_KT; \
        const LAS unsigned* mb = (const LAS unsigned*)(kb + A_KT + A_VT) + wv * 32 + r32;
#define SA_STAGE_OUT() if (j < jmax) kv1_store(st, lds + (cur ^ 1) * A_BUF, tid); \
        LDS_BARRIER(); \
        cur ^= 1;
    for (; j < jf; ++j) {
        SA_STAGE_IN()
#pragma unroll
        for (int pr = 0; pr < 2; ++pr) {
            const unsigned mw0 = mb[(2 * pr) * 256] >> (4 * hh), mw1 = mb[(2 * pr + 1) * 256] >> (4 * hh);
            h16x8 kf0[4], kf1[4], vf0[2][2], vf1[2][2]; b16x8 pa0[2], pa1[2];
            k_frags(kf0, kb, 2 * pr, r32, hh); k_frags(kf1, kb, 2 * pr + 1, r32, hh); v_frags(vf0, vb, 2 * pr, lane);
            SCHED_FENCE();
            const f32x16 s0 = qk_mma(kf0, qf, f32x16{});
            const f32x16 s1 = qk_mma(kf1, qf, f32x16{});
            v_frags(vf1, vb, 2 * pr + 1, lane);
            SCHED_FENCE();
            sa_probs(s0, mw0, btab, false, pa0, osum, ones, hh);
            pv_mma_b(o, vf0, pa0);
            sa_probs(s1, mw1, btab, false, pa1, osum, ones, hh);
            pv_mma_b(o, vf1, pa1);
        }
        SA_STAGE_OUT()
    }
    for (; j <= jd; ++j) {
        SA_STAGE_IN()
#pragma unroll
        for (int sub = 0; sub < 4; ++sub) {
            const int si = 4 * j + sub;
            if (si <= diag) {
                const unsigned mw = mb[sub * 256] >> (4 * hh);
                const f32x16 s = qk_tile(kb, sub, qf, r32, hh);
                b16x8 pa[2]; h16x8 vfn[2][2];
                v_frags(vfn, vb, sub, lane);
                sa_probs(s, mw, btab + (tq - 32 * si + 5 - 4 * hh), true, pa, osum, ones, hh);
                pv_mma_b(o, vfn, pa);
            }
        }
        SA_STAGE_OUT()
    }
    for (; j <= jmax; ++j) {
        SA_STAGE_IN()
        (void)vb; (void)mb;
        SA_STAGE_OUT()
    }
#undef SA_STAGE_IN
#undef SA_STAGE_OUT
    if (has_next) { sa_prefetch_kvq(pre_next, p, nb, nh, nqb); sa_prefetch_m(pre_next, p, nb, nqb); }
    if (r32 == 0) {
#pragma unroll
        for (int r = 0; r < 16; ++r) lx[wv * 32 + crow(r, hh)] = osum[r];
    }
    att_store(o, lds + wv * (32 * OSTR), lx + wv * 32, Gg, Og, qw, lane);
}
__device__ __forceinline__ void phase_sa(const Params& p, LAS unsigned char* lds, int bid, int nblk, const XcdBarrier& bar) {
    SaPre pa, pb;
    const int u = bid; const bool any = u < 512;
    int b = 0, h = 0, qb = 0;
    if (any) { att_unit(u, b, h, qb); sa_prefetch_kvq(pa, p, b, h, qb); }
    flat_wait(bar, 0);
    if (!any) return;
    sa_prefetch_m(pa, p, b, qb);
    const int u2 = u + nblk; const bool hn = u2 < 512;
    int nb = 0, nh = 0, nqb = 0; if (hn) att_unit(u2, nb, nh, nqb);
    sa_unit(p, lds, b, h, qb, true, pa, hn, nb, nh, nqb, pb);
    if (!hn) return;
    sa_unit(p, lds, nb, nh, nqb, nh != h, pb, false, 0, 0, 0, pa);
    int hprev = nh;
    for (int u3 = u2 + nblk; u3 < 512; u3 += nblk) {
        SaPre pc; att_unit(u3, b, h, qb); sa_prefetch_kvq(pc, p, b, h, qb); sa_prefetch_m(pc, p, b, qb);
        sa_unit(p, lds, b, h, qb, h != hprev, pc, false, 0, 0, 0, pc); hprev = h;
    }
}
constexpr int IK_STR = 144, IK_BUF = 256 * IK_STR, IK_SB = 2 * IK_BUF;
__device__ __forceinline__ int half_sum(int v) {
    v += __builtin_amdgcn_update_dpp(0, v, 0xB1, 0xF, 0xF, false);
    v += __builtin_amdgcn_update_dpp(0, v, 0x4E, 0xF, 0xF, false);
    v += __builtin_amdgcn_update_dpp(0, v, 0x141, 0xF, 0xF, false);
    v += __builtin_amdgcn_update_dpp(0, v, 0x140, 0xF, 0xF, false);
    { auto rr = __builtin_amdgcn_permlane16_swap((unsigned)v, (unsigned)v, false, false); v = (int)(rr[0] + rr[1]); }
    return v;
}
__device__ __forceinline__ unsigned half_umax(unsigned v) {
    unsigned o;
    o = (unsigned)__builtin_amdgcn_update_dpp(0, (int)v, 0xB1, 0xF, 0xF, false); v = v > o ? v : o;
    o = (unsigned)__builtin_amdgcn_update_dpp(0, (int)v, 0x4E, 0xF, 0xF, false); v = v > o ? v : o;
    o = (unsigned)__builtin_amdgcn_update_dpp(0, (int)v, 0x141, 0xF, 0xF, false); v = v > o ? v : o;
    o = (unsigned)__builtin_amdgcn_update_dpp(0, (int)v, 0x140, 0xF, 0xF, false); v = v > o ? v : o;
    { auto rr = __builtin_amdgcn_permlane16_swap(v, v, false, false); v = rr[0] > rr[1] ? rr[0] : rr[1]; }
    return v;
}
__device__ __forceinline__ float keyf(unsigned k) { return __uint_as_float((k & 0x80000000u) ? (k ^ 0x80000000u) : ~k); }
__device__ __forceinline__ void ik_load(u32x4 (&sk)[4], const h16* KI, int g, int tid) {
#pragma unroll
    for (int i = 0; i < 4; ++i) { const int idx = tid + 512 * i; sk[i] = *(const u32x4*)(KI + (size_t)(256 * g + (idx >> 3)) * 64 + (idx & 7) * 8); }
}
__device__ __forceinline__ void ik_store(const u32x4 (&sk)[4], LAS unsigned char* buf, int tid) {
#pragma unroll
    for (int i = 0; i < 4; ++i) { const int idx = tid + 512 * i; *(LAS u32x4*)(buf + (idx >> 3) * IK_STR + (idx & 7) * 16) = sk[i]; }
}
struct IdxPre { u32x4 sk[4]; h16x8 aq[4]; };
__device__ __forceinline__ void idx_prefetch(IdxPre& pre, const Params& p, int b, int qt) {
    const int tid = opaque_tid(), lane = tid & 63, wv = __builtin_amdgcn_readfirstlane(tid >> 6), c = lane & 31, hi = lane >> 5;
    const h16* QI = (const h16*)(p.ws + WS_QI) + (size_t)b * SEQ * 1024;
    const h16* KI = (const h16*)(p.ws + WS_KI) + (size_t)b * SEQ * 64;
    const int t0 = qt * 16 + wv * 2;
    ik_load(pre.sk, KI, 0, tid);
    const int rq = (c >> 2) & 1, rh = (c & 3) + 4 * (c >> 3);
#pragma unroll
    for (int ks = 0; ks < 4; ++ks) pre.aq[ks] = *(const h16x8*)(QI + (size_t)(t0 + rq) * 1024 + rh * 64 + ks * 16 + hi * 8);
}
__device__ __forceinline__ void idx_unit(const Params& p, LAS unsigned char* lds, int b, int qt, IdxPre& pre, bool has_next, int nb, int nqt, IdxPre& pre_next) {
    const int tid = opaque_tid(), lane = tid & 63, wv = __builtin_amdgcn_readfirstlane(tid >> 6), c = lane & 31, hi = lane >> 5;
    const h16* KI = (const h16*)(p.ws + WS_KI) + (size_t)b * SEQ * 64;
    unsigned* Mg = (unsigned*)(p.ws + WS_MASK) + (size_t)b * 64 * SEQ;
    const int t0 = qt * 16 + wv * 2, t = t0 + hi;
    u32x4 (&sk)[4] = pre.sk;
    h16x8 aq[4];
#pragma unroll
    for (int ks = 0; ks < 4; ++ks) aq[ks] = pre.aq[ks];
    const float* WI = (const float*)(p.ws + WS_WI) + (size_t)b * SEQ * 16;
    float wq[16];
#pragma unroll
    for (int i = 0; i < 4; ++i) { const f32x4 w4 = *(const f32x4*)(WI + (size_t)t * 16 + 4 * i); wq[4 * i] = w4.x; wq[4 * i + 1] = w4.y; wq[4 * i + 2] = w4.z; wq[4 * i + 3] = w4.w; }
    const int ntile = ((t0 + 1) >> 5) + 1;
    const int ngroup = ((qt * 16 + 15) >> 8) + 1;
    LAS unsigned* sb = (LAS unsigned*)(lds + IK_SB + wv * 2048);
    unsigned u[64];
#pragma unroll
    for (int j = 0; j < 64; ++j) u[j] = 0x7FC00000u;
    asm volatile("" : "+v"(aq[0]), "+v"(aq[1]), "+v"(aq[2]), "+v"(aq[3]));
    ik_store(sk, lds, tid);
    __syncthreads();
#pragma unroll
    for (int i = 0; i < 16; ++i) asm volatile("" : "+v"(wq[i]));
#pragma unroll
    for (int g = 0; g < 8; ++g) {
        if (g < ngroup) {
            if (g + 1 < ngroup) ik_load(sk, KI, g + 1, tid);
            LAS const unsigned char* kb = lds + (g & 1) * IK_BUF + c * IK_STR + hi * 16;
            h16x8 bk[4];
#pragma unroll
            for (int ks = 0; ks < 4; ++ks) bk[ks] = *(LAS const h16x8*)(kb + ks * 32);
#pragma unroll 2
            for (int jj = 0; jj < 8; ++jj) {
                const int j = 8 * g + jj, jn = jj < 7 ? jj + 1 : 7;
                h16x8 bn[4];
#pragma unroll
                for (int ks = 0; ks < 4; ++ks) bn[ks] = *(LAS const h16x8*)(kb + jn * (32 * IK_STR) + ks * 32);
                __builtin_amdgcn_sched_barrier(0);
                unsigned key = 0x7FC00000u;
                if (j < ntile) {
                    f32x16 acc = f32x16{};
#pragma unroll
                    for (int ks = 0; ks < 4; ++ks) acc = __builtin_amdgcn_mfma_f32_32x32x16_f16(aq[ks], bk[ks], acc, 0, 0, 0);
                    float sc = 0.f;
#pragma unroll
                    for (int r = 0; r < 16; ++r) { const int ib = __float_as_int(acc[r]); sc = __builtin_fmaf(wq[r], __int_as_float(ib > 0 ? ib : 0), sc); }
                    key = __float_as_uint(sc);
                }
                sb[jj * 64 + lane] = key;
#pragma unroll
                for (int ks = 0; ks < 4; ++ks) bk[ks] = bn[ks];
            }
            if (g == ((ntile - 1) >> 3)) { if (32 * (ntile - 1) + c > t) sb[((ntile - 1) & 7) * 64 + lane] = 0x7FC00000u; }
#pragma unroll
            for (int jj = 0; jj < 8; ++jj) u[8 * g + jj] = sb[jj * 64 + lane];
            if (g + 1 < ngroup) ik_store(sk, lds + ((g + 1) & 1) * IK_BUF, tid);
            asm volatile("s_waitcnt lgkmcnt(0)\n\ts_barrier" ::: "memory");
        }
    }
    if (has_next) idx_prefetch(pre_next, p, nb, nqt);
    unsigned T = 1u; bool exact = true;
    if (t0 >= TOPK) {
        float fmx = -__builtin_inff(), fmn = __builtin_inff();
#define IDX_MM(J0) _Pragma("unroll") for (int j = (J0); j < (J0) + 16; ++j) asm volatile("v_max_f32 %0, %0, %2\n\tv_min_f32 %1, %1, %2" : "+v"(fmx), "+v"(fmn) : "v"(u[j]));
        IDX_MM(0)
        if (ntile > 16) { IDX_MM(16) if (ntile > 32) { IDX_MM(32) if (ntile > 48) { IDX_MM(48) } } }
#undef IDX_MM
        unsigned kmax = fkey(fmx), kmin1 = fkey(fmn) - 1u;
        kmax = half_umax(kmax); kmin1 = ~half_umax(~kmin1);
        unsigned lo_k = kmin1 + 1u, hi_k = kmax + 1u;
        float lo_f = keyf(lo_k), hi_f = keyf(hi_k);
        float f_lo = (float)(t + 1) - ((float)TOPK - 0.5f), f_hi = -((float)TOPK - 0.5f);
        int side = 0; bool done = false; exact = false; T = lo_k;
        if (hi_k - lo_k <= 1u) done = true;
        for (int it = 0; it < 64; ++it) {
            unsigned mid_k;
            if (it < 24) { const float mid_f = hi_f - (hi_f - lo_f) * (f_hi / (f_hi - f_lo)); mid_k = fkey(mid_f); } else mid_k = lo_k + ((hi_k - lo_k) >> 1);
            mid_k = mid_k < lo_k + 1u ? lo_k + 1u : (mid_k > hi_k - 1u ? hi_k - 1u : mid_k);
            const float mid_c = keyf(mid_k);
            int c0 = 0, c1 = 0, c2 = 0, c3 = 0;
#define IDX_CNT(J0) _Pragma("unroll") for (int j = (J0); j < (J0) + 16; j += 4) { \
                asm volatile("v_cmp_ge_f32_e64 s[20:21], %4, %8\n\tv_cmp_ge_f32_e64 s[22:23], %5, %8\n\tv_cmp_ge_f32_e64 s[24:25], %6, %8\n\tv_cmp_ge_f32_e64 s[26:27], %7, %8\n\t" \
                             "v_addc_co_u32_e64 %0, s[28:29], 0, %0, s[20:21]\n\tv_addc_co_u32_e64 %1, s[28:29], 0, %1, s[22:23]\n\tv_addc_co_u32_e64 %2, s[28:29], 0, %2, s[24:25]\n\tv_addc_co_u32_e64 %3, s[28:29], 0, %3, s[26:27]" \
                             : "+v"(c0), "+v"(c1), "+v"(c2), "+v"(c3) : "v"(u[j]), "v"(u[j + 1]), "v"(u[j + 2]), "v"(u[j + 3]), "v"(mid_c) \
                             : "s20", "s21", "s22", "s23", "s24", "s25", "s26", "s27", "s28", "s29"); }
            IDX_CNT(0)
            if (ntile > 16) { IDX_CNT(16) if (ntile > 32) { IDX_CNT(32) if (ntile > 48) { IDX_CNT(48) } } }
#undef IDX_CNT
            const int cnt = half_sum((c0 + c1) + (c2 + c3));
            if (!done) {
                if (cnt == TOPK) { T = mid_k; exact = true; done = true; }
                else if (cnt > TOPK) { lo_k = mid_k; lo_f = keyf(mid_k); f_lo = (float)cnt - ((float)TOPK - 0.5f); if (side > 0) f_hi *= 0.5f; side = 1; }
                else { hi_k = mid_k; hi_f = keyf(mid_k); f_hi = (float)cnt - ((float)TOPK - 0.5f); if (side < 0) f_lo *= 0.5f; side = -1; }
                if (!done && hi_k - lo_k <= 1u) { T = lo_k; done = true; }
            }
            if (__all(done)) break;
        }
    }
    LAS unsigned long long* tb = (LAS unsigned long long*)(lds + IK_SB + 16384) + wv;
    const float Tf = (t0 >= TOPK) ? keyf(T) : -__builtin_inff();
    if (__all(exact)) {
        unsigned vlo = 0u, vhi = 0u;
#define IDX_OUT(J0) _Pragma("unroll") for (int j = (J0); j < (J0) + 16; j += 4) { \
            asm volatile("v_cmp_ge_f32_e64 s[20:21], %2, %6\n\tv_cmp_ge_f32_e64 s[22:23], %3, %6\n\tv_cmp_ge_f32_e64 s[24:25], %4, %6\n\tv_cmp_ge_f32_e64 s[26:27], %5, %6\n\t" \
                         "v_writelane_b32 %0, s20, %7\n\tv_writelane_b32 %1, s21, %7\n\tv_writelane_b32 %0, s22, %8\n\tv_writelane_b32 %1, s23, %8\n\t" \
                         "v_writelane_b32 %0, s24, %9\n\tv_writelane_b32 %1, s25, %9\n\tv_writelane_b32 %0, s26, %10\n\tv_writelane_b32 %1, s27, %10" \
                         : "+v"(vlo), "+v"(vhi) : "v"(u[j]), "v"(u[j + 1]), "v"(u[j + 2]), "v"(u[j + 3]), "v"(Tf), "n"(j), "n"(j + 1), "n"(j + 2), "n"(j + 3) \
                         : "s20", "s21", "s22", "s23", "s24", "s25", "s26", "s27"); }
        IDX_OUT(0)
        if (ntile > 16) { IDX_OUT(16) if (ntile > 32) { IDX_OUT(32) if (ntile > 48) { IDX_OUT(48) } } }
#undef IDX_OUT
        tb[lane * 8] = ((unsigned long long)vhi << 32) | vlo;
    } else {
        int ngt = 0;
#pragma unroll
        for (int j = 0; j < 64; ++j) ngt += (__uint_as_float(u[j]) > Tf) ? 1 : 0;
        ngt = half_sum(ngt);
        const int need = exact ? (1 << 30) : TOPK - ngt;
        int base = 0;
#pragma unroll
        for (int j = 0; j < 64; ++j) {
            const bool eq = (__uint_as_float(u[j]) == Tf);
            const unsigned long long be = __ballot(eq);
            const unsigned mh = hi ? (unsigned)(be >> 32) : (unsigned)be;
            const int rank = base + __popc(mh & ((1u << c) - 1u));
            const bool sel = (__uint_as_float(u[j]) > Tf) || (eq && rank < need);
            base += __popc(mh);
            const unsigned long long bal = __ballot(sel);
            if (lane == 0) tb[j * 8] = bal;
        }
    }
    __syncthreads();
    __hip_atomic_store((unsigned long long*)(Mg + (size_t)(tid >> 3) * SEQ + qt * 16 + 2 * (tid & 7)), ((LAS const unsigned long long*)(lds + IK_SB + 16384))[tid], __ATOMIC_RELAXED, __HIP_MEMORY_SCOPE_AGENT);
}
__device__ __forceinline__ void idx_deal(int u, int& b, int& qt) {
    b = u & 7; const int kk = (u >> 3) & 31, r = u >> 8; qt = r == 0 ? 127 - kk : (r == 1 ? 64 + kk : (r == 2 ? 63 - kk : kk));
}
__device__ __forceinline__ void phase_idx(const Params& p, LAS unsigned char* lds, int bid, int nblk) {
    IdxPre pa, pb;
    int u = bid; if (u >= 1024) return;
    int b, qt; idx_deal(u, b, qt);
    idx_prefetch(pa, p, b, qt);
    for (;;) {
        int un = u + nblk, nb = 0, nqt = 0; bool hn = un < 1024; if (hn) idx_deal(un, nb, nqt);
        idx_unit(p, lds, b, qt, pa, hn, nb, nqt, pb);
        if (!hn) break;
        u = un; b = nb; qt = nqt; un = u + nblk; hn = un < 1024; if (hn) idx_deal(un, nb, nqt);
        idx_unit(p, lds, b, qt, pb, hn, nb, nqt, pa);
        if (!hn) break;
        u = un; b = nb; qt = nqt;
    }
}
#include <cstdio>
__global__ void __launch_bounds__(NTHR, 2) k_fused(Params p) {
    extern __shared__ __attribute__((aligned(16))) unsigned char lds_raw[];
    LAS unsigned char* lds = (LAS unsigned char*)lds_raw;
    const int bid = blockIdx.x, nblk = gridDim.x;
    volatile LAS unsigned* st = (volatile LAS unsigned*)(lds + MISC_OFF);
    if (threadIdx.x < 64) st[threadIdx.x] = 0u;
    __syncthreads();
    Half H = half_init(lds);
    const XcdBarrier bar = xcd_barrier_post((unsigned*)(p.ws + WS_CTL), st);
    phase_prologue(p, lds, bid, nblk);
    xcd_barrier(bar);
    phase_gemm1(p, lds, bid, nblk);
    phase_kiwi(p, lds, bid, nblk);
    xcd_barrier(bar);
    phase_idx(p, lds, bid, nblk);
    flat_arrive(bar, 0);
    phase_sb2(p, H, bid, nblk);
    phase_sa(p, lds, bid, nblk, bar);
    xcd_barrier(bar);
    phase_gemm2(p, lds, bid, nblk);
}

extern "C" void kernel_launch(void* const* d_in, const int* in_sizes, int n_in, void* d_out, int out_size, void* d_ws, size_t ws_size, hipStream_t stream) {
    static int grid_blocks = 0;
    if (!grid_blocks) {
        int dev = 0, cus = 0, per_cu = 0;
        (void)hipGetDevice(&dev);
        (void)hipDeviceGetAttribute(&cus, hipDeviceAttributeMultiprocessorCount, dev);
        (void)hipFuncSetAttribute((const void*)k_fused, hipFuncAttributeMaxDynamicSharedMemorySize, LDS_BYTES);
        (void)hipOccupancyMaxActiveBlocksPerMultiprocessor(&per_cu, (const void*)k_fused, NTHR, LDS_BYTES);
        if (per_cu < 1) per_cu = 1;
        if (per_cu > 1) per_cu = 1;
        grid_blocks = cus * per_cu;
    }
    (void)hipMemsetAsync((char*)d_ws + WS_CTL, 0, 16384, stream);
    Params p{};
    p.x = (const float*)d_in[0]; p.norm_gain = (const float*)d_in[1]; p.w_in = (const float*)d_in[2]; p.qg = (const float*)d_in[3]; p.kg = (const float*)d_in[4];
    p.rel_bias = (const float*)d_in[5]; p.w_out = (const float*)d_in[6]; p.out = (float*)d_out; p.ws = (unsigned char*)d_ws; p.use_cg = 0; p.pad = 0;
    void* args[] = {&p};
    hipError_t e = hipLaunchCooperativeKernel((const void*)k_fused, dim3(grid_blocks), dim3(NTHR), args, LDS_BYTES, stream);
    if (e != hipSuccess) fprintf(stderr, "cooperative launch failed: %s (grid %d)\n", hipGetErrorString(e), grid_blocks);
}
```
